# Optimizing an MI355X kernel written in HIP

```python
import jax, jax.numpy as jnp
from jax import lax
import numpy as np

D_MODEL = 1024
BATCH = 2
SEQ = 8192
DEPTH = 1

GRID_W = 64
HEAD_DIM = 64
NA_HEADS = 8
NA_KH_MAX = 8
NA_KW = 16
SWA_HEADS = 8
SWA_KV_HEADS = 2
SWA_WINDOW = 128
SWA_BLOCK = 128
ROPE_THETA = 10000.0
NA_WIDTH = NA_HEADS * HEAD_DIM
SWA_WIDTH = SWA_HEADS * HEAD_DIM
SWA_KV_WIDTH = SWA_KV_HEADS * HEAD_DIM
MIX_WIDTH = NA_WIDTH + SWA_WIDTH
QKV_WIDTH = 3 * NA_WIDTH + SWA_WIDTH + 2 * SWA_KV_WIDTH
N_GROUPS = 4
EXPERTS_PER_GROUP = 8
N_EXPERTS = N_GROUPS * EXPERTS_PER_GROUP
TOP_K_IN_GROUP = 2
EXPERT_FF = 256
N_MOD = 6
EPS = 1e-6
NEG_INF = -1e30

kernel_name = "hymba_na_swa_hmoe_encoder"


def rmsnorm(x, g):
    xf = x.astype(jnp.float32)
    y = xf * lax.rsqrt(jnp.mean(xf * xf, axis=-1, keepdims=True) + EPS)
    return (y * g.astype(jnp.float32)).astype(x.dtype)


def rope(x, pos):
    d = x.shape[-1]
    half = d // 2
    inv = ROPE_THETA ** (-jnp.arange(half, dtype=jnp.float32) * 2.0 / d)
    ang = pos.astype(jnp.float32)[:, None] * inv[None, :]
    cos = jnp.cos(ang)[None, :, None, :]
    sin = jnp.sin(ang)[None, :, None, :]
    xf = x.astype(jnp.float32)
    x1, x2 = xf[..., :half], xf[..., half:]
    return jnp.concatenate([x1 * cos - x2 * sin, x2 * cos + x1 * sin], axis=-1).astype(x.dtype)


def neighborhood_attention(q, k, v, rpb):
    b, s, h, d = q.shape
    rows = s // GRID_W
    kh = min(NA_KH_MAX, rows)
    qg = q.reshape(b, rows, GRID_W, h, d)
    kg = k.reshape(b, rows, GRID_W, h, d)
    vg = v.reshape(b, rows, GRID_W, h, d)
    col = jnp.arange(GRID_W)
    col_start = jnp.clip(col - NA_KW // 2, 0, GRID_W - NA_KW)
    col_idx = col_start[:, None] + jnp.arange(NA_KW)[None, :]
    dc = col_idx - col[:, None] + (NA_KW - 1)
    scale = d ** -0.5

    def row_block(r):
        r0 = jnp.clip(r - kh // 2, 0, rows - kh)
        k_rows = lax.dynamic_slice_in_dim(kg, r0, kh, axis=1)
        v_rows = lax.dynamic_slice_in_dim(vg, r0, kh, axis=1)
        k_win = k_rows[:, :, col_idx]
        v_win = v_rows[:, :, col_idx]
        q_row = lax.dynamic_index_in_dim(qg, r, axis=1, keepdims=False)
        dr = r0 + jnp.arange(kh) - r + (NA_KH_MAX - 1)
        bias = rpb[:, dr[:, None, None], dc[None, :, :]]
        bias = jnp.transpose(bias, (0, 2, 1, 3)).astype(jnp.float32)
        logits = jnp.einsum('bqhd,biqjhd->bhqij', q_row, k_win).astype(jnp.float32) * scale
        logits = logits + bias[None]
        p = jax.nn.softmax(logits.reshape(b, h, GRID_W, kh * NA_KW), axis=-1)
        p = p.reshape(b, h, GRID_W, kh, NA_KW).astype(v.dtype)
        return jnp.einsum('bhqij,biqjhd->bqhd', p, v_win)

    out = lax.map(row_block, jnp.arange(rows))
    return jnp.transpose(out, (1, 0, 2, 3, 4)).reshape(b, s, h * d)


def sliding_window_gqa(q, k, v, sinks):
    b, s, hq, d = q.shape
    hkv = k.shape[2]
    g = hq // hkv
    nb = s // SWA_BLOCK
    qb = q.reshape(b, nb, SWA_BLOCK, hkv, g, d)

    def band(t):
        tp = jnp.pad(t, ((0, 0), (SWA_BLOCK, SWA_BLOCK), (0, 0), (0, 0)))
        tb = tp.reshape(b, nb + 2, SWA_BLOCK, hkv, d)
        return jnp.concatenate([tb[:, :-2], tb[:, 1:-1], tb[:, 2:]], axis=2)

    kb, vb = band(k), band(v)
    q_off = jnp.arange(SWA_BLOCK)
    k_off = jnp.arange(3 * SWA_BLOCK) - SWA_BLOCK
    in_window = jnp.abs(k_off[None, :] - q_off[:, None]) <= SWA_WINDOW
    k_abs = jnp.arange(nb)[:, None] * SWA_BLOCK + k_off[None, :]
    k_valid = (k_abs >= 0) & (k_abs < s)
    mask = in_window[None] & k_valid[:, None, :]
    logits = jnp.einsum('bnqhgd,bnkhd->bnhgqk', qb, kb).astype(jnp.float32) * (d ** -0.5)
    logits = jnp.where(mask[None, :, None, None], logits, NEG_INF)
    sink = jnp.broadcast_to(sinks.astype(jnp.float32).reshape(hkv, g)[None, None, :, :, None, None],
                            logits.shape[:-1] + (1,))
    p = jax.nn.softmax(jnp.concatenate([logits, sink], axis=-1), axis=-1)[..., :-1]
    out = jnp.einsum('bnhgqk,bnkhd->bnqhgd', p.astype(v.dtype), vb)
    return out.reshape(b, s, hq * d)


def hierarchical_moe(h, w_group_router, w_expert_router, w_gate, w_up, w_down):
    b, s, d = h.shape
    n = b * s
    t = h.reshape(n, d)
    g_logits = (t @ w_group_router).astype(jnp.float32)
    g_probs = jax.nn.softmax(g_logits, axis=-1)
    g_top = jnp.argmax(g_logits, axis=-1)
    g_weight = jnp.take_along_axis(g_probs, g_top[:, None], axis=-1)
    e_logits = jnp.einsum('nd,gde->nge', t, w_expert_router).astype(jnp.float32)
    e_in = jnp.take_along_axis(e_logits, g_top[:, None, None], axis=1)[:, 0]
    top_vals, top_idx = lax.top_k(e_in, TOP_K_IN_GROUP)
    top_w = jax.nn.softmax(top_vals, axis=-1) * g_weight
    expert_id = g_top[:, None] * EXPERTS_PER_GROUP + top_idx
    gates = jnp.sum(jax.nn.one_hot(expert_id, N_EXPERTS, dtype=jnp.float32) * top_w[..., None], axis=1)
    y = jnp.zeros((n, d), jnp.float32)
    for e in range(N_EXPERTS):
        he = jax.nn.silu(t @ w_gate[e]) * (t @ w_up[e])
        y = y + gates[:, e:e + 1] * (he @ w_down[e]).astype(jnp.float32)
    return y.astype(h.dtype).reshape(b, s, d)


def setup_inputs(seed: int = 0) -> dict:
    key = jax.random.key(seed)
    ks = jax.random.split(key, 20)
    f32 = jnp.float32
    nrm = lambda k, shape, sc: jax.random.normal(k, shape, f32) * sc
    return {
        "x": nrm(ks[0], (BATCH, SEQ, D_MODEL), 1.0),
        "c": nrm(ks[1], (BATCH, D_MODEL), 1.0),
        "w_ada": nrm(ks[2], (DEPTH, D_MODEL, N_MOD * D_MODEL), 0.5 * D_MODEL ** -0.5),
        "b_ada": nrm(ks[3], (DEPTH, N_MOD * D_MODEL), 0.01),
        "g_pre_mix": 1.0 + nrm(ks[4], (DEPTH, D_MODEL), 0.02),
        "w_in": nrm(ks[5], (DEPTH, D_MODEL, QKV_WIDTH), D_MODEL ** -0.5),
        "na_rpb": nrm(ks[6], (DEPTH, NA_HEADS, 2 * NA_KH_MAX - 1, 2 * NA_KW - 1), 0.1),
        "swa_sinks": nrm(ks[7], (DEPTH, SWA_HEADS), 1.0),
        "beta_na": 1.0 + nrm(ks[8], (DEPTH, NA_WIDTH), 0.02),
        "beta_swa": 1.0 + nrm(ks[9], (DEPTH, SWA_WIDTH), 0.02),
        "w_out": nrm(ks[10], (DEPTH, MIX_WIDTH, D_MODEL), MIX_WIDTH ** -0.5),
        "g_post_mix": 1.0 + nrm(ks[11], (DEPTH, D_MODEL), 0.02),
        "g_pre_ffn": 1.0 + nrm(ks[12], (DEPTH, D_MODEL), 0.02),
        "w_group_router": nrm(ks[13], (DEPTH, D_MODEL, N_GROUPS), D_MODEL ** -0.5),
        "w_expert_router": nrm(ks[14], (DEPTH, N_GROUPS, D_MODEL, EXPERTS_PER_GROUP), D_MODEL ** -0.5),
        "w_gate": nrm(ks[15], (DEPTH, N_EXPERTS, D_MODEL, EXPERT_FF), D_MODEL ** -0.5),
        "w_up": nrm(ks[16], (DEPTH, N_EXPERTS, D_MODEL, EXPERT_FF), D_MODEL ** -0.5),
        "w_down": nrm(ks[17], (DEPTH, N_EXPERTS, EXPERT_FF, D_MODEL), EXPERT_FF ** -0.5),
        "g_post_ffn": 1.0 + nrm(ks[18], (DEPTH, D_MODEL), 0.02),
    }


def reference(x, c, w_ada, b_ada, g_pre_mix, w_in, na_rpb, swa_sinks, beta_na, beta_swa,
              w_out, g_post_mix, g_pre_ffn, w_group_router, w_expert_router, w_gate, w_up,
              w_down, g_post_ffn):
    b, s, d = x.shape
    pos = jnp.arange(s)
    o_nq, o_nk, o_nv = 0, NA_WIDTH, 2 * NA_WIDTH
    o_sq = 3 * NA_WIDTH
    o_sk = o_sq + SWA_WIDTH
    o_sv = o_sk + SWA_KV_WIDTH
    for l in range(DEPTH):
        mod = (jax.nn.silu(c) @ w_ada[l] + b_ada[l]).reshape(b, N_MOD, d)
        shift_a, scale_a, gate_a = mod[:, 0, None], mod[:, 1, None], mod[:, 2, None]
        shift_f, scale_f, gate_f = mod[:, 3, None], mod[:, 4, None], mod[:, 5, None]

        h = rmsnorm(x, g_pre_mix[l]) * (1.0 + scale_a) + shift_a
        qkv = h @ w_in[l]
        na_q = qkv[..., o_nq:o_nk].reshape(b, s, NA_HEADS, HEAD_DIM)
        na_k = qkv[..., o_nk:o_nv].reshape(b, s, NA_HEADS, HEAD_DIM)
        na_v = qkv[..., o_nv:o_sq].reshape(b, s, NA_HEADS, HEAD_DIM)
        sw_q = rope(qkv[..., o_sq:o_sk].reshape(b, s, SWA_HEADS, HEAD_DIM), pos)
        sw_k = rope(qkv[..., o_sk:o_sv].reshape(b, s, SWA_KV_HEADS, HEAD_DIM), pos)
        sw_v = qkv[..., o_sv:].reshape(b, s, SWA_KV_HEADS, HEAD_DIM)
        na_out = rmsnorm(neighborhood_attention(na_q, na_k, na_v, na_rpb[l]), beta_na[l])
        sw_out = rmsnorm(sliding_window_gqa(sw_q, sw_k, sw_v, swa_sinks[l]), beta_swa[l])
        mix = jnp.concatenate([na_out, sw_out], axis=-1) @ w_out[l]
        x = x + gate_a * rmsnorm(mix, g_post_mix[l])

        h = rmsnorm(x, g_pre_ffn[l]) * (1.0 + scale_f) + shift_f
        y = hierarchical_moe(h, w_group_router[l], w_expert_router[l], w_gate[l], w_up[l], w_down[l])
        x = x + gate_f * rmsnorm(y, g_post_ffn[l])
    return x
```

```cpp
#include <hip/hip_runtime.h>
#include <hip/hip_cooperative_groups.h>
#include <stdint.h>
#include <stdio.h>
namespace cg = cooperative_groups;

#ifndef NAIVE_GEMM
#define NAIVE_GEMM 0
#endif
#ifndef NAIVE_ATTN
#define NAIVE_ATTN 0
#endif
#ifndef N_LAUNCH_MODE
#define N_LAUNCH_MODE 0
#endif

#define DEVINL __device__ __forceinline__

typedef unsigned short bf16_t;
typedef short bf16x8 __attribute__((ext_vector_type(8)));
typedef float f32x4 __attribute__((ext_vector_type(4)));
typedef unsigned u32x4 __attribute__((ext_vector_type(4)));
typedef unsigned u32x2 __attribute__((ext_vector_type(2)));

constexpr int SEQ = 8192, DM = 1024, NT = 2 * SEQ;
constexpr int QKVW = 2304;
constexpr float EPS = 1e-6f;
constexpr float LOG2E = 1.4426950408889634f;
constexpr float QSCALE = 0.125f * LOG2E;

constexpr size_t MiB = 1u << 20;
constexpr size_t WS_CNT  = 0;
constexpr size_t WS_MOD  = 1 * MiB;
constexpr size_t WS_ROPE = 2 * MiB;
constexpr size_t WS_WQKV = 4 * MiB;
constexpr size_t WS_WOUT = 9 * MiB;
constexpr size_t WS_WGU  = 11 * MiB;
constexpr size_t WS_WD   = 43 * MiB;
constexpr size_t WS_H    = 59 * MiB;
constexpr size_t WS_NAQ  = 91 * MiB;
constexpr size_t WS_NAK  = 107 * MiB;
constexpr size_t WS_NAVT = 123 * MiB;
constexpr size_t WS_SWQ  = 139 * MiB;
constexpr size_t WS_SWK  = 155 * MiB;
constexpr size_t WS_SWVT = 159 * MiB;
constexpr size_t WS_ATT  = 163 * MiB;
constexpr size_t WS_SSQ  = 195 * MiB;
constexpr size_t WS_LTOK = 196 * MiB;
constexpr size_t WS_LW   = 198 * MiB;
constexpr size_t WS_HID  = 200 * MiB;
constexpr size_t WS_Y    = 91 * MiB;
constexpr size_t WS_END  = 218 * MiB;

constexpr int LDS_BYTES = 65536 + 4096;

struct Params {
    const float *x, *c, *w_ada, *b_ada, *g_pre_mix, *w_in, *na_rpb, *swa_sinks, *beta_na, *beta_swa, *w_out, *g_post_mix, *g_pre_ffn,
                *w_gr, *w_er, *w_gate, *w_up, *w_down, *g_post_ffn;
    float* out; unsigned char* ws; int ph_lo, ph_hi;
};

DEVINL unsigned f2bf(float f) { unsigned u = __float_as_uint(f); return (u + 0x7fffu + ((u >> 16) & 1u)) >> 16; }
DEVINL unsigned pk2(float lo, float hi) { return f2bf(lo) | (f2bf(hi) << 16); }
DEVINL float bf2f(bf16_t v) { return __uint_as_float(((unsigned)v) << 16); }
DEVINL float bflo(unsigned u) { return __uint_as_float(u << 16); }
DEVINL float bfhi(unsigned u) { return __uint_as_float(u & 0xffff0000u); }
DEVINL float wave_sum(float v) {
#pragma unroll
    for (int o = 32; o >= 1; o >>= 1) v += __shfl_xor(v, o);
    return v;
}
DEVINL float silu_f(float v) { return v / (1.f + expf(-v)); }

DEVINL void mod_item(const Params& P, int item, unsigned char* smem) {
    float* s_silu = (float*)smem;
    float* s_red  = s_silu + 2048;
    const int t = threadIdx.x;
    for (int i = t; i < 2048; i += 256) s_silu[i] = silu_f(P.c[i]);
    __syncthreads();
    const int c4 = t & 7, rg = t >> 3, col = item * 32 + c4 * 4;
    f32x4 a0 = {0.f, 0.f, 0.f, 0.f}, a1 = {0.f, 0.f, 0.f, 0.f};
#pragma unroll 4
    for (int i = 0; i < 32; ++i) {
        const int k = rg + 32 * i;
        const f32x4 w = *(const f32x4*)(P.w_ada + (size_t)k * 6144 + col);
        a0 += w * s_silu[k]; a1 += w * s_silu[1024 + k];
    }
    *(f32x4*)(s_red + (rg * 2 + 0) * 32 + c4 * 4) = a0;
    *(f32x4*)(s_red + (rg * 2 + 1) * 32 + c4 * 4) = a1;
    __syncthreads();
    if (t < 64) {
        const int b = t >> 5, cc = t & 31; float s = 0.f;
        for (int r = 0; r < 32; ++r) s += s_red[(r * 2 + b) * 32 + cc];
        ((float*)(P.ws + WS_MOD))[b * 6144 + item * 32 + cc] = s + P.b_ada[item * 32 + cc];
    }
    __syncthreads();
}
DEVINL void transpose_item(const float* src, int N, int k0, int n0, bf16_t* dst, int ldd, int mode, const float* kscale, unsigned char* smem) {
    float* scr = (float*)smem;
    const int t = threadIdx.x;
#pragma unroll
    for (int p = 0; p < 4; ++p) {
        const int r = (t >> 4) + 16 * p;
        f32x4 v = *(const f32x4*)(src + (size_t)(k0 + r) * N + n0 + (t & 15) * 4);
        const float sc = kscale ? kscale[r] : 1.f;
        float* d = scr + r * 65 + (t & 15) * 4;
        d[0] = v.x * sc; d[1] = v.y * sc; d[2] = v.z * sc; d[3] = v.w * sc;
    }
    __syncthreads();
    const int n = t >> 2, kq = t & 3;
    u32x4 w0, w1;
    const float* s = scr + (kq * 16) * 65 + n;
    w0.x = pk2(s[0 * 65], s[1 * 65]);   w0.y = pk2(s[2 * 65], s[3 * 65]);   w0.z = pk2(s[4 * 65], s[5 * 65]);   w0.w = pk2(s[6 * 65], s[7 * 65]);
    w1.x = pk2(s[8 * 65], s[9 * 65]);   w1.y = pk2(s[10 * 65], s[11 * 65]); w1.z = pk2(s[12 * 65], s[13 * 65]); w1.w = pk2(s[14 * 65], s[15 * 65]);
    const int j = n0 + n;
    int drow = j;
    if (mode == 1) drow = (j >> 4) * 32 + (j & 15);
    if (mode == 2) drow = (j >> 4) * 32 + 16 + (j & 15);
    bf16_t* o = dst + (size_t)drow * ldd + k0 + kq * 16;
    *(u32x4*)o = w0; *(u32x4*)(o + 8) = w1;
    __syncthreads();
}
DEVINL void phase0(const Params& P, unsigned char* smem) {
    const int t = threadIdx.x;
    if (blockIdx.x == 0 && t < 64) ((unsigned*)(P.ws + WS_CNT))[t] = 0u;
    {
        float* rc = (float*)(P.ws + WS_ROPE); float* rs = rc + SEQ * 32;
        for (int i = blockIdx.x * 256 + t; i < SEQ * 32; i += gridDim.x * 256) {
            const int pos = i >> 5, fi = i & 31;
            const float ex = -((float)fi * 2.0f) / 64.0f;
            const float inv = exp2f(ex * 13.287712379549449f);
            const float ang = (float)pos * inv;
            double tt = (double)ang * 0.15915494309189535; tt -= floor(tt);
            const float fr = (float)tt;
            rc[i] = __builtin_amdgcn_cosf(fr); rs[i] = __builtin_amdgcn_sinf(fr);
        }
    }
    bf16_t* Wqkv = (bf16_t*)(P.ws + WS_WQKV); bf16_t* Wout = (bf16_t*)(P.ws + WS_WOUT);
    bf16_t* Wgu = (bf16_t*)(P.ws + WS_WGU);   bf16_t* Wd = (bf16_t*)(P.ws + WS_WD);
    constexpr int NMOD = 192, NI_IN = 16 * 36, NI_OUT = 256, NI_E = 2048;
    constexpr int total = NMOD + NI_IN + NI_OUT + 3 * NI_E;
    for (int it = blockIdx.x; it < total; it += gridDim.x) {
        int r = it;
        if (r < NMOD) { mod_item(P, r, smem); continue; } r -= NMOD;
        if (r < NI_IN) { const int kb = r / 36, nb = r % 36; transpose_item(P.w_in, QKVW, kb * 64, nb * 64, Wqkv, 1024, 0, nullptr, smem); continue; } r -= NI_IN;
        if (r < NI_OUT) { const int kb = r >> 4, nb = r & 15; const int k0 = kb * 64;
            const float* ks = (k0 < 512) ? (P.beta_na + k0) : (P.beta_swa + (k0 - 512));
            transpose_item(P.w_out, 1024, k0, nb * 64, Wout, 1024, 0, ks, smem); continue; } r -= NI_OUT;
        if (r < NI_E) { const int e = r >> 6, q = r & 63, kb = q >> 2, nb = q & 3;
            transpose_item(P.w_gate + (size_t)e * 1024 * 256, 256, kb * 64, nb * 64, Wgu + (size_t)e * 512 * 1024, 1024, 1, nullptr, smem); continue; } r -= NI_E;
        if (r < NI_E) { const int e = r >> 6, q = r & 63, kb = q >> 2, nb = q & 3;
            transpose_item(P.w_up + (size_t)e * 1024 * 256, 256, kb * 64, nb * 64, Wgu + (size_t)e * 512 * 1024, 1024, 2, nullptr, smem); continue; } r -= NI_E;
        { const int e = r >> 6, q = r & 63, kb = q >> 4, nb = q & 15;
            transpose_item(P.w_down + (size_t)e * 256 * 1024, 1024, kb * 64, nb * 64, Wd + (size_t)e * 1024 * 256, 256, 0, nullptr, smem); }
    }
}

DEVINL void phase1(const Params& P) {
    const int lane = threadIdx.x & 63, gw = blockIdx.x * 4 + (threadIdx.x >> 6), ngw = gridDim.x * 4;
    const float* mod = (const float*)(P.ws + WS_MOD);
    bf16_t* H = (bf16_t*)(P.ws + WS_H);
    for (int row = gw; row < NT; row += ngw) {
        const f32x4* xr = (const f32x4*)(P.x + (size_t)row * DM) + lane;
        f32x4 v[4]; float ss = 0.f;
#pragma unroll
        for (int j = 0; j < 4; ++j) { v[j] = xr[64 * j]; ss += v[j].x * v[j].x + v[j].y * v[j].y + v[j].z * v[j].z + v[j].w * v[j].w; }
        ss = wave_sum(ss);
        const float rstd = rsqrtf(ss * (1.f / DM) + EPS);
        const float* mb = mod + (row >> 13) * 6144;
#pragma unroll
        for (int j = 0; j < 4; ++j) {
            const int col = 4 * lane + 256 * j;
            const f32x4 g = *(const f32x4*)(P.g_pre_mix + col), sc = *(const f32x4*)(mb + 1024 + col), sh = *(const f32x4*)(mb + col);
            const f32x4 h = v[j] * rstd * g * (sc + 1.f) + sh;
            u32x2 o; o.x = pk2(h.x, h.y); o.y = pk2(h.z, h.w);
            *(u32x2*)(H + (size_t)row * DM + col) = o;
        }
    }
}

DEVINL int lds_off(int row, int chunk) { return row * 128 + ((chunk ^ ((row >> 1) & 7)) << 4); }

DEVINL void gemm_core(f32x4 (&acc)[4][4], const bf16_t* a0, const bf16_t* a1, const bf16_t* a2, const bf16_t* a3,
                      const bf16_t* b0, const bf16_t* b1, const bf16_t* b2, const bf16_t* b3, int kbeg, int kend, unsigned char* smem) {
    const int t = threadIdx.x, lane = t & 63, w = t >> 6, wm = w & 1, wn = w >> 1, lr = lane & 15, g = lane >> 4;
    const int ldrow = t >> 3, ldc = t & 7;
#if NAIVE_GEMM
    const bf16_t** sp = (const bf16_t**)(smem + 65536);
    __syncthreads();
    if (ldc == 0) { sp[ldrow] = a0; sp[ldrow + 32] = a1; sp[ldrow + 64] = a2; sp[ldrow + 96] = a3;
                    sp[128 + ldrow] = b0; sp[128 + ldrow + 32] = b1; sp[128 + ldrow + 64] = b2; sp[128 + ldrow + 96] = b3; }
    __syncthreads();
#pragma unroll
    for (int ni = 0; ni < 4; ++ni)
#pragma unroll
        for (int mi = 0; mi < 4; ++mi) {
            const bf16_t* ap = sp[64 * wm + 16 * mi + lr];
#pragma unroll
            for (int reg = 0; reg < 4; ++reg) {
                const bf16_t* bp = sp[128 + 64 * wn + 16 * ni + 4 * g + reg];
                float s = 0.f;
#pragma unroll 1
                for (int k = kbeg; k < kend; k += 8) {
                    const u32x4 av = *(const u32x4*)(ap + k), bv = *(const u32x4*)(bp + k);
                    s += bflo(av.x) * bflo(bv.x) + bfhi(av.x) * bfhi(bv.x) + bflo(av.y) * bflo(bv.y) + bfhi(av.y) * bfhi(bv.y)
                       + bflo(av.z) * bflo(bv.z) + bfhi(av.z) * bfhi(bv.z) + bflo(av.w) * bflo(bv.w) + bfhi(av.w) * bfhi(bv.w);
                }
                acc[ni][mi][reg] += s;
            }
        }
    __syncthreads();
#else
    u32x4 ra0, ra1, ra2, ra3, rb0, rb1, rb2, rb3;
    const int wo0 = lds_off(ldrow, ldc), wo1 = lds_off(ldrow + 32, ldc), wo2 = lds_off(ldrow + 64, ldc), wo3 = lds_off(ldrow + 96, ldc);
#define GLOAD(kk) do { const int ko_ = (kk) + ldc * 8; \
        ra0 = *(const u32x4*)(a0 + ko_); ra1 = *(const u32x4*)(a1 + ko_); ra2 = *(const u32x4*)(a2 + ko_); ra3 = *(const u32x4*)(a3 + ko_); \
        rb0 = *(const u32x4*)(b0 + ko_); rb1 = *(const u32x4*)(b1 + ko_); rb2 = *(const u32x4*)(b2 + ko_); rb3 = *(const u32x4*)(b3 + ko_); } while (0)
#define LWRITE(buf) do { unsigned char* a_ = smem + (buf) * 32768; unsigned char* b_ = a_ + 16384; \
        *(u32x4*)(a_ + wo0) = ra0; *(u32x4*)(a_ + wo1) = ra1; *(u32x4*)(a_ + wo2) = ra2; *(u32x4*)(a_ + wo3) = ra3; \
        *(u32x4*)(b_ + wo0) = rb0; *(u32x4*)(b_ + wo1) = rb1; *(u32x4*)(b_ + wo2) = rb2; *(u32x4*)(b_ + wo3) = rb3; } while (0)
    const int nk = (kend - kbeg) >> 6;
    __syncthreads();
    GLOAD(kbeg); LWRITE(0); __syncthreads();
    for (int kt = 0; kt < nk; ++kt) {
        if (kt + 1 < nk) GLOAD(kbeg + (kt + 1) * 64);
        const unsigned char* a_ = smem + (kt & 1) * 32768; const unsigned char* b_ = a_ + 16384;
#pragma unroll
        for (int ks = 0; ks < 2; ++ks) {
            bf16x8 fa[4], fb[4];
#pragma unroll
            for (int i = 0; i < 4; ++i) { fa[i] = *(const bf16x8*)(a_ + lds_off(64 * wm + 16 * i + lr, ks * 4 + g)); fb[i] = *(const bf16x8*)(b_ + lds_off(64 * wn + 16 * i + lr, ks * 4 + g)); }
#pragma unroll
            for (int ni = 0; ni < 4; ++ni)
#pragma unroll
                for (int mi = 0; mi < 4; ++mi) acc[ni][mi] = __builtin_amdgcn_mfma_f32_16x16x32_bf16(fb[ni], fa[mi], acc[ni][mi], 0, 0, 0);
        }
        if (kt + 1 < nk) LWRITE((kt + 1) & 1);
        __syncthreads();
    }
#undef GLOAD
#undef LWRITE
#endif
}
DEVINL void zero_acc(f32x4 (&acc)[4][4]) {
#pragma unroll
    for (int i = 0; i < 4; ++i)
#pragma unroll
        for (int j = 0; j < 4; ++j) acc[i][j] = (f32x4){0.f, 0.f, 0.f, 0.f};
}

DEVINL void phase2(const Params& P, unsigned char* smem) {
    const int t = threadIdx.x, lane = t & 63, w = t >> 6, wm = w & 1, wn = w >> 1, lr = lane & 15, g = lane >> 4, ldrow = t >> 3;
    const bf16_t* H = (const bf16_t*)(P.ws + WS_H); const bf16_t* Wt = (const bf16_t*)(P.ws + WS_WQKV);
    const float* rc = (const float*)(P.ws + WS_ROPE); const float* rs = rc + SEQ * 32;
    constexpr int TN = QKVW / 128, TM = NT / 128;
    for (int it = blockIdx.x; it < TN * TM; it += gridDim.x) {
        const int tm = it / TN, tn = it % TN, m0 = tm * 128, n0 = tn * 128;
        const bf16_t* ab = H + (size_t)(m0 + ldrow) * DM; const bf16_t* bb = Wt + (size_t)(n0 + ldrow) * DM;
        f32x4 acc[4][4]; zero_acc(acc);
        gemm_core(acc, ab, ab + 32 * DM, ab + 64 * DM, ab + 96 * DM, bb, bb + 32 * DM, bb + 64 * DM, bb + 96 * DM, 0, DM, smem);
        const int nW = n0 + 64 * wn;
        int region, hh;
        if (nW < 512) { region = 0; hh = nW >> 6; } else if (nW < 1024) { region = 1; hh = (nW - 512) >> 6; } else if (nW < 1536) { region = 2; hh = (nW - 1024) >> 6; }
        else if (nW < 2048) { region = 3; hh = (nW - 1536) >> 6; } else if (nW < 2176) { region = 4; hh = (nW - 2048) >> 6; } else { region = 5; hh = (nW - 2176) >> 6; }
#pragma unroll
        for (int mi = 0; mi < 4; ++mi) {
            const int m = m0 + 64 * wm + 16 * mi + lr, b = m >> 13, s = m & (SEQ - 1);
            f32x4 v[4];
#pragma unroll
            for (int ni = 0; ni < 4; ++ni) v[ni] = acc[ni][mi];
            if (region == 3 || region == 4) {
#pragma unroll
                for (int ni = 0; ni < 2; ++ni) {
                    const f32x4 cs = *(const f32x4*)(rc + s * 32 + 16 * ni + 4 * g), sn = *(const f32x4*)(rs + s * 32 + 16 * ni + 4 * g);
                    const f32x4 x1 = v[ni], x2 = v[ni + 2];
                    v[ni] = x1 * cs - x2 * sn; v[ni + 2] = x2 * cs + x1 * sn;
                }
            }
            if (region == 0 || region == 3) {
#pragma unroll
                for (int ni = 0; ni < 4; ++ni) v[ni] = v[ni] * QSCALE;
            }
            if (region == 2 || region == 5) {
                bf16_t* base = (bf16_t*)(P.ws + (region == 2 ? WS_NAVT : WS_SWVT)) + ((size_t)(b * (region == 2 ? 8 : 2) + hh) * 64) * SEQ + s;
#pragma unroll
                for (int ni = 0; ni < 4; ++ni) {
                    const int d = 16 * ni + 4 * g;
                    base[(size_t)(d + 0) * SEQ] = (bf16_t)f2bf(v[ni].x); base[(size_t)(d + 1) * SEQ] = (bf16_t)f2bf(v[ni].y);
                    base[(size_t)(d + 2) * SEQ] = (bf16_t)f2bf(v[ni].z); base[(size_t)(d + 3) * SEQ] = (bf16_t)f2bf(v[ni].w);
                }
            } else {
                const size_t off = region == 0 ? WS_NAQ : region == 1 ? WS_NAK : region == 3 ? WS_SWQ : WS_SWK;
                const int nh = (region == 4) ? 2 : 8;
                bf16_t* base = (bf16_t*)(P.ws + off) + ((size_t)(b * nh + hh) * SEQ + s) * 64;
#pragma unroll
                for (int ni = 0; ni < 4; ++ni) { u32x2 o; o.x = pk2(v[ni].x, v[ni].y); o.y = pk2(v[ni].z, v[ni].w); *(u32x2*)(base + 16 * ni + 4 * g) = o; }
            }
        }
    }
}

#if NAIVE_ATTN
DEVINL void phase3(const Params& P, unsigned char* smem) {
    const int lane = threadIdx.x & 63, gw = blockIdx.x * 4 + (threadIdx.x >> 6), ngw = gridDim.x * 4;
    bf16_t* ATT = (bf16_t*)(P.ws + WS_ATT); float* SSQ = (float*)(P.ws + WS_SSQ);
    for (int it = gw; it < NT * 16; it += ngw) {
        const int isw = it >= NT * 8; const int r = isw ? it - NT * 8 : it;
        const int tok = r >> 3, h = r & 7, b = tok >> 13, s = tok & (SEQ - 1);
        float m = -3.0e38f, sum = 0.f, o = 0.f;
        if (!isw) {
            const bf16_t* Q = (const bf16_t*)(P.ws + WS_NAQ) + ((size_t)(b * 8 + h) * SEQ) * 64;
            const bf16_t* K = (const bf16_t*)(P.ws + WS_NAK) + ((size_t)(b * 8 + h) * SEQ) * 64;
            const bf16_t* VT = (const bf16_t*)(P.ws + WS_NAVT) + ((size_t)(b * 8 + h) * 64) * SEQ;
            const float q = bf2f(Q[(size_t)s * 64 + lane]);
            const int row = s >> 6, col = s & 63;
            int r0 = row - 4; r0 = r0 < 0 ? 0 : (r0 > 120 ? 120 : r0);
            int cs = col - 8; cs = cs < 0 ? 0 : (cs > 48 ? 48 : cs);
            const float* rpb = P.na_rpb + h * 15 * 31;
            for (int pass = 0; pass < 2; ++pass)
                for (int i = 0; i < 8; ++i)
                    for (int j = 0; j < 16; ++j) {
                        const int key = (r0 + i) * 64 + cs + j;
                        float d = wave_sum(q * bf2f(K[(size_t)key * 64 + lane]));
                        d += rpb[(r0 + i - row + 7) * 31 + (cs + j - col + 15)] * LOG2E;
                        if (pass == 0) m = fmaxf(m, d);
                        else { const float p = exp2f(d - m); sum += p; o += p * bf2f(VT[(size_t)lane * SEQ + key]); }
                    }
        } else {
            const int kvh = h >> 2;
            const bf16_t* Q = (const bf16_t*)(P.ws + WS_SWQ) + ((size_t)(b * 8 + h) * SEQ) * 64;
            const bf16_t* K = (const bf16_t*)(P.ws + WS_SWK) + ((size_t)(b * 2 + kvh) * SEQ) * 64;
            const bf16_t* VT = (const bf16_t*)(P.ws + WS_SWVT) + ((size_t)(b * 2 + kvh) * 64) * SEQ;
            const float q = bf2f(Q[(size_t)s * 64 + lane]);
            const int klo = s - 128 < 0 ? 0 : s - 128, khi = s + 128 > SEQ - 1 ? SEQ - 1 : s + 128;
            const float sk = P.swa_sinks[h] * LOG2E;
            m = sk;
            for (int pass = 0; pass < 2; ++pass)
                for (int key = klo; key <= khi; ++key) {
                    const float d = wave_sum(q * bf2f(K[(size_t)key * 64 + lane]));
                    if (pass == 0) m = fmaxf(m, d);
                    else { const float p = exp2f(d - m); sum += p; o += p * bf2f(VT[(size_t)lane * SEQ + key]); }
                }
            sum += exp2f(sk - m);
        }
        o /= sum;
        ATT[(size_t)tok * DM + (isw ? 512 : 0) + h * 64 + lane] = (bf16_t)f2bf(o);
        const float sq = wave_sum(o * o);
        if (lane == 0) SSQ[tok * 16 + (isw ? 8 : 0) + h] = sq;
    }
}
#else
DEVINL void phase3(const Params& P, unsigned char* smem) {
    const int t = threadIdx.x, lane = t & 63, w = t >> 6, lr = lane & 15, g = lane >> 4;
    bf16_t* ATT = (bf16_t*)(P.ws + WS_ATT); float* SSQ = (float*)(P.ws + WS_SSQ);
    float* s_rpb = (float*)smem;
    for (int i = t; i < 8 * 465; i += 256) s_rpb[i] = P.na_rpb[i] * LOG2E;
    __syncthreads();
    constexpr int N_NA = 2 * 8 * 128, N_SW = 2 * 2 * 512;
    for (int it = blockIdx.x; it < N_NA + N_SW; it += gridDim.x) {
        if (it < N_NA) {
            const int r = it & 127, h = (it >> 7) & 7, b = it >> 10;
            const int c0 = 16 * w;
            int r0 = r - 4; r0 = r0 < 0 ? 0 : (r0 > 120 ? 120 : r0);
            int kc0 = c0 - 8; kc0 = kc0 < 0 ? 0 : (kc0 > 32 ? 32 : kc0);
            const bf16_t* Q = (const bf16_t*)(P.ws + WS_NAQ) + ((size_t)(b * 8 + h) * SEQ) * 64;
            const bf16_t* K = (const bf16_t*)(P.ws + WS_NAK) + ((size_t)(b * 8 + h) * SEQ) * 64;
            const bf16_t* VT = (const bf16_t*)(P.ws + WS_NAVT) + ((size_t)(b * 8 + h) * 64) * SEQ;
            const bf16_t* qp = Q + (size_t)(r * 64 + c0 + lr) * 64 + 8 * g;
            const bf16x8 q0 = *(const bf16x8*)qp, q1 = *(const bf16x8*)(qp + 32);
            f32x4 sc[16];
#pragma unroll
            for (int tt = 0; tt < 16; ++tt) {
                const bf16_t* kp = K + (size_t)((r0 + (tt >> 1)) * 64 + kc0 + (tt & 1) * 16 + lr) * 64 + 8 * g;
                const bf16x8 k0 = *(const bf16x8*)kp, k1 = *(const bf16x8*)(kp + 32);
                f32x4 a = {0.f, 0.f, 0.f, 0.f};
                a = __builtin_amdgcn_mfma_f32_16x16x32_bf16(k0, q0, a, 0, 0, 0);
                a = __builtin_amdgcn_mfma_f32_16x16x32_bf16(k1, q1, a, 0, 0, 0);
                sc[tt] = a;
            }
            const int c = c0 + lr; int cs = c - 8; cs = cs < 0 ? 0 : (cs > 48 ? 48 : cs);
            const float* rp = s_rpb + h * 465;
            float mx = -3.0e38f;
#pragma unroll
            for (int tt = 0; tt < 16; ++tt) {
                const int dr = r0 + (tt >> 1) - r + 7;
#pragma unroll
                for (int e = 0; e < 4; ++e) {
                    const int kc = kc0 + (tt & 1) * 16 + 4 * g + e;
                    const bool ok = (kc >= cs) && (kc < cs + 16);
                    int dc = kc - c + 15; dc = dc < 0 ? 0 : (dc > 30 ? 30 : dc);
                    const float v = ok ? sc[tt][e] + rp[dr * 31 + dc] : -3.0e38f;
                    sc[tt][e] = v; mx = fmaxf(mx, v);
                }
            }
            mx = fmaxf(mx, __shfl_xor(mx, 16)); mx = fmaxf(mx, __shfl_xor(mx, 32));
            float sum = 0.f;
#pragma unroll
            for (int tt = 0; tt < 16; ++tt)
#pragma unroll
                for (int e = 0; e < 4; ++e) { const float p = exp2f(sc[tt][e] - mx); sc[tt][e] = p; sum += p; }
            sum += __shfl_xor(sum, 16); sum += __shfl_xor(sum, 32);
            f32x4 o[4];
#pragma unroll
            for (int dt = 0; dt < 4; ++dt) o[dt] = (f32x4){0.f, 0.f, 0.f, 0.f};
#pragma unroll
            for (int kk = 0; kk < 8; ++kk) {
                union { bf16x8 v; unsigned u[4]; } pf;
                pf.u[0] = pk2(sc[2 * kk][0], sc[2 * kk][1]); pf.u[1] = pk2(sc[2 * kk][2], sc[2 * kk][3]);
                pf.u[2] = pk2(sc[2 * kk + 1][0], sc[2 * kk + 1][1]); pf.u[3] = pk2(sc[2 * kk + 1][2], sc[2 * kk + 1][3]);
                const int key0 = (r0 + kk) * 64 + kc0 + 4 * g;
#pragma unroll
                for (int dt = 0; dt < 4; ++dt) {
                    const bf16_t* vp = VT + (size_t)(16 * dt + lr) * SEQ + key0;
                    union { bf16x8 v; u32x2 h[2]; } vf;
                    vf.h[0] = *(const u32x2*)vp; vf.h[1] = *(const u32x2*)(vp + 16);
                    o[dt] = __builtin_amdgcn_mfma_f32_16x16x32_bf16(vf.v, pf.v, o[dt], 0, 0, 0);
                }
            }
            const float inv = 1.f / sum; float sq = 0.f;
            const int tok = b * SEQ + r * 64 + c0 + lr;
#pragma unroll
            for (int dt = 0; dt < 4; ++dt) {
                const f32x4 v = o[dt] * inv; sq += v.x * v.x + v.y * v.y + v.z * v.z + v.w * v.w;
                u32x2 ov; ov.x = pk2(v.x, v.y); ov.y = pk2(v.z, v.w);
                *(u32x2*)(ATT + (size_t)tok * DM + h * 64 + 16 * dt + 4 * g) = ov;
            }
            sq += __shfl_xor(sq, 16); sq += __shfl_xor(sq, 32);
            if (g == 0) SSQ[tok * 16 + h] = sq;
        } else {
            const int r = it - N_NA, qt = r & 511, kvh = (r >> 9) & 1, b = r >> 10;
            const int hq = kvh * 4 + w, q0p = qt * 16, kb = q0p - 128;
            const bf16_t* Q = (const bf16_t*)(P.ws + WS_SWQ) + ((size_t)(b * 8 + hq) * SEQ) * 64;
            const bf16_t* K = (const bf16_t*)(P.ws + WS_SWK) + ((size_t)(b * 2 + kvh) * SEQ) * 64;
            const bf16_t* VT = (const bf16_t*)(P.ws + WS_SWVT) + ((size_t)(b * 2 + kvh) * 64) * SEQ;
            const bf16_t* qp = Q + (size_t)(q0p + lr) * 64 + 8 * g;
            const bf16x8 q0 = *(const bf16x8*)qp, q1 = *(const bf16x8*)(qp + 32);
            f32x4 sc[18];
            const float sk = P.swa_sinks[hq] * LOG2E;
            float mx = sk;
#pragma unroll
            for (int tt = 0; tt < 18; ++tt) {
                const int kt0 = kb + 16 * tt;
                f32x4 a = {0.f, 0.f, 0.f, 0.f};
                const bool tile_ok = (tt < 17) && (kt0 >= 0) && (kt0 < SEQ);
                if (tile_ok) {
                    const bf16_t* kp = K + (size_t)(kt0 + lr) * 64 + 8 * g;
                    const bf16x8 k0 = *(const bf16x8*)kp, k1 = *(const bf16x8*)(kp + 32);
                    a = __builtin_amdgcn_mfma_f32_16x16x32_bf16(k0, q0, a, 0, 0, 0);
                    a = __builtin_amdgcn_mfma_f32_16x16x32_bf16(k1, q1, a, 0, 0, 0);
                }
#pragma unroll
                for (int e = 0; e < 4; ++e) {
                    const int dlt = 16 * tt + 4 * g + e - lr;
                    const bool ok = tile_ok && dlt >= 0 && dlt <= 256;
                    const float v = ok ? a[e] : -3.0e38f;
                    a[e] = v; mx = fmaxf(mx, v);
                }
                sc[tt] = a;
            }
            mx = fmaxf(mx, __shfl_xor(mx, 16)); mx = fmaxf(mx, __shfl_xor(mx, 32));
            float sum = 0.f;
#pragma unroll
            for (int tt = 0; tt < 18; ++tt)
#pragma unroll
                for (int e = 0; e < 4; ++e) { const float p = exp2f(sc[tt][e] - mx); sc[tt][e] = p; sum += p; }
            sum += __shfl_xor(sum, 16); sum += __shfl_xor(sum, 32);
            sum += exp2f(sk - mx);
            f32x4 o[4];
#pragma unroll
            for (int dt = 0; dt < 4; ++dt) o[dt] = (f32x4){0.f, 0.f, 0.f, 0.f};
#pragma unroll
            for (int kk = 0; kk < 9; ++kk) {
                union { bf16x8 v; unsigned u[4]; } pf;
                pf.u[0] = pk2(sc[2 * kk][0], sc[2 * kk][1]); pf.u[1] = pk2(sc[2 * kk][2], sc[2 * kk][3]);
                pf.u[2] = pk2(sc[2 * kk + 1][0], sc[2 * kk + 1][1]); pf.u[3] = pk2(sc[2 * kk + 1][2], sc[2 * kk + 1][3]);
                const int key0 = kb + 32 * kk + 4 * g, key1 = key0 + 16;
                const bool ok0 = key0 >= 0 && key0 < SEQ, ok1 = (2 * kk + 1 < 17) && key1 >= 0 && key1 < SEQ;
#pragma unroll
                for (int dt = 0; dt < 4; ++dt) {
                    const bf16_t* vp = VT + (size_t)(16 * dt + lr) * SEQ;
                    union { bf16x8 v; u32x2 h[2]; } vf;
                    vf.h[0] = ok0 ? *(const u32x2*)(vp + key0) : (u32x2){0u, 0u};
                    vf.h[1] = ok1 ? *(const u32x2*)(vp + key1) : (u32x2){0u, 0u};
                    o[dt] = __builtin_amdgcn_mfma_f32_16x16x32_bf16(vf.v, pf.v, o[dt], 0, 0, 0);
                }
            }
            const float inv = 1.f / sum; float sq = 0.f;
            const int tok = b * SEQ + q0p + lr;
#pragma unroll
            for (int dt = 0; dt < 4; ++dt) {
                const f32x4 v = o[dt] * inv; sq += v.x * v.x + v.y * v.y + v.z * v.z + v.w * v.w;
                u32x2 ov; ov.x = pk2(v.x, v.y); ov.y = pk2(v.z, v.w);
                *(u32x2*)(ATT + (size_t)tok * DM + 512 + hq * 64 + 16 * dt + 4 * g) = ov;
            }
            sq += __shfl_xor(sq, 16); sq += __shfl_xor(sq, 32);
            if (g == 0) SSQ[tok * 16 + 8 + hq] = sq;
        }
    }
}
#endif

DEVINL void phase4a(const Params& P, unsigned char* smem) {
    const int t = threadIdx.x, lane = t & 63, w = t >> 6, wm = w & 1, wn = w >> 1, lr = lane & 15, g = lane >> 4, ldrow = t >> 3;
    const bf16_t* A = (const bf16_t*)(P.ws + WS_ATT); const bf16_t* Wt = (const bf16_t*)(P.ws + WS_WOUT);
    const float* SSQ = (const float*)(P.ws + WS_SSQ);
    bf16_t* MIX = (bf16_t*)(P.ws + WS_H);
    constexpr int TN = 8, TM = NT / 128;
    for (int it = blockIdx.x; it < TN * TM; it += gridDim.x) {
        const int tm = it / TN, tn = it % TN, m0 = tm * 128, n0 = tn * 128;
        const bf16_t* ab = A + (size_t)(m0 + ldrow) * DM; const bf16_t* bb = Wt + (size_t)(n0 + ldrow) * DM;
        float rna[4], rsw[4];
#pragma unroll
        for (int mi = 0; mi < 4; ++mi) {
            const float* sp = SSQ + (size_t)(m0 + 64 * wm + 16 * mi + lr) * 16;
            const f32x4 a = *(const f32x4*)sp, b2 = *(const f32x4*)(sp + 4), c2 = *(const f32x4*)(sp + 8), d2 = *(const f32x4*)(sp + 12);
            rna[mi] = rsqrtf((a.x + a.y + a.z + a.w + b2.x + b2.y + b2.z + b2.w) * (1.f / 512.f) + EPS);
            rsw[mi] = rsqrtf((c2.x + c2.y + c2.z + c2.w + d2.x + d2.y + d2.z + d2.w) * (1.f / 512.f) + EPS);
        }
        f32x4 acc[4][4]; zero_acc(acc);
        gemm_core(acc, ab, ab + 32 * DM, ab + 64 * DM, ab + 96 * DM, bb, bb + 32 * DM, bb + 64 * DM, bb + 96 * DM, 0, 512, smem);
#pragma unroll
        for (int mi = 0; mi < 4; ++mi) { const float f = rna[mi] / rsw[mi];
#pragma unroll
            for (int ni = 0; ni < 4; ++ni) acc[ni][mi] = acc[ni][mi] * f; }
        gemm_core(acc, ab, ab + 32 * DM, ab + 64 * DM, ab + 96 * DM, bb, bb + 32 * DM, bb + 64 * DM, bb + 96 * DM, 512, 1024, smem);
#pragma unroll
        for (int mi = 0; mi < 4; ++mi) {
            const int m = m0 + 64 * wm + 16 * mi + lr;
#pragma unroll
            for (int ni = 0; ni < 4; ++ni) {
                const f32x4 v = acc[ni][mi] * rsw[mi];
                u32x2 o; o.x = pk2(v.x, v.y); o.y = pk2(v.z, v.w);
                *(u32x2*)(MIX + (size_t)m * DM + n0 + 64 * wn + 16 * ni + 4 * g) = o;
            }
        }
    }
}

DEVINL void phase4b(const Params& P) {
    const int lane = threadIdx.x & 63, gw = blockIdx.x * 4 + (threadIdx.x >> 6), ngw = gridDim.x * 4;
    const float* mod = (const float*)(P.ws + WS_MOD);
    bf16_t* H = (bf16_t*)(P.ws + WS_H);
    unsigned* cnt = (unsigned*)(P.ws + WS_CNT);
    int* ltok = (int*)(P.ws + WS_LTOK); float* lw = (float*)(P.ws + WS_LW);
    for (int row = gw; row < NT; row += ngw) {
        const float* mb = mod + (row >> 13) * 6144;
        f32x4 mx[4]; float ss = 0.f;
#pragma unroll
        for (int j = 0; j < 4; ++j) {
            const u32x2 raw = *(const u32x2*)(H + (size_t)row * DM + 4 * lane + 256 * j);
            mx[j] = (f32x4){bflo(raw.x), bfhi(raw.x), bflo(raw.y), bfhi(raw.y)};
            ss += mx[j].x * mx[j].x + mx[j].y * mx[j].y + mx[j].z * mx[j].z + mx[j].w * mx[j].w;
        }
        ss = wave_sum(ss);
        const float rstd = rsqrtf(ss * (1.f / DM) + EPS);
        f32x4 x1[4]; float s1 = 0.f;
#pragma unroll
        for (int j = 0; j < 4; ++j) {
            const int col = 4 * lane + 256 * j;
            const f32x4 xv = *(const f32x4*)(P.x + (size_t)row * DM + col), gp = *(const f32x4*)(P.g_post_mix + col), ga = *(const f32x4*)(mb + 2048 + col);
            x1[j] = xv + ga * (mx[j] * rstd * gp);
            *(f32x4*)(P.out + (size_t)row * DM + col) = x1[j];
            s1 += x1[j].x * x1[j].x + x1[j].y * x1[j].y + x1[j].z * x1[j].z + x1[j].w * x1[j].w;
        }
        s1 = wave_sum(s1);
        const float rstd1 = rsqrtf(s1 * (1.f / DM) + EPS);
        f32x4 hv[4];
#pragma unroll
        for (int j = 0; j < 4; ++j) {
            const int col = 4 * lane + 256 * j;
            const f32x4 gp = *(const f32x4*)(P.g_pre_ffn + col), sc = *(const f32x4*)(mb + 4096 + col), sh = *(const f32x4*)(mb + 3072 + col);
            hv[j] = x1[j] * rstd1 * gp * (sc + 1.f) + sh;
            u32x2 o; o.x = pk2(hv[j].x, hv[j].y); o.y = pk2(hv[j].z, hv[j].w);
            *(u32x2*)(H + (size_t)row * DM + col) = o;
        }
        f32x4 gl = {0.f, 0.f, 0.f, 0.f};
#pragma unroll
        for (int j = 0; j < 4; ++j) {
            const float* wp = P.w_gr + (size_t)(4 * lane + 256 * j) * 4;
            gl += *(const f32x4*)(wp) * hv[j].x; gl += *(const f32x4*)(wp + 4) * hv[j].y; gl += *(const f32x4*)(wp + 8) * hv[j].z; gl += *(const f32x4*)(wp + 12) * hv[j].w;
        }
        gl.x = wave_sum(gl.x); gl.y = wave_sum(gl.y); gl.z = wave_sum(gl.z); gl.w = wave_sum(gl.w);
        int gtop = 0; float gm = gl.x;
        if (gl.y > gm) { gm = gl.y; gtop = 1; } if (gl.z > gm) { gm = gl.z; gtop = 2; } if (gl.w > gm) { gm = gl.w; gtop = 3; }
        const float gwt = 1.f / (expf(gl.x - gm) + expf(gl.y - gm) + expf(gl.z - gm) + expf(gl.w - gm));
        const float* we = P.w_er + (size_t)gtop * 1024 * 8;
        f32x4 ea = {0.f, 0.f, 0.f, 0.f}, eb = {0.f, 0.f, 0.f, 0.f};
#pragma unroll
        for (int j = 0; j < 4; ++j) {
            const float* wp = we + (size_t)(4 * lane + 256 * j) * 8;
            ea += *(const f32x4*)(wp) * hv[j].x;      eb += *(const f32x4*)(wp + 4) * hv[j].x;
            ea += *(const f32x4*)(wp + 8) * hv[j].y;  eb += *(const f32x4*)(wp + 12) * hv[j].y;
            ea += *(const f32x4*)(wp + 16) * hv[j].z; eb += *(const f32x4*)(wp + 20) * hv[j].z;
            ea += *(const f32x4*)(wp + 24) * hv[j].w; eb += *(const f32x4*)(wp + 28) * hv[j].w;
        }
        const float e0 = wave_sum(ea.x), e1 = wave_sum(ea.y), e2 = wave_sum(ea.z), e3 = wave_sum(ea.w), e4 = wave_sum(eb.x), e5 = wave_sum(eb.y), e6 = wave_sum(eb.z), e7 = wave_sum(eb.w);
        int i1 = 0; float v1 = e0;
        if (e1 > v1) { v1 = e1; i1 = 1; } if (e2 > v1) { v1 = e2; i1 = 2; } if (e3 > v1) { v1 = e3; i1 = 3; }
        if (e4 > v1) { v1 = e4; i1 = 4; } if (e5 > v1) { v1 = e5; i1 = 5; } if (e6 > v1) { v1 = e6; i1 = 6; } if (e7 > v1) { v1 = e7; i1 = 7; }
        int i2 = -1; float v2 = -3.0e38f;
        if (i1 != 0 && e0 > v2) { v2 = e0; i2 = 0; } if (i1 != 1 && e1 > v2) { v2 = e1; i2 = 1; } if (i1 != 2 && e2 > v2) { v2 = e2; i2 = 2; } if (i1 != 3 && e3 > v2) { v2 = e3; i2 = 3; }
        if (i1 != 4 && e4 > v2) { v2 = e4; i2 = 4; } if (i1 != 5 && e5 > v2) { v2 = e5; i2 = 5; } if (i1 != 6 && e6 > v2) { v2 = e6; i2 = 6; } if (i1 != 7 && e7 > v2) { v2 = e7; i2 = 7; }
        const float ex = expf(v2 - v1), w1 = gwt / (1.f + ex), w2 = gwt * ex / (1.f + ex);
        if (lane == 0) {
            const int ea1 = gtop * 8 + i1, ea2 = gtop * 8 + i2;
            const unsigned p1 = atomicAdd(&cnt[ea1], 1u); ltok[ea1 * NT + p1] = row * 2;     lw[ea1 * NT + p1] = w1;
            const unsigned p2 = atomicAdd(&cnt[ea2], 1u); ltok[ea2 * NT + p2] = row * 2 + 1; lw[ea2 * NT + p2] = w2;
        }
    }
}

DEVINL void phase5a(const Params& P, unsigned char* smem) {
    const int t = threadIdx.x, lane = t & 63, w = t >> 6, wm = w & 1, wn = w >> 1, lr = lane & 15, g = lane >> 4, ldrow = t >> 3;
    const bf16_t* H = (const bf16_t*)(P.ws + WS_H); const bf16_t* Wgu = (const bf16_t*)(P.ws + WS_WGU);
    const unsigned* cnt = (const unsigned*)(P.ws + WS_CNT); const int* ltok = (const int*)(P.ws + WS_LTOK);
    bf16_t* HID = (bf16_t*)(P.ws + WS_HID);
    int total = 0;
    for (int e = 0; e < 32; ++e) total += ((int)cnt[e] + 127) >> 7;
    for (int it = blockIdx.x; it < total * 4; it += gridDim.x) {
        const int tn = it & 3; int mt = it >> 2, e = 0, off = 0;
        for (; e < 32; ++e) { const int c = (int)cnt[e], nt = (c + 127) >> 7; if (mt < nt) break; mt -= nt; off += c; }
        const int ce = (int)cnt[e], n0 = tn * 128;
        const bf16_t* ar[4];
#pragma unroll
        for (int i = 0; i < 4; ++i) { const int r = mt * 128 + ldrow + 32 * i; const int tok = (r < ce) ? (ltok[e * NT + r] >> 1) : 0; ar[i] = H + (size_t)tok * DM; }
        const bf16_t* bb = Wgu + ((size_t)e * 512 + n0 + ldrow) * DM;
        f32x4 acc[4][4]; zero_acc(acc);
        gemm_core(acc, ar[0], ar[1], ar[2], ar[3], bb, bb + 32 * DM, bb + 64 * DM, bb + 96 * DM, 0, DM, smem);
#pragma unroll
        for (int mi = 0; mi < 4; ++mi) {
            const int r = mt * 128 + 64 * wm + 16 * mi + lr;
            if (r < ce) {
#pragma unroll
                for (int p = 0; p < 2; ++p) {
                    const f32x4 gt = acc[2 * p][mi], up = acc[2 * p + 1][mi];
                    f32x4 hd; hd.x = silu_f(gt.x) * up.x; hd.y = silu_f(gt.y) * up.y; hd.z = silu_f(gt.z) * up.z; hd.w = silu_f(gt.w) * up.w;
                    u32x2 o; o.x = pk2(hd.x, hd.y); o.y = pk2(hd.z, hd.w);
                    *(u32x2*)(HID + (size_t)(off + r) * 256 + (n0 >> 1) + 32 * wn + 16 * p + 4 * g) = o;
                }
            }
        }
    }
}
DEVINL void phase5b(const Params& P, unsigned char* smem) {
    const int t = threadIdx.x, lane = t & 63, w = t >> 6, wm = w & 1, wn = w >> 1, lr = lane & 15, g = lane >> 4, ldrow = t >> 3;
    const bf16_t* HID = (const bf16_t*)(P.ws + WS_HID); const bf16_t* Wd = (const bf16_t*)(P.ws + WS_WD);
    const unsigned* cnt = (const unsigned*)(P.ws + WS_CNT); const int* ltok = (const int*)(P.ws + WS_LTOK); const float* lw = (const float*)(P.ws + WS_LW);
    bf16_t* Y = (bf16_t*)(P.ws + WS_Y);
    int total = 0;
    for (int e = 0; e < 32; ++e) total += ((int)cnt[e] + 127) >> 7;
    for (int it = blockIdx.x; it < total * 8; it += gridDim.x) {
        const int tn = it & 7; int mt = it >> 3, e = 0, off = 0;
        for (; e < 32; ++e) { const int c = (int)cnt[e], nt = (c + 127) >> 7; if (mt < nt) break; mt -= nt; off += c; }
        const int ce = (int)cnt[e], n0 = tn * 128;
        const bf16_t* ar[4];
#pragma unroll
        for (int i = 0; i < 4; ++i) { int r = mt * 128 + ldrow + 32 * i; r = r < ce ? r : ce - 1; ar[i] = HID + (size_t)(off + r) * 256; }
        const bf16_t* bb = Wd + ((size_t)e * 1024 + n0 + ldrow) * 256;
        f32x4 acc[4][4]; zero_acc(acc);
        gemm_core(acc, ar[0], ar[1], ar[2], ar[3], bb, bb + 32 * 256, bb + 64 * 256, bb + 96 * 256, 0, 256, smem);
#pragma unroll
        for (int mi = 0; mi < 4; ++mi) {
            const int r = mt * 128 + 64 * wm + 16 * mi + lr;
            if (r < ce) {
                const int ent = ltok[e * NT + r]; const float wt = lw[e * NT + r];
                bf16_t* yp = Y + ((size_t)(ent & 1) * NT + (ent >> 1)) * DM + n0 + 64 * wn + 4 * g;
#pragma unroll
                for (int ni = 0; ni < 4; ++ni) { const f32x4 v = acc[ni][mi] * wt; u32x2 o; o.x = pk2(v.x, v.y); o.y = pk2(v.z, v.w); *(u32x2*)(yp + 16 * ni) = o; }
            }
        }
    }
}
DEVINL void phase6(const Params& P) {
    const int lane = threadIdx.x & 63, gw = blockIdx.x * 4 + (threadIdx.x >> 6), ngw = gridDim.x * 4;
    const float* mod = (const float*)(P.ws + WS_MOD);
    const bf16_t* Y = (const bf16_t*)(P.ws + WS_Y);
    for (int row = gw; row < NT; row += ngw) {
        const float* mb = mod + (row >> 13) * 6144;
        f32x4 y[4]; float ss = 0.f;
#pragma unroll
        for (int j = 0; j < 4; ++j) {
            const int col = 4 * lane + 256 * j;
            const u32x2 a = *(const u32x2*)(Y + (size_t)row * DM + col), b = *(const u32x2*)(Y + ((size_t)NT + row) * DM + col);
            y[j] = (f32x4){bflo(a.x) + bflo(b.x), bfhi(a.x) + bfhi(b.x), bflo(a.y) + bflo(b.y), bfhi(a.y) + bfhi(b.y)};
            ss += y[j].x * y[j].x + y[j].y * y[j].y + y[j].z * y[j].z + y[j].w * y[j].w;
        }
        ss = wave_sum(ss);
        const float rstd = rsqrtf(ss * (1.f / DM) + EPS);
#pragma unroll
        for (int j = 0; j < 4; ++j) {
            const int col = 4 * lane + 256 * j;
            const f32x4 x1 = *(const f32x4*)(P.out + (size_t)row * DM + col), gp = *(const f32x4*)(P.g_post_ffn + col), gf = *(const f32x4*)(mb + 5120 + col);
            *(f32x4*)(P.out + (size_t)row * DM + col) = x1 + gf * (y[j] * rstd * gp);
        }
    }
}

constexpr int NPHASE = 9;
__global__ void __launch_bounds__(256, 2) fwd_kernel(Params P) {
    extern __shared__ __attribute__((aligned(16))) unsigned char smem[];
#if N_LAUNCH_MODE == 1
    cg::grid_group grid = cg::this_grid();
#define SEAM(k) do { if (P.ph_lo <= (k) && (k) + 1 < P.ph_hi) grid.sync(); } while (0)
#else
#define SEAM(k) do { } while (0)
#endif
#define IN(k) (P.ph_lo <= (k) && (k) < P.ph_hi)
    if (IN(0)) { phase0(P, smem); }  SEAM(0);
    if (IN(1)) { phase1(P); }        SEAM(1);
    if (IN(2)) { phase2(P, smem); }  SEAM(2);
    if (IN(3)) { phase3(P, smem); }  SEAM(3);
    if (IN(4)) { phase4a(P, smem); } SEAM(4);
    if (IN(5)) { phase4b(P); }       SEAM(5);
    if (IN(6)) { phase5a(P, smem); } SEAM(6);
    if (IN(7)) { phase5b(P, smem); } SEAM(7);
    if (IN(8)) { phase6(P); }
#undef IN
#undef SEAM
}

extern "C" void kernel_launch(void* const* d_in, const int* in_sizes, int n_in, void* d_out, int out_size, void* d_ws, size_t ws_size, hipStream_t stream) {
    static int grid_blocks = 0;
    if (!grid_blocks) {
        if (ws_size < WS_END) { fprintf(stderr, "kernel_launch: workspace too small (%zu < %zu)\n", ws_size, (size_t)WS_END); grid_blocks = -1; return; }
        int dev = 0, cus = 0, per_cu = 0;
        hipGetDevice(&dev);
        hipDeviceGetAttribute(&cus, hipDeviceAttributeMultiprocessorCount, dev);
        hipFuncSetAttribute((const void*)fwd_kernel, hipFuncAttributeMaxDynamicSharedMemorySize, LDS_BYTES);
        hipOccupancyMaxActiveBlocksPerMultiprocessor(&per_cu, (const void*)fwd_kernel, 256, LDS_BYTES);
        if (per_cu > 2) per_cu = 2;
        if (per_cu < 1) per_cu = 1;
        grid_blocks = cus * per_cu;
        fprintf(stderr, "kernel_launch: %d CUs x %d blocks\n", cus, per_cu);
    }
    if (grid_blocks < 0) return;
    Params p{};
    const float** pp = (const float**)&p;
    for (int i = 0; i < 19; ++i) pp[i] = (const float*)d_in[i];
    p.out = (float*)d_out; p.ws = (unsigned char*)d_ws;
#if N_LAUNCH_MODE == 1
    p.ph_lo = 0; p.ph_hi = NPHASE;
    void* args[] = {&p};
    hipError_t e = hipLaunchCooperativeKernel((const void*)fwd_kernel, dim3(grid_blocks), dim3(256), args, LDS_BYTES, stream);
    if (e != hipSuccess) fprintf(stderr, "cooperative launch failed: %s (grid %d)\n", hipGetErrorString(e), grid_blocks);
#else
    for (int ph = 0; ph < NPHASE; ++ph) {
        p.ph_lo = ph; p.ph_hi = ph + 1;
        hipLaunchKernelGGL(fwd_kernel, dim3(grid_blocks), dim3(256), LDS_BYTES, stream, p);
    }
#endif
}
```

```cpp
#include <hip/hip_runtime.h>
#include <hip/hip_cooperative_groups.h>
#include <stdint.h>
#include <stdio.h>
namespace cg = cooperative_groups;

#ifndef NAIVE_GEMM
#define NAIVE_GEMM 0
#endif
#ifndef NAIVE_ATTN
#define NAIVE_ATTN 0
#endif
#ifndef N_LAUNCH_MODE
#define N_LAUNCH_MODE 1
#endif

#define DEVINL __device__ __forceinline__

typedef unsigned short bf16_t;
typedef short bf16x8 __attribute__((ext_vector_type(8)));
typedef float f32x4 __attribute__((ext_vector_type(4)));
typedef unsigned u32x4 __attribute__((ext_vector_type(4)));
typedef unsigned u32x2 __attribute__((ext_vector_type(2)));

constexpr int SEQ = 8192, DM = 1024, NT = 2 * SEQ;
constexpr int QKVW = 2304;
constexpr float EPS = 1e-6f;
constexpr float LOG2E = 1.4426950408889634f;
constexpr float QSCALE = 0.125f * LOG2E;

constexpr size_t MiB = 1u << 20;
constexpr size_t WS_CNT  = 0;
constexpr size_t WS_MOD  = 1 * MiB;
constexpr size_t WS_ROPE = 2 * MiB;
constexpr size_t WS_WQKV = 4 * MiB;
constexpr size_t WS_WOUT = 9 * MiB;
constexpr size_t WS_WGU  = 11 * MiB;
constexpr size_t WS_WD   = 43 * MiB;
constexpr size_t WS_H    = 59 * MiB;
constexpr size_t WS_NAQ  = 91 * MiB;
constexpr size_t WS_NAK  = 107 * MiB;
constexpr size_t WS_NAVT = 123 * MiB;
constexpr size_t WS_SWQ  = 139 * MiB;
constexpr size_t WS_SWK  = 155 * MiB;
constexpr size_t WS_SWVT = 159 * MiB;
constexpr size_t WS_ATT  = 163 * MiB;
constexpr size_t WS_SSQ  = 195 * MiB;
constexpr size_t WS_LTOK = 196 * MiB;
constexpr size_t WS_LW   = 198 * MiB;
constexpr size_t WS_HID  = 200 * MiB;
constexpr size_t WS_Y    = 91 * MiB;
constexpr size_t WS_END  = 218 * MiB;

constexpr int LDS_BYTES = 65536 + 4096;

struct Params {
    const float *x, *c, *w_ada, *b_ada, *g_pre_mix, *w_in, *na_rpb, *swa_sinks, *beta_na, *beta_swa, *w_out, *g_post_mix, *g_pre_ffn,
                *w_gr, *w_er, *w_gate, *w_up, *w_down, *g_post_ffn;
    float* out; unsigned char* ws; int ph_lo, ph_hi;
};

DEVINL unsigned f2bf(float f) { unsigned u = __float_as_uint(f); return (u + 0x7fffu + ((u >> 16) & 1u)) >> 16; }
DEVINL unsigned pk2(float lo, float hi) { return f2bf(lo) | (f2bf(hi) << 16); }
DEVINL float bf2f(bf16_t v) { return __uint_as_float(((unsigned)v) << 16); }
DEVINL float bflo(unsigned u) { return __uint_as_float(u << 16); }
DEVINL float bfhi(unsigned u) { return __uint_as_float(u & 0xffff0000u); }
DEVINL float wave_sum(float v) {
#pragma unroll
    for (int o = 32; o >= 1; o >>= 1) v += __shfl_xor(v, o);
    return v;
}
DEVINL float silu_f(float v) { return v / (1.f + expf(-v)); }

DEVINL void mod_item(const Params& P, int item, unsigned char* smem) {
    float* s_silu = (float*)smem;
    float* s_red  = s_silu + 2048;
    const int t = threadIdx.x;
    for (int i = t; i < 2048; i += 256) s_silu[i] = silu_f(P.c[i]);
    __syncthreads();
    const int c4 = t & 7, rg = t >> 3, col = item * 32 + c4 * 4;
    f32x4 a0 = {0.f, 0.f, 0.f, 0.f}, a1 = {0.f, 0.f, 0.f, 0.f};
#pragma unroll 4
    for (int i = 0; i < 32; ++i) {
        const int k = rg + 32 * i;
        const f32x4 w = *(const f32x4*)(P.w_ada + (size_t)k * 6144 + col);
        a0 += w * s_silu[k]; a1 += w * s_silu[1024 + k];
    }
    *(f32x4*)(s_red + (rg * 2 + 0) * 32 + c4 * 4) = a0;
    *(f32x4*)(s_red + (rg * 2 + 1) * 32 + c4 * 4) = a1;
    __syncthreads();
    if (t < 64) {
        const int b = t >> 5, cc = t & 31; float s = 0.f;
        for (int r = 0; r < 32; ++r) s += s_red[(r * 2 + b) * 32 + cc];
        ((float*)(P.ws + WS_MOD))[b * 6144 + item * 32 + cc] = s + P.b_ada[item * 32 + cc];
    }
    __syncthreads();
}
DEVINL void transpose_item(const float* src, int N, int k0, int n0, bf16_t* dst, int ldd, int mode, const float* kscale, unsigned char* smem) {
    float* scr = (float*)smem;
    const int t = threadIdx.x;
#pragma unroll
    for (int p = 0; p < 4; ++p) {
        const int r = (t >> 4) + 16 * p;
        f32x4 v = *(const f32x4*)(src + (size_t)(k0 + r) * N + n0 + (t & 15) * 4);
        const float sc = kscale ? kscale[r] : 1.f;
        float* d = scr + r * 65 + (t & 15) * 4;
        d[0] = v.x * sc; d[1] = v.y * sc; d[2] = v.z * sc; d[3] = v.w * sc;
    }
    __syncthreads();
    const int n = t >> 2, kq = t & 3;
    u32x4 w0, w1;
    const float* s = scr + (kq * 16) * 65 + n;
    w0.x = pk2(s[0 * 65], s[1 * 65]);   w0.y = pk2(s[2 * 65], s[3 * 65]);   w0.z = pk2(s[4 * 65], s[5 * 65]);   w0.w = pk2(s[6 * 65], s[7 * 65]);
    w1.x = pk2(s[8 * 65], s[9 * 65]);   w1.y = pk2(s[10 * 65], s[11 * 65]); w1.z = pk2(s[12 * 65], s[13 * 65]); w1.w = pk2(s[14 * 65], s[15 * 65]);
    const int j = n0 + n;
    int drow = j;
    if (mode == 1) drow = (j >> 4) * 32 + (j & 15);
    if (mode == 2) drow = (j >> 4) * 32 + 16 + (j & 15);
    bf16_t* o = dst + (size_t)drow * ldd + k0 + kq * 16;
    *(u32x4*)o = w0; *(u32x4*)(o + 8) = w1;
    __syncthreads();
}
DEVINL void phase0(const Params& P, unsigned char* smem) {
    const int t = threadIdx.x;
    if (blockIdx.x == 0 && t < 64) ((unsigned*)(P.ws + WS_CNT))[t] = 0u;
    {
        float* rc = (float*)(P.ws + WS_ROPE); float* rs = rc + SEQ * 32;
        for (int i = blockIdx.x * 256 + t; i < SEQ * 32; i += gridDim.x * 256) {
            const int pos = i >> 5, fi = i & 31;
            const float ex = -((float)fi * 2.0f) / 64.0f;
            const float inv = exp2f(ex * 13.287712379549449f);
            const float ang = (float)pos * inv;
            double tt = (double)ang * 0.15915494309189535; tt -= floor(tt);
            const float fr = (float)tt;
            rc[i] = __builtin_amdgcn_cosf(fr); rs[i] = __builtin_amdgcn_sinf(fr);
        }
    }
    bf16_t* Wqkv = (bf16_t*)(P.ws + WS_WQKV); bf16_t* Wout = (bf16_t*)(P.ws + WS_WOUT);
    bf16_t* Wgu = (bf16_t*)(P.ws + WS_WGU);   bf16_t* Wd = (bf16_t*)(P.ws + WS_WD);
    constexpr int NMOD = 192, NI_IN = 16 * 36, NI_OUT = 256, NI_E = 2048;
    constexpr int total = NMOD + NI_IN + NI_OUT + 3 * NI_E;
    for (int it = blockIdx.x; it < total; it += gridDim.x) {
        int r = it;
        if (r < NMOD) { mod_item(P, r, smem); continue; } r -= NMOD;
        if (r < NI_IN) { const int kb = r / 36, nb = r % 36; transpose_item(P.w_in, QKVW, kb * 64, nb * 64, Wqkv, 1024, 0, nullptr, smem); continue; } r -= NI_IN;
        if (r < NI_OUT) { const int kb = r >> 4, nb = r & 15; const int k0 = kb * 64;
            const float* ks = (k0 < 512) ? (P.beta_na + k0) : (P.beta_swa + (k0 - 512));
            transpose_item(P.w_out, 1024, k0, nb * 64, Wout, 1024, 0, ks, smem); continue; } r -= NI_OUT;
        if (r < NI_E) { const int e = r >> 6, q = r & 63, kb = q >> 2, nb = q & 3;
            transpose_item(P.w_gate + (size_t)e * 1024 * 256, 256, kb * 64, nb * 64, Wgu + (size_t)e * 512 * 1024, 1024, 1, nullptr, smem); continue; } r -= NI_E;
        if (r < NI_E) { const int e = r >> 6, q = r & 63, kb = q >> 2, nb = q & 3;
            transpose_item(P.w_up + (size_t)e * 1024 * 256, 256, kb * 64, nb * 64, Wgu + (size_t)e * 512 * 1024, 1024, 2, nullptr, smem); continue; } r -= NI_E;
        { const int e = r >> 6, q = r & 63, kb = q >> 4, nb = q & 15;
            transpose_item(P.w_down + (size_t)e * 256 * 1024, 1024, kb * 64, nb * 64, Wd + (size_t)e * 1024 * 256, 256, 0, nullptr, smem); }
    }
}

DEVINL void phase1(const Params& P) {
    const int lane = threadIdx.x & 63, gw = blockIdx.x * 4 + (threadIdx.x >> 6), ngw = gridDim.x * 4;
    const float* mod = (const float*)(P.ws + WS_MOD);
    bf16_t* H = (bf16_t*)(P.ws + WS_H);
    for (int row = gw; row < NT; row += ngw) {
        const f32x4* xr = (const f32x4*)(P.x + (size_t)row * DM) + lane;
        f32x4 v[4]; float ss = 0.f;
#pragma unroll
        for (int j = 0; j < 4; ++j) { v[j] = xr[64 * j]; ss += v[j].x * v[j].x + v[j].y * v[j].y + v[j].z * v[j].z + v[j].w * v[j].w; }
        ss = wave_sum(ss);
        const float rstd = rsqrtf(ss * (1.f / DM) + EPS);
        const float* mb = mod + (row >> 13) * 6144;
#pragma unroll
        for (int j = 0; j < 4; ++j) {
            const int col = 4 * lane + 256 * j;
            const f32x4 g = *(const f32x4*)(P.g_pre_mix + col), sc = *(const f32x4*)(mb + 1024 + col), sh = *(const f32x4*)(mb + col);
            const f32x4 h = v[j] * rstd * g * (sc + 1.f) + sh;
            u32x2 o; o.x = pk2(h.x, h.y); o.y = pk2(h.z, h.w);
            *(u32x2*)(H + (size_t)row * DM + col) = o;
        }
    }
}

DEVINL int lds_off(int row, int chunk) { return row * 128 + ((chunk ^ ((row >> 1) & 7)) << 4); }

DEVINL void gemm_core(f32x4 (&acc)[4][4], const bf16_t* a0, const bf16_t* a1, const bf16_t* a2, const bf16_t* a3,
                      const bf16_t* b0, const bf16_t* b1, const bf16_t* b2, const bf16_t* b3, int kbeg, int kend, unsigned char* smem) {
    const int t = threadIdx.x, lane = t & 63, w = t >> 6, wm = w & 1, wn = w >> 1, lr = lane & 15, g = lane >> 4;
    const int ldrow = t >> 3, ldc = t & 7;
#if NAIVE_GEMM
    const bf16_t** sp = (const bf16_t**)(smem + 65536);
    __syncthreads();
    if (ldc == 0) { sp[ldrow] = a0; sp[ldrow + 32] = a1; sp[ldrow + 64] = a2; sp[ldrow + 96] = a3;
                    sp[128 + ldrow] = b0; sp[128 + ldrow + 32] = b1; sp[128 + ldrow + 64] = b2; sp[128 + ldrow + 96] = b3; }
    __syncthreads();
#pragma unroll
    for (int ni = 0; ni < 4; ++ni)
#pragma unroll
        for (int mi = 0; mi < 4; ++mi) {
            const bf16_t* ap = sp[64 * wm + 16 * mi + lr];
#pragma unroll
            for (int reg = 0; reg < 4; ++reg) {
                const bf16_t* bp = sp[128 + 64 * wn + 16 * ni + 4 * g + reg];
                float s = 0.f;
#pragma unroll 1
                for (int k = kbeg; k < kend; k += 8) {
                    const u32x4 av = *(const u32x4*)(ap + k), bv = *(const u32x4*)(bp + k);
                    s += bflo(av.x) * bflo(bv.x) + bfhi(av.x) * bfhi(bv.x) + bflo(av.y) * bflo(bv.y) + bfhi(av.y) * bfhi(bv.y)
                       + bflo(av.z) * bflo(bv.z) + bfhi(av.z) * bfhi(bv.z) + bflo(av.w) * bflo(bv.w) + bfhi(av.w) * bfhi(bv.w);
                }
                acc[ni][mi][reg] += s;
            }
        }
    __syncthreads();
#else
    u32x4 ra0, ra1, ra2, ra3, rb0, rb1, rb2, rb3;
    const int wo0 = lds_off(ldrow, ldc), wo1 = lds_off(ldrow + 32, ldc), wo2 = lds_off(ldrow + 64, ldc), wo3 = lds_off(ldrow + 96, ldc);
#define GLOAD(kk) do { const int ko_ = (kk) + ldc * 8; \
        ra0 = *(const u32x4*)(a0 + ko_); ra1 = *(const u32x4*)(a1 + ko_); ra2 = *(const u32x4*)(a2 + ko_); ra3 = *(const u32x4*)(a3 + ko_); \
        rb0 = *(const u32x4*)(b0 + ko_); rb1 = *(const u32x4*)(b1 + ko_); rb2 = *(const u32x4*)(b2 + ko_); rb3 = *(const u32x4*)(b3 + ko_); } while (0)
#define LWRITE(buf) do { unsigned char* a_ = smem + (buf) * 32768; unsigned char* b_ = a_ + 16384; \
        *(u32x4*)(a_ + wo0) = ra0; *(u32x4*)(a_ + wo1) = ra1; *(u32x4*)(a_ + wo2) = ra2; *(u32x4*)(a_ + wo3) = ra3; \
        *(u32x4*)(b_ + wo0) = rb0; *(u32x4*)(b_ + wo1) = rb1; *(u32x4*)(b_ + wo2) = rb2; *(u32x4*)(b_ + wo3) = rb3; } while (0)
    const int nk = (kend - kbeg) >> 6;
    __syncthreads();
    GLOAD(kbeg); LWRITE(0); __syncthreads();
    for (int kt = 0; kt < nk; ++kt) {
        if (kt + 1 < nk) GLOAD(kbeg + (kt + 1) * 64);
        const unsigned char* a_ = smem + (kt & 1) * 32768; const unsigned char* b_ = a_ + 16384;
#pragma unroll
        for (int ks = 0; ks < 2; ++ks) {
            bf16x8 fa[4], fb[4];
#pragma unroll
            for (int i = 0; i < 4; ++i) { fa[i] = *(const bf16x8*)(a_ + lds_off(64 * wm + 16 * i + lr, ks * 4 + g)); fb[i] = *(const bf16x8*)(b_ + lds_off(64 * wn + 16 * i + lr, ks * 4 + g)); }
#pragma unroll
            for (int ni = 0; ni < 4; ++ni)
#pragma unroll
                for (int mi = 0; mi < 4; ++mi) acc[ni][mi] = __builtin_amdgcn_mfma_f32_16x16x32_bf16(fb[ni], fa[mi], acc[ni][mi], 0, 0, 0);
        }
        if (kt + 1 < nk) LWRITE((kt + 1) & 1);
        __syncthreads();
    }
#undef GLOAD
#undef LWRITE
#endif
}
DEVINL void zero_acc(f32x4 (&acc)[4][4]) {
#pragma unroll
    for (int i = 0; i < 4; ++i)
#pragma unroll
        for (int j = 0; j < 4; ++j) acc[i][j] = (f32x4){0.f, 0.f, 0.f, 0.f};
}

DEVINL void phase2(const Params& P, unsigned char* smem) {
    const int t = threadIdx.x, lane = t & 63, w = t >> 6, wm = w & 1, wn = w >> 1, lr = lane & 15, g = lane >> 4, ldrow = t >> 3;
    const bf16_t* H = (const bf16_t*)(P.ws + WS_H); const bf16_t* Wt = (const bf16_t*)(P.ws + WS_WQKV);
    const float* rc = (const float*)(P.ws + WS_ROPE); const float* rs = rc + SEQ * 32;
    constexpr int TN = QKVW / 128, TM = NT / 128;
    for (int it = blockIdx.x; it < TN * TM; it += gridDim.x) {
        const int tm = it / TN, tn = it % TN, m0 = tm * 128, n0 = tn * 128;
        const bf16_t* ab = H + (size_t)(m0 + ldrow) * DM; const bf16_t* bb = Wt + (size_t)(n0 + ldrow) * DM;
        f32x4 acc[4][4]; zero_acc(acc);
        gemm_core(acc, ab, ab + 32 * DM, ab + 64 * DM, ab + 96 * DM, bb, bb + 32 * DM, bb + 64 * DM, bb + 96 * DM, 0, DM, smem);
        const int nW = n0 + 64 * wn;
        int region, hh;
        if (nW < 512) { region = 0; hh = nW >> 6; } else if (nW < 1024) { region = 1; hh = (nW - 512) >> 6; } else if (nW < 1536) { region = 2; hh = (nW - 1024) >> 6; }
        else if (nW < 2048) { region = 3; hh = (nW - 1536) >> 6; } else if (nW < 2176) { region = 4; hh = (nW - 2048) >> 6; } else { region = 5; hh = (nW - 2176) >> 6; }
#pragma unroll
        for (int mi = 0; mi < 4; ++mi) {
            const int m = m0 + 64 * wm + 16 * mi + lr, b = m >> 13, s = m & (SEQ - 1);
            f32x4 v[4];
#pragma unroll
            for (int ni = 0; ni < 4; ++ni) v[ni] = acc[ni][mi];
            if (region == 3 || region == 4) {
#pragma unroll
                for (int ni = 0; ni < 2; ++ni) {
                    const f32x4 cs = *(const f32x4*)(rc + s * 32 + 16 * ni + 4 * g), sn = *(const f32x4*)(rs + s * 32 + 16 * ni + 4 * g);
                    const f32x4 x1 = v[ni], x2 = v[ni + 2];
                    v[ni] = x1 * cs - x2 * sn; v[ni + 2] = x2 * cs + x1 * sn;
                }
            }
            if (region == 0 || region == 3) {
#pragma unroll
                for (int ni = 0; ni < 4; ++ni) v[ni] = v[ni] * QSCALE;
            }
            if (region == 2 || region == 5) {
                bf16_t* base = (bf16_t*)(P.ws + (region == 2 ? WS_NAVT : WS_SWVT)) + ((size_t)(b * (region == 2 ? 8 : 2) + hh) * 64) * SEQ + s;
#pragma unroll
                for (int ni = 0; ni < 4; ++ni) {
                    const int d = 16 * ni + 4 * g;
                    base[(size_t)(d + 0) * SEQ] = (bf16_t)f2bf(v[ni].x); base[(size_t)(d + 1) * SEQ] = (bf16_t)f2bf(v[ni].y);
                    base[(size_t)(d + 2) * SEQ] = (bf16_t)f2bf(v[ni].z); base[(size_t)(d + 3) * SEQ] = (bf16_t)f2bf(v[ni].w);
                }
            } else {
                const size_t off = region == 0 ? WS_NAQ : region == 1 ? WS_NAK : region == 3 ? WS_SWQ : WS_SWK;
                const int nh = (region == 4) ? 2 : 8;
                bf16_t* base = (bf16_t*)(P.ws + off) + ((size_t)(b * nh + hh) * SEQ + s) * 64;
#pragma unroll
                for (int ni = 0; ni < 4; ++ni) { u32x2 o; o.x = pk2(v[ni].x, v[ni].y); o.y = pk2(v[ni].z, v[ni].w); *(u32x2*)(base + 16 * ni + 4 * g) = o; }
            }
        }
    }
}

#if NAIVE_ATTN
DEVINL void phase3(const Params& P, unsigned char* smem) {
    const int lane = threadIdx.x & 63, gw = blockIdx.x * 4 + (threadIdx.x >> 6), ngw = gridDim.x * 4;
    bf16_t* ATT = (bf16_t*)(P.ws + WS_ATT); float* SSQ = (float*)(P.ws + WS_SSQ);
    for (int it = gw; it < NT * 16; it += ngw) {
        const int isw = it >= NT * 8; const int r = isw ? it - NT * 8 : it;
        const int tok = r >> 3, h = r & 7, b = tok >> 13, s = tok & (SEQ - 1);
        float m = -3.0e38f, sum = 0.f, o = 0.f;
        if (!isw) {
            const bf16_t* Q = (const bf16_t*)(P.ws + WS_NAQ) + ((size_t)(b * 8 + h) * SEQ) * 64;
            const bf16_t* K = (const bf16_t*)(P.ws + WS_NAK) + ((size_t)(b * 8 + h) * SEQ) * 64;
            const bf16_t* VT = (const bf16_t*)(P.ws + WS_NAVT) + ((size_t)(b * 8 + h) * 64) * SEQ;
            const float q = bf2f(Q[(size_t)s * 64 + lane]);
            const int row = s >> 6, col = s & 63;
            int r0 = row - 4; r0 = r0 < 0 ? 0 : (r0 > 120 ? 120 : r0);
            int cs = col - 8; cs = cs < 0 ? 0 : (cs > 48 ? 48 : cs);
            const float* rpb = P.na_rpb + h * 15 * 31;
            for (int pass = 0; pass < 2; ++pass)
                for (int i = 0; i < 8; ++i)
                    for (int j = 0; j < 16; ++j) {
                        const int key = (r0 + i) * 64 + cs + j;
                        float d = wave_sum(q * bf2f(K[(size_t)key * 64 + lane]));
                        d += rpb[(r0 + i - row + 7) * 31 + (cs + j - col + 15)] * LOG2E;
                        if (pass == 0) m = fmaxf(m, d);
                        else { const float p = exp2f(d - m); sum += p; o += p * bf2f(VT[(size_t)lane * SEQ + key]); }
                    }
        } else {
            const int kvh = h >> 2;
            const bf16_t* Q = (const bf16_t*)(P.ws + WS_SWQ) + ((size_t)(b * 8 + h) * SEQ) * 64;
            const bf16_t* K = (const bf16_t*)(P.ws + WS_SWK) + ((size_t)(b * 2 + kvh) * SEQ) * 64;
            const bf16_t* VT = (const bf16_t*)(P.ws + WS_SWVT) + ((size_t)(b * 2 + kvh) * 64) * SEQ;
            const float q = bf2f(Q[(size_t)s * 64 + lane]);
            const int klo = s - 128 < 0 ? 0 : s - 128, khi = s + 128 > SEQ - 1 ? SEQ - 1 : s + 128;
            const float sk = P.swa_sinks[h] * LOG2E;
            m = sk;
            for (int pass = 0; pass < 2; ++pass)
                for (int key = klo; key <= khi; ++key) {
                    const float d = wave_sum(q * bf2f(K[(size_t)key * 64 + lane]));
                    if (pass == 0) m = fmaxf(m, d);
                    else { const float p = exp2f(d - m); sum += p; o += p * bf2f(VT[(size_t)lane * SEQ + key]); }
                }
            sum += exp2f(sk - m);
        }
        o /= sum;
        ATT[(size_t)tok * DM + (isw ? 512 : 0) + h * 64 + lane] = (bf16_t)f2bf(o);
        const float sq = wave_sum(o * o);
        if (lane == 0) SSQ[tok * 16 + (isw ? 8 : 0) + h] = sq;
    }
}
#else
DEVINL void phase3(const Params& P, unsigned char* smem) {
    const int t = threadIdx.x, lane = t & 63, w = t >> 6, lr = lane & 15, g = lane >> 4;
    bf16_t* ATT = (bf16_t*)(P.ws + WS_ATT); float* SSQ = (float*)(P.ws + WS_SSQ);
    float* s_rpb = (float*)smem;
    for (int i = t; i < 8 * 465; i += 256) s_rpb[i] = P.na_rpb[i] * LOG2E;
    __syncthreads();
    constexpr int N_NA = 2 * 8 * 128, N_SW = 2 * 2 * 512;
    for (int it = blockIdx.x; it < N_NA + N_SW; it += gridDim.x) {
        if (it < N_NA) {
            const int r = it & 127, h = (it >> 7) & 7, b = it >> 10;
            const int c0 = 16 * w;
            int r0 = r - 4; r0 = r0 < 0 ? 0 : (r0 > 120 ? 120 : r0);
            int kc0 = c0 - 8; kc0 = kc0 < 0 ? 0 : (kc0 > 32 ? 32 : kc0);
            const bf16_t* Q = (const bf16_t*)(P.ws + WS_NAQ) + ((size_t)(b * 8 + h) * SEQ) * 64;
            const bf16_t* K = (const bf16_t*)(P.ws + WS_NAK) + ((size_t)(b * 8 + h) * SEQ) * 64;
            const bf16_t* VT = (const bf16_t*)(P.ws + WS_NAVT) + ((size_t)(b * 8 + h) * 64) * SEQ;
            const bf16_t* qp = Q + (size_t)(r * 64 + c0 + lr) * 64 + 8 * g;
            const bf16x8 q0 = *(const bf16x8*)qp, q1 = *(const bf16x8*)(qp + 32);
            f32x4 sc[16];
#pragma unroll
            for (int tt = 0; tt < 16; ++tt) {
                const bf16_t* kp = K + (size_t)((r0 + (tt >> 1)) * 64 + kc0 + (tt & 1) * 16 + lr) * 64 + 8 * g;
                const bf16x8 k0 = *(const bf16x8*)kp, k1 = *(const bf16x8*)(kp + 32);
                f32x4 a = {0.f, 0.f, 0.f, 0.f};
                a = __builtin_amdgcn_mfma_f32_16x16x32_bf16(k0, q0, a, 0, 0, 0);
                a = __builtin_amdgcn_mfma_f32_16x16x32_bf16(k1, q1, a, 0, 0, 0);
                sc[tt] = a;
            }
            const int c = c0 + lr; int cs = c - 8; cs = cs < 0 ? 0 : (cs > 48 ? 48 : cs);
            const float* rp = s_rpb + h * 465;
            float mx = -3.0e38f;
#pragma unroll
            for (int tt = 0; tt < 16; ++tt) {
                const int dr = r0 + (tt >> 1) - r + 7;
#pragma unroll
                for (int e = 0; e < 4; ++e) {
                    const int kc = kc0 + (tt & 1) * 16 + 4 * g + e;
                    const bool ok = (kc >= cs) && (kc < cs + 16);
                    int dc = kc - c + 15; dc = dc < 0 ? 0 : (dc > 30 ? 30 : dc);
                    const float v = ok ? sc[tt][e] + rp[dr * 31 + dc] : -3.0e38f;
                    sc[tt][e] = v; mx = fmaxf(mx, v);
                }
            }
            mx = fmaxf(mx, __shfl_xor(mx, 16)); mx = fmaxf(mx, __shfl_xor(mx, 32));
            float sum = 0.f;
#pragma unroll
            for (int tt = 0; tt < 16; ++tt)
#pragma unroll
                for (int e = 0; e < 4; ++e) { const float p = exp2f(sc[tt][e] - mx); sc[tt][e] = p; sum += p; }
            sum += __shfl_xor(sum, 16); sum += __shfl_xor(sum, 32);
            f32x4 o[4];
#pragma unroll
            for (int dt = 0; dt < 4; ++dt) o[dt] = (f32x4){0.f, 0.f, 0.f, 0.f};
#pragma unroll
            for (int kk = 0; kk < 8; ++kk) {
                union { bf16x8 v; unsigned u[4]; } pf;
                pf.u[0] = pk2(sc[2 * kk][0], sc[2 * kk][1]); pf.u[1] = pk2(sc[2 * kk][2], sc[2 * kk][3]);
                pf.u[2] = pk2(sc[2 * kk + 1][0], sc[2 * kk + 1][1]); pf.u[3] = pk2(sc[2 * kk + 1][2], sc[2 * kk + 1][3]);
                const int key0 = (r0 + kk) * 64 + kc0 + 4 * g;
#pragma unroll
                for (int dt = 0; dt < 4; ++dt) {
                    const bf16_t* vp = VT + (size_t)(16 * dt + lr) * SEQ + key0;
                    union { bf16x8 v; u32x2 h[2]; } vf;
                    vf.h[0] = *(const u32x2*)vp; vf.h[1] = *(const u32x2*)(vp + 16);
                    o[dt] = __builtin_amdgcn_mfma_f32_16x16x32_bf16(vf.v, pf.v, o[dt], 0, 0, 0);
                }
            }
            const float inv = 1.f / sum; float sq = 0.f;
            const int tok = b * SEQ + r * 64 + c0 + lr;
#pragma unroll
            for (int dt = 0; dt < 4; ++dt) {
                const f32x4 v = o[dt] * inv; sq += v.x * v.x + v.y * v.y + v.z * v.z + v.w * v.w;
                u32x2 ov; ov.x = pk2(v.x, v.y); ov.y = pk2(v.z, v.w);
                *(u32x2*)(ATT + (size_t)tok * DM + h * 64 + 16 * dt + 4 * g) = ov;
            }
            sq += __shfl_xor(sq, 16); sq += __shfl_xor(sq, 32);
            if (g == 0) SSQ[tok * 16 + h] = sq;
        } else {
            const int r = it - N_NA, qt = r & 511, kvh = (r >> 9) & 1, b = r >> 10;
            const int hq = kvh * 4 + w, q0p = qt * 16, kb = q0p - 128;
            const bf16_t* Q = (const bf16_t*)(P.ws + WS_SWQ) + ((size_t)(b * 8 + hq) * SEQ) * 64;
            const bf16_t* K = (const bf16_t*)(P.ws + WS_SWK) + ((size_t)(b * 2 + kvh) * SEQ) * 64;
            const bf16_t* VT = (const bf16_t*)(P.ws + WS_SWVT) + ((size_t)(b * 2 + kvh) * 64) * SEQ;
            const bf16_t* qp = Q + (size_t)(q0p + lr) * 64 + 8 * g;
            const bf16x8 q0 = *(const bf16x8*)qp, q1 = *(const bf16x8*)(qp + 32);
            f32x4 sc[18];
            const float sk = P.swa_sinks[hq] * LOG2E;
            float mx = sk;
#pragma unroll
            for (int tt = 0; tt < 18; ++tt) {
                const int kt0 = kb + 16 * tt;
                f32x4 a = {0.f, 0.f, 0.f, 0.f};
                const bool tile_ok = (tt < 17) && (kt0 >= 0) && (kt0 < SEQ);
                if (tile_ok) {
                    const bf16_t* kp = K + (size_t)(kt0 + lr) * 64 + 8 * g;
                    const bf16x8 k0 = *(const bf16x8*)kp, k1 = *(const bf16x8*)(kp + 32);
                    a = __builtin_amdgcn_mfma_f32_16x16x32_bf16(k0, q0, a, 0, 0, 0);
                    a = __builtin_amdgcn_mfma_f32_16x16x32_bf16(k1, q1, a, 0, 0, 0);
                }
#pragma unroll
                for (int e = 0; e < 4; ++e) {
                    const int dlt = 16 * tt + 4 * g + e - lr;
                    const bool ok = tile_ok && dlt >= 0 && dlt <= 256;
                    const float v = ok ? a[e] : -3.0e38f;
                    a[e] = v; mx = fmaxf(mx, v);
                }
                sc[tt] = a;
            }
            mx = fmaxf(mx, __shfl_xor(mx, 16)); mx = fmaxf(mx, __shfl_xor(mx, 32));
            float sum = 0.f;
#pragma unroll
            for (int tt = 0; tt < 18; ++tt)
#pragma unroll
                for (int e = 0; e < 4; ++e) { const float p = exp2f(sc[tt][e] - mx); sc[tt][e] = p; sum += p; }
            sum += __shfl_xor(sum, 16); sum += __shfl_xor(sum, 32);
            sum += exp2f(sk - mx);
            f32x4 o[4];
#pragma unroll
            for (int dt = 0; dt < 4; ++dt) o[dt] = (f32x4){0.f, 0.f, 0.f, 0.f};
#pragma unroll
            for (int kk = 0; kk < 9; ++kk) {
                union { bf16x8 v; unsigned u[4]; } pf;
                pf.u[0] = pk2(sc[2 * kk][0], sc[2 * kk][1]); pf.u[1] = pk2(sc[2 * kk][2], sc[2 * kk][3]);
                pf.u[2] = pk2(sc[2 * kk + 1][0], sc[2 * kk + 1][1]); pf.u[3] = pk2(sc[2 * kk + 1][2], sc[2 * kk + 1][3]);
                const int key0 = kb + 32 * kk + 4 * g, key1 = key0 + 16;
                const bool ok0 = key0 >= 0 && key0 < SEQ, ok1 = (2 * kk + 1 < 17) && key1 >= 0 && key1 < SEQ;
#pragma unroll
                for (int dt = 0; dt < 4; ++dt) {
                    const bf16_t* vp = VT + (size_t)(16 * dt + lr) * SEQ;
                    union { bf16x8 v; u32x2 h[2]; } vf;
                    vf.h[0] = ok0 ? *(const u32x2*)(vp + key0) : (u32x2){0u, 0u};
                    vf.h[1] = ok1 ? *(const u32x2*)(vp + key1) : (u32x2){0u, 0u};
                    o[dt] = __builtin_amdgcn_mfma_f32_16x16x32_bf16(vf.v, pf.v, o[dt], 0, 0, 0);
                }
            }
            const float inv = 1.f / sum; float sq = 0.f;
            const int tok = b * SEQ + q0p + lr;
#pragma unroll
            for (int dt = 0; dt < 4; ++dt) {
                const f32x4 v = o[dt] * inv; sq += v.x * v.x + v.y * v.y + v.z * v.z + v.w * v.w;
                u32x2 ov; ov.x = pk2(v.x, v.y); ov.y = pk2(v.z, v.w);
                *(u32x2*)(ATT + (size_t)tok * DM + 512 + hq * 64 + 16 * dt + 4 * g) = ov;
            }
            sq += __shfl_xor(sq, 16); sq += __shfl_xor(sq, 32);
            if (g == 0) SSQ[tok * 16 + 8 + hq] = sq;
        }
    }
}
#endif

DEVINL void phase4a(const Params& P, unsigned char* smem) {
    const int t = threadIdx.x, lane = t & 63, w = t >> 6, wm = w & 1, wn = w >> 1, lr = lane & 15, g = lane >> 4, ldrow = t >> 3;
    const bf16_t* A = (const bf16_t*)(P.ws + WS_ATT); const bf16_t* Wt = (const bf16_t*)(P.ws + WS_WOUT);
    const float* SSQ = (const float*)(P.ws + WS_SSQ);
    bf16_t* MIX = (bf16_t*)(P.ws + WS_H);
    constexpr int TN = 8, TM = NT / 128;
    for (int it = blockIdx.x; it < TN * TM; it += gridDim.x) {
        const int tm = it / TN, tn = it % TN, m0 = tm * 128, n0 = tn * 128;
        const bf16_t* ab = A + (size_t)(m0 + ldrow) * DM; const bf16_t* bb = Wt + (size_t)(n0 + ldrow) * DM;
        float rna[4], rsw[4];
#pragma unroll
        for (int mi = 0; mi < 4; ++mi) {
            const float* sp = SSQ + (size_t)(m0 + 64 * wm + 16 * mi + lr) * 16;
            const f32x4 a = *(const f32x4*)sp, b2 = *(const f32x4*)(sp + 4), c2 = *(const f32x4*)(sp + 8), d2 = *(const f32x4*)(sp + 12);
            rna[mi] = rsqrtf((a.x + a.y + a.z + a.w + b2.x + b2.y + b2.z + b2.w) * (1.f / 512.f) + EPS);
            rsw[mi] = rsqrtf((c2.x + c2.y + c2.z + c2.w + d2.x + d2.y + d2.z + d2.w) * (1.f / 512.f) + EPS);
        }
        f32x4 acc[4][4]; zero_acc(acc);
        gemm_core(acc, ab, ab + 32 * DM, ab + 64 * DM, ab + 96 * DM, bb, bb + 32 * DM, bb + 64 * DM, bb + 96 * DM, 0, 512, smem);
#pragma unroll
        for (int mi = 0; mi < 4; ++mi) { const float f = rna[mi] / rsw[mi];
#pragma unroll
            for (int ni = 0; ni < 4; ++ni) acc[ni][mi] = acc[ni][mi] * f; }
        gemm_core(acc, ab, ab + 32 * DM, ab + 64 * DM, ab + 96 * DM, bb, bb + 32 * DM, bb + 64 * DM, bb + 96 * DM, 512, 1024, smem);
#pragma unroll
        for (int mi = 0; mi < 4; ++mi) {
            const int m = m0 + 64 * wm + 16 * mi + lr;
#pragma unroll
            for (int ni = 0; ni < 4; ++ni) {
                const f32x4 v = acc[ni][mi] * rsw[mi];
                u32x2 o; o.x = pk2(v.x, v.y); o.y = pk2(v.z, v.w);
                *(u32x2*)(MIX + (size_t)m * DM + n0 + 64 * wn + 16 * ni + 4 * g) = o;
            }
        }
    }
}

DEVINL void phase4b(const Params& P) {
    const int lane = threadIdx.x & 63, gw = blockIdx.x * 4 + (threadIdx.x >> 6), ngw = gridDim.x * 4;
    const float* mod = (const float*)(P.ws + WS_MOD);
    bf16_t* H = (bf16_t*)(P.ws + WS_H);
    unsigned* cnt = (unsigned*)(P.ws + WS_CNT);
    int* ltok = (int*)(P.ws + WS_LTOK); float* lw = (float*)(P.ws + WS_LW);
    for (int row = gw; row < NT; row += ngw) {
        const float* mb = mod + (row >> 13) * 6144;
        f32x4 mx[4]; float ss = 0.f;
#pragma unroll
        for (int j = 0; j < 4; ++j) {
            const u32x2 raw = *(const u32x2*)(H + (size_t)row * DM + 4 * lane + 256 * j);
            mx[j] = (f32x4){bflo(raw.x), bfhi(raw.x), bflo(raw.y), bfhi(raw.y)};
            ss += mx[j].x * mx[j].x + mx[j].y * mx[j].y + mx[j].z * mx[j].z + mx[j].w * mx[j].w;
        }
        ss = wave_sum(ss);
        const float rstd = rsqrtf(ss * (1.f / DM) + EPS);
        f32x4 x1[4]; float s1 = 0.f;
#pragma unroll
        for (int j = 0; j < 4; ++j) {
            const int col = 4 * lane + 256 * j;
            const f32x4 xv = *(const f32x4*)(P.x + (size_t)row * DM + col), gp = *(const f32x4*)(P.g_post_mix + col), ga = *(const f32x4*)(mb + 2048 + col);
            x1[j] = xv + ga * (mx[j] * rstd * gp);
            *(f32x4*)(P.out + (size_t)row * DM + col) = x1[j];
            s1 += x1[j].x * x1[j].x + x1[j].y * x1[j].y + x1[j].z * x1[j].z + x1[j].w * x1[j].w;
        }
        s1 = wave_sum(s1);
        const float rstd1 = rsqrtf(s1 * (1.f / DM) + EPS);
        f32x4 hv[4];
#pragma unroll
        for (int j = 0; j < 4; ++j) {
            const int col = 4 * lane + 256 * j;
            const f32x4 gp = *(const f32x4*)(P.g_pre_ffn + col), sc = *(const f32x4*)(mb + 4096 + col), sh = *(const f32x4*)(mb + 3072 + col);
            hv[j] = x1[j] * rstd1 * gp * (sc + 1.f) + sh;
            u32x2 o; o.x = pk2(hv[j].x, hv[j].y); o.y = pk2(hv[j].z, hv[j].w);
            *(u32x2*)(H + (size_t)row * DM + col) = o;
        }
        f32x4 gl = {0.f, 0.f, 0.f, 0.f};
#pragma unroll
        for (int j = 0; j < 4; ++j) {
            const float* wp = P.w_gr + (size_t)(4 * lane + 256 * j) * 4;
            gl += *(const f32x4*)(wp) * hv[j].x; gl += *(const f32x4*)(wp + 4) * hv[j].y; gl += *(const f32x4*)(wp + 8) * hv[j].z; gl += *(const f32x4*)(wp + 12) * hv[j].w;
        }
        gl.x = wave_sum(gl.x); gl.y = wave_sum(gl.y); gl.z = wave_sum(gl.z); gl.w = wave_sum(gl.w);
        int gtop = 0; float gm = gl.x;
        if (gl.y > gm) { gm = gl.y; gtop = 1; } if (gl.z > gm) { gm = gl.z; gtop = 2; } if (gl.w > gm) { gm = gl.w; gtop = 3; }
        const float gwt = 1.f / (expf(gl.x - gm) + expf(gl.y - gm) + expf(gl.z - gm) + expf(gl.w - gm));
        const float* we = P.w_er + (size_t)gtop * 1024 * 8;
        f32x4 ea = {0.f, 0.f, 0.f, 0.f}, eb = {0.f, 0.f, 0.f, 0.f};
#pragma unroll
        for (int j = 0; j < 4; ++j) {
            const float* wp = we + (size_t)(4 * lane + 256 * j) * 8;
            ea += *(const f32x4*)(wp) * hv[j].x;      eb += *(const f32x4*)(wp + 4) * hv[j].x;
            ea += *(const f32x4*)(wp + 8) * hv[j].y;  eb += *(const f32x4*)(wp + 12) * hv[j].y;
            ea += *(const f32x4*)(wp + 16) * hv[j].z; eb += *(const f32x4*)(wp + 20) * hv[j].z;
            ea += *(const f32x4*)(wp + 24) * hv[j].w; eb += *(const f32x4*)(wp + 28) * hv[j].w;
        }
        const float e0 = wave_sum(ea.x), e1 = wave_sum(ea.y), e2 = wave_sum(ea.z), e3 = wave_sum(ea.w), e4 = wave_sum(eb.x), e5 = wave_sum(eb.y), e6 = wave_sum(eb.z), e7 = wave_sum(eb.w);
        int i1 = 0; float v1 = e0;
        if (e1 > v1) { v1 = e1; i1 = 1; } if (e2 > v1) { v1 = e2; i1 = 2; } if (e3 > v1) { v1 = e3; i1 = 3; }
        if (e4 > v1) { v1 = e4; i1 = 4; } if (e5 > v1) { v1 = e5; i1 = 5; } if (e6 > v1) { v1 = e6; i1 = 6; } if (e7 > v1) { v1 = e7; i1 = 7; }
        int i2 = -1; float v2 = -3.0e38f;
        if (i1 != 0 && e0 > v2) { v2 = e0; i2 = 0; } if (i1 != 1 && e1 > v2) { v2 = e1; i2 = 1; } if (i1 != 2 && e2 > v2) { v2 = e2; i2 = 2; } if (i1 != 3 && e3 > v2) { v2 = e3; i2 = 3; }
        if (i1 != 4 && e4 > v2) { v2 = e4; i2 = 4; } if (i1 != 5 && e5 > v2) { v2 = e5; i2 = 5; } if (i1 != 6 && e6 > v2) { v2 = e6; i2 = 6; } if (i1 != 7 && e7 > v2) { v2 = e7; i2 = 7; }
        const float ex = expf(v2 - v1), w1 = gwt / (1.f + ex), w2 = gwt * ex / (1.f + ex);
        if (lane == 0) {
            const int ea1 = gtop * 8 + i1, ea2 = gtop * 8 + i2;
            const unsigned p1 = atomicAdd(&cnt[ea1], 1u); ltok[ea1 * NT + p1] = row * 2;     lw[ea1 * NT + p1] = w1;
            const unsigned p2 = atomicAdd(&cnt[ea2], 1u); ltok[ea2 * NT + p2] = row * 2 + 1; lw[ea2 * NT + p2] = w2;
        }
    }
}

DEVINL void phase5a(const Params& P, unsigned char* smem) {
    const int t = threadIdx.x, lane = t & 63, w = t >> 6, wm = w & 1, wn = w >> 1, lr = lane & 15, g = lane >> 4, ldrow = t >> 3;
    const bf16_t* H = (const bf16_t*)(P.ws + WS_H); const bf16_t* Wgu = (const bf16_t*)(P.ws + WS_WGU);
    const unsigned* cnt = (const unsigned*)(P.ws + WS_CNT); const int* ltok = (const int*)(P.ws + WS_LTOK);
    bf16_t* HID = (bf16_t*)(P.ws + WS_HID);
    int total = 0;
    for (int e = 0; e < 32; ++e) total += ((int)cnt[e] + 127) >> 7;
    for (int it = blockIdx.x; it < total * 4; it += gridDim.x) {
        const int tn = it & 3; int mt = it >> 2, e = 0, off = 0;
        for (; e < 32; ++e) { const int c = (int)cnt[e], nt = (c + 127) >> 7; if (mt < nt) break; mt -= nt; off += c; }
        const int ce = (int)cnt[e], n0 = tn * 128;
        const bf16_t* ar[4];
#pragma unroll
        for (int i = 0; i < 4; ++i) { const int r = mt * 128 + ldrow + 32 * i; const int tok = (r < ce) ? (ltok[e * NT + r] >> 1) : 0; ar[i] = H + (size_t)tok * DM; }
        const bf16_t* bb = Wgu + ((size_t)e * 512 + n0 + ldrow) * DM;
        f32x4 acc[4][4]; zero_acc(acc);
        gemm_core(acc, ar[0], ar[1], ar[2], ar[3], bb, bb + 32 * DM, bb + 64 * DM, bb + 96 * DM, 0, DM, smem);
#pragma unroll
        for (int mi = 0; mi < 4; ++mi) {
            const int r = mt * 128 + 64 * wm + 16 * mi + lr;
            if (r < ce) {
#pragma unroll
                for (int p = 0; p < 2; ++p) {
                    const f32x4 gt = acc[2 * p][mi], up = acc[2 * p + 1][mi];
                    f32x4 hd; hd.x = silu_f(gt.x) * up.x; hd.y = silu_f(gt.y) * up.y; hd.z = silu_f(gt.z) * up.z; hd.w = silu_f(gt.w) * up.w;
                    u32x2 o; o.x = pk2(hd.x, hd.y); o.y = pk2(hd.z, hd.w);
                    *(u32x2*)(HID + (size_t)(off + r) * 256 + (n0 >> 1) + 32 * wn + 16 * p + 4 * g) = o;
                }
            }
        }
    }
}
DEVINL void phase5b(const Params& P, unsigned char* smem) {
    const int t = threadIdx.x, lane = t & 63, w = t >> 6, wm = w & 1, wn = w >> 1, lr = lane & 15, g = lane >> 4, ldrow = t >> 3;
    const bf16_t* HID = (const bf16_t*)(P.ws + WS_HID); const bf16_t* Wd = (const bf16_t*)(P.ws + WS_WD);
    const unsigned* cnt = (const unsigned*)(P.ws + WS_CNT); const int* ltok = (const int*)(P.ws + WS_LTOK); const float* lw = (const float*)(P.ws + WS_LW);
    bf16_t* Y = (bf16_t*)(P.ws + WS_Y);
    int total = 0;
    for (int e = 0; e < 32; ++e) total += ((int)cnt[e] + 127) >> 7;
    for (int it = blockIdx.x; it < total * 8; it += gridDim.x) {
        const int tn = it & 7; int mt = it >> 3, e = 0, off = 0;
        for (; e < 32; ++e) { const int c = (int)cnt[e], nt = (c + 127) >> 7; if (mt < nt) break; mt -= nt; off += c; }
        const int ce = (int)cnt[e], n0 = tn * 128;
        const bf16_t* ar[4];
#pragma unroll
        for (int i = 0; i < 4; ++i) { int r = mt * 128 + ldrow + 32 * i; r = r < ce ? r : ce - 1; ar[i] = HID + (size_t)(off + r) * 256; }
        const bf16_t* bb = Wd + ((size_t)e * 1024 + n0 + ldrow) * 256;
        f32x4 acc[4][4]; zero_acc(acc);
        gemm_core(acc, ar[0], ar[1], ar[2], ar[3], bb, bb + 32 * 256, bb + 64 * 256, bb + 96 * 256, 0, 256, smem);
#pragma unroll
        for (int mi = 0; mi < 4; ++mi) {
            const int r = mt * 128 + 64 * wm + 16 * mi + lr;
            if (r < ce) {
                const int ent = ltok[e * NT + r]; const float wt = lw[e * NT + r];
                bf16_t* yp = Y + ((size_t)(ent & 1) * NT + (ent >> 1)) * DM + n0 + 64 * wn + 4 * g;
#pragma unroll
                for (int ni = 0; ni < 4; ++ni) { const f32x4 v = acc[ni][mi] * wt; u32x2 o; o.x = pk2(v.x, v.y); o.y = pk2(v.z, v.w); *(u32x2*)(yp + 16 * ni) = o; }
            }
        }
    }
}
DEVINL void phase6(const Params& P) {
    const int lane = threadIdx.x & 63, gw = blockIdx.x * 4 + (threadIdx.x >> 6), ngw = gridDim.x * 4;
    const float* mod = (const float*)(P.ws + WS_MOD);
    const bf16_t* Y = (const bf16_t*)(P.ws + WS_Y);
    for (int row = gw; row < NT; row += ngw) {
        const float* mb = mod + (row >> 13) * 6144;
        f32x4 y[4]; float ss = 0.f;
#pragma unroll
        for (int j = 0; j < 4; ++j) {
            const int col = 4 * lane + 256 * j;
            const u32x2 a = *(const u32x2*)(Y + (size_t)row * DM + col), b = *(const u32x2*)(Y + ((size_t)NT + row) * DM + col);
            y[j] = (f32x4){bflo(a.x) + bflo(b.x), bfhi(a.x) + bfhi(b.x), bflo(a.y) + bflo(b.y), bfhi(a.y) + bfhi(b.y)};
            ss += y[j].x * y[j].x + y[j].y * y[j].y + y[j].z * y[j].z + y[j].w * y[j].w;
        }
        ss = wave_sum(ss);
        const float rstd = rsqrtf(ss * (1.f / DM) + EPS);
#pragma unroll
        for (int j = 0; j < 4; ++j) {
            const int col = 4 * lane + 256 * j;
            const f32x4 x1 = *(const f32x4*)(P.out + (size_t)row * DM + col), gp = *(const f32x4*)(P.g_post_ffn + col), gf = *(const f32x4*)(mb + 5120 + col);
            *(f32x4*)(P.out + (size_t)row * DM + col) = x1 + gf * (y[j] * rstd * gp);
        }
    }
}

constexpr int NPHASE = 9;
__global__ void __launch_bounds__(256, 2) fwd_kernel(Params P) {
    extern __shared__ __attribute__((aligned(16))) unsigned char smem[];
#if N_LAUNCH_MODE == 1
    cg::grid_group grid = cg::this_grid();
#define SEAM(k) do { if (P.ph_lo <= (k) && (k) + 1 < P.ph_hi) grid.sync(); } while (0)
#else
#define SEAM(k) do { } while (0)
#endif
#define IN(k) (P.ph_lo <= (k) && (k) < P.ph_hi)
    if (IN(0)) { phase0(P, smem); }  SEAM(0);
    if (IN(1)) { phase1(P); }        SEAM(1);
    if (IN(2)) { phase2(P, smem); }  SEAM(2);
    if (IN(3)) { phase3(P, smem); }  SEAM(3);
    if (IN(4)) { phase4a(P, smem); } SEAM(4);
    if (IN(5)) { phase4b(P); }       SEAM(5);
    if (IN(6)) { phase5a(P, smem); } SEAM(6);
    if (IN(7)) { phase5b(P, smem); } SEAM(7);
    if (IN(8)) { phase6(P); }
#undef IN
#undef SEAM
}

extern "C" void kernel_launch(void* const* d_in, const int* in_sizes, int n_in, void* d_out, int out_size, void* d_ws, size_t ws_size, hipStream_t stream) {
    static int grid_blocks = 0;
    if (!grid_blocks) {
        if (ws_size < WS_END) { fprintf(stderr, "kernel_launch: workspace too small (%zu < %zu)\n", ws_size, (size_t)WS_END); grid_blocks = -1; return; }
        int dev = 0, cus = 0, per_cu = 0;
        hipGetDevice(&dev);
        hipDeviceGetAttribute(&cus, hipDeviceAttributeMultiprocessorCount, dev);
        hipFuncSetAttribute((const void*)fwd_kernel, hipFuncAttributeMaxDynamicSharedMemorySize, LDS_BYTES);
        hipOccupancyMaxActiveBlocksPerMultiprocessor(&per_cu, (const void*)fwd_kernel, 256, LDS_BYTES);
        if (per_cu > 2) per_cu = 2;
        if (per_cu < 1) per_cu = 1;
        grid_blocks = cus * per_cu;
        fprintf(stderr, "kernel_launch: %d CUs x %d blocks\n", cus, per_cu);
    }
    if (grid_blocks < 0) return;
    Params p{};
    const float** pp = (const float**)&p;
    for (int i = 0; i < 19; ++i) pp[i] = (const float*)d_in[i];
    p.out = (float*)d_out; p.ws = (unsigned char*)d_ws;
#if N_LAUNCH_MODE == 1
    p.ph_lo = 0; p.ph_hi = NPHASE;
    void* args[] = {&p};
    hipError_t e = hipLaunchCooperativeKernel((const void*)fwd_kernel, dim3(grid_blocks), dim3(256), args, LDS_BYTES, stream);
    if (e != hipSuccess) fprintf(stderr, "cooperative launch failed: %s (grid %d)\n", hipGetErrorString(e), grid_blocks);
#else
    for (int ph = 0; ph < NPHASE; ++ph) {
        p.ph_lo = ph; p.ph_hi = ph + 1;
        hipLaunchKernelGGL(fwd_kernel, dim3(grid_blocks), dim3(256), LDS_BYTES, stream, p);
    }
#endif
}
```

```cpp
#include <hip/hip_runtime.h>
#include <hip/hip_cooperative_groups.h>
#include <stdint.h>
#include <stdio.h>
namespace cg = cooperative_groups;

#ifndef NAIVE_GEMM
#define NAIVE_GEMM 0
#endif
#ifndef NAIVE_ATTN
#define NAIVE_ATTN 0
#endif
#ifndef N_LAUNCH_MODE
#define N_LAUNCH_MODE 2
#endif

#define DEVINL __device__ __forceinline__

typedef unsigned short bf16_t;
typedef short bf16x8 __attribute__((ext_vector_type(8)));
typedef float f32x4 __attribute__((ext_vector_type(4)));
typedef unsigned u32x4 __attribute__((ext_vector_type(4)));
typedef unsigned u32x2 __attribute__((ext_vector_type(2)));

constexpr int SEQ = 8192, DM = 1024, NT = 2 * SEQ;
constexpr int QKVW = 2304;
constexpr float EPS = 1e-6f;
constexpr float LOG2E = 1.4426950408889634f;
constexpr float QSCALE = 0.125f * LOG2E;

constexpr size_t MiB = 1u << 20;
constexpr size_t WS_CNT  = 0;
constexpr size_t WS_MOD  = 1 * MiB;
constexpr size_t WS_ROPE = 2 * MiB;
constexpr size_t WS_WQKV = 4 * MiB;
constexpr size_t WS_WOUT = 9 * MiB;
constexpr size_t WS_WGU  = 11 * MiB;
constexpr size_t WS_WD   = 43 * MiB;
constexpr size_t WS_H    = 59 * MiB;
constexpr size_t WS_NAQ  = 91 * MiB;
constexpr size_t WS_NAK  = 107 * MiB;
constexpr size_t WS_NAVT = 123 * MiB;
constexpr size_t WS_SWQ  = 139 * MiB;
constexpr size_t WS_SWK  = 155 * MiB;
constexpr size_t WS_SWVT = 159 * MiB;
constexpr size_t WS_ATT  = 163 * MiB;
constexpr size_t WS_SSQ  = 195 * MiB;
constexpr size_t WS_LTOK = 196 * MiB;
constexpr size_t WS_LW   = 198 * MiB;
constexpr size_t WS_HID  = 200 * MiB;
constexpr size_t WS_Y    = 91 * MiB;
constexpr size_t WS_END  = 218 * MiB;

constexpr int LDS_BYTES = 65536 + 4096;

struct Params {
    const float *x, *c, *w_ada, *b_ada, *g_pre_mix, *w_in, *na_rpb, *swa_sinks, *beta_na, *beta_swa, *w_out, *g_post_mix, *g_pre_ffn,
                *w_gr, *w_er, *w_gate, *w_up, *w_down, *g_post_ffn;
    float* out; unsigned char* ws; int ph_lo, ph_hi;
};

DEVINL unsigned f2bf(float f) { unsigned u = __float_as_uint(f); return (u + 0x7fffu + ((u >> 16) & 1u)) >> 16; }
DEVINL unsigned pk2(float lo, float hi) { return f2bf(lo) | (f2bf(hi) << 16); }
DEVINL float bf2f(bf16_t v) { return __uint_as_float(((unsigned)v) << 16); }
DEVINL float bflo(unsigned u) { return __uint_as_float(u << 16); }
DEVINL float bfhi(unsigned u) { return __uint_as_float(u & 0xffff0000u); }
DEVINL float wave_sum(float v) {
#pragma unroll
    for (int o = 32; o >= 1; o >>= 1) v += __shfl_xor(v, o);
    return v;
}
DEVINL float silu_f(float v) { return v / (1.f + expf(-v)); }

DEVINL void mod_item(const Params& P, int item, unsigned char* smem) {
    float* s_silu = (float*)smem;
    float* s_red  = s_silu + 2048;
    const int t = threadIdx.x;
    for (int i = t; i < 2048; i += 256) s_silu[i] = silu_f(P.c[i]);
    __syncthreads();
    const int c4 = t & 7, rg = t >> 3, col = item * 32 + c4 * 4;
    f32x4 a0 = {0.f, 0.f, 0.f, 0.f}, a1 = {0.f, 0.f, 0.f, 0.f};
#pragma unroll 4
    for (int i = 0; i < 32; ++i) {
        const int k = rg + 32 * i;
        const f32x4 w = *(const f32x4*)(P.w_ada + (size_t)k * 6144 + col);
        a0 += w * s_silu[k]; a1 += w * s_silu[1024 + k];
    }
    *(f32x4*)(s_red + (rg * 2 + 0) * 32 + c4 * 4) = a0;
    *(f32x4*)(s_red + (rg * 2 + 1) * 32 + c4 * 4) = a1;
    __syncthreads();
    if (t < 64) {
        const int b = t >> 5, cc = t & 31; float s = 0.f;
        for (int r = 0; r < 32; ++r) s += s_red[(r * 2 + b) * 32 + cc];
        ((float*)(P.ws + WS_MOD))[b * 6144 + item * 32 + cc] = s + P.b_ada[item * 32 + cc];
    }
    __syncthreads();
}
DEVINL void transpose_item(const float* src, int N, int k0, int n0, bf16_t* dst, int ldd, int mode, const float* kscale, unsigned char* smem) {
    float* scr = (float*)smem;
    const int t = threadIdx.x;
#pragma unroll
    for (int p = 0; p < 4; ++p) {
        const int r = (t >> 4) + 16 * p;
        f32x4 v = *(const f32x4*)(src + (size_t)(k0 + r) * N + n0 + (t & 15) * 4);
        const float sc = kscale ? kscale[r] : 1.f;
        float* d = scr + r * 65 + (t & 15) * 4;
        d[0] = v.x * sc; d[1] = v.y * sc; d[2] = v.z * sc; d[3] = v.w * sc;
    }
    __syncthreads();
    const int n = t >> 2, kq = t & 3;
    u32x4 w0, w1;
    const float* s = scr + (kq * 16) * 65 + n;
    w0.x = pk2(s[0 * 65], s[1 * 65]);   w0.y = pk2(s[2 * 65], s[3 * 65]);   w0.z = pk2(s[4 * 65], s[5 * 65]);   w0.w = pk2(s[6 * 65], s[7 * 65]);
    w1.x = pk2(s[8 * 65], s[9 * 65]);   w1.y = pk2(s[10 * 65], s[11 * 65]); w1.z = pk2(s[12 * 65], s[13 * 65]); w1.w = pk2(s[14 * 65], s[15 * 65]);
    const int j = n0 + n;
    int drow = j;
    if (mode == 1) drow = (j >> 4) * 32 + (j & 15);
    if (mode == 2) drow = (j >> 4) * 32 + 16 + (j & 15);
    bf16_t* o = dst + (size_t)drow * ldd + k0 + kq * 16;
    *(u32x4*)o = w0; *(u32x4*)(o + 8) = w1;
    __syncthreads();
}
DEVINL void phase0(const Params& P, unsigned char* smem) {
    const int t = threadIdx.x;
    if (blockIdx.x == 0 && t < 64) ((unsigned*)(P.ws + WS_CNT))[t] = 0u;
    {
        float* rc = (float*)(P.ws + WS_ROPE); float* rs = rc + SEQ * 32;
        for (int i = blockIdx.x * 256 + t; i < SEQ * 32; i += gridDim.x * 256) {
            const int pos = i >> 5, fi = i & 31;
            const float ex = -((float)fi * 2.0f) / 64.0f;
            const float inv = exp2f(ex * 13.287712379549449f);
            const float ang = (float)pos * inv;
            double tt = (double)ang * 0.15915494309189535; tt -= floor(tt);
            const float fr = (float)tt;
            rc[i] = __builtin_amdgcn_cosf(fr); rs[i] = __builtin_amdgcn_sinf(fr);
        }
    }
    bf16_t* Wqkv = (bf16_t*)(P.ws + WS_WQKV); bf16_t* Wout = (bf16_t*)(P.ws + WS_WOUT);
    bf16_t* Wgu = (bf16_t*)(P.ws + WS_WGU);   bf16_t* Wd = (bf16_t*)(P.ws + WS_WD);
    constexpr int NMOD = 192, NI_IN = 16 * 36, NI_OUT = 256, NI_E = 2048;
    constexpr int total = NMOD + NI_IN + NI_OUT + 3 * NI_E;
    for (int it = blockIdx.x; it < total; it += gridDim.x) {
        int r = it;
        if (r < NMOD) { mod_item(P, r, smem); continue; } r -= NMOD;
        if (r < NI_IN) { const int kb = r / 36, nb = r % 36; transpose_item(P.w_in, QKVW, kb * 64, nb * 64, Wqkv, 1024, 0, nullptr, smem); continue; } r -= NI_IN;
        if (r < NI_OUT) { const int kb = r >> 4, nb = r & 15; const int k0 = kb * 64;
            const float* ks = (k0 < 512) ? (P.beta_na + k0) : (P.beta_swa + (k0 - 512));
            transpose_item(P.w_out, 1024, k0, nb * 64, Wout, 1024, 0, ks, smem); continue; } r -= NI_OUT;
        if (r < NI_E) { const int e = r >> 6, q = r & 63, kb = q >> 2, nb = q & 3;
            transpose_item(P.w_gate + (size_t)e * 1024 * 256, 256, kb * 64, nb * 64, Wgu + (size_t)e * 512 * 1024, 1024, 1, nullptr, smem); continue; } r -= NI_E;
        if (r < NI_E) { const int e = r >> 6, q = r & 63, kb = q >> 2, nb = q & 3;
            transpose_item(P.w_up + (size_t)e * 1024 * 256, 256, kb * 64, nb * 64, Wgu + (size_t)e * 512 * 1024, 1024, 2, nullptr, smem); continue; } r -= NI_E;
        { const int e = r >> 6, q = r & 63, kb = q >> 4, nb = q & 15;
            transpose_item(P.w_down + (size_t)e * 256 * 1024, 1024, kb * 64, nb * 64, Wd + (size_t)e * 1024 * 256, 256, 0, nullptr, smem); }
    }
}

DEVINL void phase1(const Params& P) {
    const int lane = threadIdx.x & 63, gw = blockIdx.x * 4 + (threadIdx.x >> 6), ngw = gridDim.x * 4;
    const float* mod = (const float*)(P.ws + WS_MOD);
    bf16_t* H = (bf16_t*)(P.ws + WS_H);
    for (int row = gw; row < NT; row += ngw) {
        const f32x4* xr = (const f32x4*)(P.x + (size_t)row * DM) + lane;
        f32x4 v[4]; float ss = 0.f;
#pragma unroll
        for (int j = 0; j < 4; ++j) { v[j] = xr[64 * j]; ss += v[j].x * v[j].x + v[j].y * v[j].y + v[j].z * v[j].z + v[j].w * v[j].w; }
        ss = wave_sum(ss);
        const float rstd = rsqrtf(ss * (1.f / DM) + EPS);
        const float* mb = mod + (row >> 13) * 6144;
#pragma unroll
        for (int j = 0; j < 4; ++j) {
            const int col = 4 * lane + 256 * j;
            const f32x4 g = *(const f32x4*)(P.g_pre_mix + col), sc = *(const f32x4*)(mb + 1024 + col), sh = *(const f32x4*)(mb + col);
            const f32x4 h = v[j] * rstd * g * (sc + 1.f) + sh;
            u32x2 o; o.x = pk2(h.x, h.y); o.y = pk2(h.z, h.w);
            *(u32x2*)(H + (size_t)row * DM + col) = o;
        }
    }
}

DEVINL int lds_off(int row, int chunk) { return row * 128 + ((chunk ^ ((row >> 1) & 7)) << 4); }

DEVINL void gemm_core(f32x4 (&acc)[4][4], const bf16_t* a0, const bf16_t* a1, const bf16_t* a2, const bf16_t* a3,
                      const bf16_t* b0, const bf16_t* b1, const bf16_t* b2, const bf16_t* b3, int kbeg, int kend, unsigned char* smem) {
    const int t = threadIdx.x, lane = t & 63, w = t >> 6, wm = w & 1, wn = w >> 1, lr = lane & 15, g = lane >> 4;
    const int ldrow = t >> 3, ldc = t & 7;
#if NAIVE_GEMM
    const bf16_t** sp = (const bf16_t**)(smem + 65536);
    __syncthreads();
    if (ldc == 0) { sp[ldrow] = a0; sp[ldrow + 32] = a1; sp[ldrow + 64] = a2; sp[ldrow + 96] = a3;
                    sp[128 + ldrow] = b0; sp[128 + ldrow + 32] = b1; sp[128 + ldrow + 64] = b2; sp[128 + ldrow + 96] = b3; }
    __syncthreads();
#pragma unroll
    for (int ni = 0; ni < 4; ++ni)
#pragma unroll
        for (int mi = 0; mi < 4; ++mi) {
            const bf16_t* ap = sp[64 * wm + 16 * mi + lr];
#pragma unroll
            for (int reg = 0; reg < 4; ++reg) {
                const bf16_t* bp = sp[128 + 64 * wn + 16 * ni + 4 * g + reg];
                float s = 0.f;
#pragma unroll 1
                for (int k = kbeg; k < kend; k += 8) {
                    const u32x4 av = *(const u32x4*)(ap + k), bv = *(const u32x4*)(bp + k);
                    s += bflo(av.x) * bflo(bv.x) + bfhi(av.x) * bfhi(bv.x) + bflo(av.y) * bflo(bv.y) + bfhi(av.y) * bfhi(bv.y)
                       + bflo(av.z) * bflo(bv.z) + bfhi(av.z) * bfhi(bv.z) + bflo(av.w) * bflo(bv.w) + bfhi(av.w) * bfhi(bv.w);
                }
                acc[ni][mi][reg] += s;
            }
        }
    __syncthreads();
#else
    u32x4 ra0, ra1, ra2, ra3, rb0, rb1, rb2, rb3;
    const int wo0 = lds_off(ldrow, ldc), wo1 = lds_off(ldrow + 32, ldc), wo2 = lds_off(ldrow + 64, ldc), wo3 = lds_off(ldrow + 96, ldc);
#define GLOAD(kk) do { const int ko_ = (kk) + ldc * 8; \
        ra0 = *(const u32x4*)(a0 + ko_); ra1 = *(const u32x4*)(a1 + ko_); ra2 = *(const u32x4*)(a2 + ko_); ra3 = *(const u32x4*)(a3 + ko_); \
        rb0 = *(const u32x4*)(b0 + ko_); rb1 = *(const u32x4*)(b1 + ko_); rb2 = *(const u32x4*)(b2 + ko_); rb3 = *(const u32x4*)(b3 + ko_); } while (0)
#define LWRITE(buf) do { unsigned char* a_ = smem + (buf) * 32768; unsigned char* b_ = a_ + 16384; \
        *(u32x4*)(a_ + wo0) = ra0; *(u32x4*)(a_ + wo1) = ra1; *(u32x4*)(a_ + wo2) = ra2; *(u32x4*)(a_ + wo3) = ra3; \
        *(u32x4*)(b_ + wo0) = rb0; *(u32x4*)(b_ + wo1) = rb1; *(u32x4*)(b_ + wo2) = rb2; *(u32x4*)(b_ + wo3) = rb3; } while (0)
    const int nk = (kend - kbeg) >> 6;
    __syncthreads();
    GLOAD(kbeg); LWRITE(0); __syncthreads();
    for (int kt = 0; kt < nk; ++kt) {
        if (kt + 1 < nk) GLOAD(kbeg + (kt + 1) * 64);
        const unsigned char* a_ = smem + (kt & 1) * 32768; const unsigned char* b_ = a_ + 16384;
#pragma unroll
        for (int ks = 0; ks < 2; ++ks) {
            bf16x8 fa[4], fb[4];
#pragma unroll
            for (int i = 0; i < 4; ++i) { fa[i] = *(const bf16x8*)(a_ + lds_off(64 * wm + 16 * i + lr, ks * 4 + g)); fb[i] = *(const bf16x8*)(b_ + lds_off(64 * wn + 16 * i + lr, ks * 4 + g)); }
#pragma unroll
            for (int ni = 0; ni < 4; ++ni)
#pragma unroll
                for (int mi = 0; mi < 4; ++mi) acc[ni][mi] = __builtin_amdgcn_mfma_f32_16x16x32_bf16(fb[ni], fa[mi], acc[ni][mi], 0, 0, 0);
        }
        if (kt + 1 < nk) LWRITE((kt + 1) & 1);
        __syncthreads();
    }
#undef GLOAD
#undef LWRITE
#endif
}
DEVINL void zero_acc(f32x4 (&acc)[4][4]) {
#pragma unroll
    for (int i = 0; i < 4; ++i)
#pragma unroll
        for (int j = 0; j < 4; ++j) acc[i][j] = (f32x4){0.f, 0.f, 0.f, 0.f};
}

DEVINL void phase2(const Params& P, unsigned char* smem) {
    const int t = threadIdx.x, lane = t & 63, w = t >> 6, wm = w & 1, wn = w >> 1, lr = lane & 15, g = lane >> 4, ldrow = t >> 3;
    const bf16_t* H = (const bf16_t*)(P.ws + WS_H); const bf16_t* Wt = (const bf16_t*)(P.ws + WS_WQKV);
    const float* rc = (const float*)(P.ws + WS_ROPE); const float* rs = rc + SEQ * 32;
    constexpr int TN = QKVW / 128, TM = NT / 128;
    for (int it = blockIdx.x; it < TN * TM; it += gridDim.x) {
        const int tm = it / TN, tn = it % TN, m0 = tm * 128, n0 = tn * 128;
        const bf16_t* ab = H + (size_t)(m0 + ldrow) * DM; const bf16_t* bb = Wt + (size_t)(n0 + ldrow) * DM;
        f32x4 acc[4][4]; zero_acc(acc);
        gemm_core(acc, ab, ab + 32 * DM, ab + 64 * DM, ab + 96 * DM, bb, bb + 32 * DM, bb + 64 * DM, bb + 96 * DM, 0, DM, smem);
        const int nW = n0 + 64 * wn;
        int region, hh;
        if (nW < 512) { region = 0; hh = nW >> 6; } else if (nW < 1024) { region = 1; hh = (nW - 512) >> 6; } else if (nW < 1536) { region = 2; hh = (nW - 1024) >> 6; }
        else if (nW < 2048) { region = 3; hh = (nW - 1536) >> 6; } else if (nW < 2176) { region = 4; hh = (nW - 2048) >> 6; } else { region = 5; hh = (nW - 2176) >> 6; }
#pragma unroll
        for (int mi = 0; mi < 4; ++mi) {
            const int m = m0 + 64 * wm + 16 * mi + lr, b = m >> 13, s = m & (SEQ - 1);
            f32x4 v[4];
#pragma unroll
            for (int ni = 0; ni < 4; ++ni) v[ni] = acc[ni][mi];
            if (region == 3 || region == 4) {
#pragma unroll
                for (int ni = 0; ni < 2; ++ni) {
                    const f32x4 cs = *(const f32x4*)(rc + s * 32 + 16 * ni + 4 * g), sn = *(const f32x4*)(rs + s * 32 + 16 * ni + 4 * g);
                    const f32x4 x1 = v[ni], x2 = v[ni + 2];
                    v[ni] = x1 * cs - x2 * sn; v[ni + 2] = x2 * cs + x1 * sn;
                }
            }
            if (region == 0 || region == 3) {
#pragma unroll
                for (int ni = 0; ni < 4; ++ni) v[ni] = v[ni] * QSCALE;
            }
            if (region == 2 || region == 5) {
                bf16_t* base = (bf16_t*)(P.ws + (region == 2 ? WS_NAVT : WS_SWVT)) + ((size_t)(b * (region == 2 ? 8 : 2) + hh) * 64) * SEQ + s;
#pragma unroll
                for (int ni = 0; ni < 4; ++ni) {
                    const int d = 16 * ni + 4 * g;
                    base[(size_t)(d + 0) * SEQ] = (bf16_t)f2bf(v[ni].x); base[(size_t)(d + 1) * SEQ] = (bf16_t)f2bf(v[ni].y);
                    base[(size_t)(d + 2) * SEQ] = (bf16_t)f2bf(v[ni].z); base[(size_t)(d + 3) * SEQ] = (bf16_t)f2bf(v[ni].w);
                }
            } else {
                const size_t off = region == 0 ? WS_NAQ : region == 1 ? WS_NAK : region == 3 ? WS_SWQ : WS_SWK;
                const int nh = (region == 4) ? 2 : 8;
                bf16_t* base = (bf16_t*)(P.ws + off) + ((size_t)(b * nh + hh) * SEQ + s) * 64;
#pragma unroll
                for (int ni = 0; ni < 4; ++ni) { u32x2 o; o.x = pk2(v[ni].x, v[ni].y); o.y = pk2(v[ni].z, v[ni].w); *(u32x2*)(base + 16 * ni + 4 * g) = o; }
            }
        }
    }
}

#if NAIVE_ATTN
DEVINL void phase3(const Params& P, unsigned char* smem) {
    const int lane = threadIdx.x & 63, gw = blockIdx.x * 4 + (threadIdx.x >> 6), ngw = gridDim.x * 4;
    bf16_t* ATT = (bf16_t*)(P.ws + WS_ATT); float* SSQ = (float*)(P.ws + WS_SSQ);
    for (int it = gw; it < NT * 16; it += ngw) {
        const int isw = it >= NT * 8; const int r = isw ? it - NT * 8 : it;
        const int tok = r >> 3, h = r & 7, b = tok >> 13, s = tok & (SEQ - 1);
        float m = -3.0e38f, sum = 0.f, o = 0.f;
        if (!isw) {
            const bf16_t* Q = (const bf16_t*)(P.ws + WS_NAQ) + ((size_t)(b * 8 + h) * SEQ) * 64;
            const bf16_t* K = (const bf16_t*)(P.ws + WS_NAK) + ((size_t)(b * 8 + h) * SEQ) * 64;
            const bf16_t* VT = (const bf16_t*)(P.ws + WS_NAVT) + ((size_t)(b * 8 + h) * 64) * SEQ;
            const float q = bf2f(Q[(size_t)s * 64 + lane]);
            const int row = s >> 6, col = s & 63;
            int r0 = row - 4; r0 = r0 < 0 ? 0 : (r0 > 120 ? 120 : r0);
            int cs = col - 8; cs = cs < 0 ? 0 : (cs > 48 ? 48 : cs);
            const float* rpb = P.na_rpb + h * 15 * 31;
            for (int pass = 0; pass < 2; ++pass)
                for (int i = 0; i < 8; ++i)
                    for (int j = 0; j < 16; ++j) {
                        const int key = (r0 + i) * 64 + cs + j;
                        float d = wave_sum(q * bf2f(K[(size_t)key * 64 + lane]));
                        d += rpb[(r0 + i - row + 7) * 31 + (cs + j - col + 15)] * LOG2E;
                        if (pass == 0) m = fmaxf(m, d);
                        else { const float p = exp2f(d - m); sum += p; o += p * bf2f(VT[(size_t)lane * SEQ + key]); }
                    }
        } else {
            const int kvh = h >> 2;
            const bf16_t* Q = (const bf16_t*)(P.ws + WS_SWQ) + ((size_t)(b * 8 + h) * SEQ) * 64;
            const bf16_t* K = (const bf16_t*)(P.ws + WS_SWK) + ((size_t)(b * 2 + kvh) * SEQ) * 64;
            const bf16_t* VT = (const bf16_t*)(P.ws + WS_SWVT) + ((size_t)(b * 2 + kvh) * 64) * SEQ;
            const float q = bf2f(Q[(size_t)s * 64 + lane]);
            const int klo = s - 128 < 0 ? 0 : s - 128, khi = s + 128 > SEQ - 1 ? SEQ - 1 : s + 128;
            const float sk = P.swa_sinks[h] * LOG2E;
            m = sk;
            for (int pass = 0; pass < 2; ++pass)
                for (int key = klo; key <= khi; ++key) {
                    const float d = wave_sum(q * bf2f(K[(size_t)key * 64 + lane]));
                    if (pass == 0) m = fmaxf(m, d);
                    else { const float p = exp2f(d - m); sum += p; o += p * bf2f(VT[(size_t)lane * SEQ + key]); }
                }
            sum += exp2f(sk - m);
        }
        o /= sum;
        ATT[(size_t)tok * DM + (isw ? 512 : 0) + h * 64 + lane] = (bf16_t)f2bf(o);
        const float sq = wave_sum(o * o);
        if (lane == 0) SSQ[tok * 16 + (isw ? 8 : 0) + h] = sq;
    }
}
#else
DEVINL void phase3(const Params& P, unsigned char* smem) {
    const int t = threadIdx.x, lane = t & 63, w = t >> 6, lr = lane & 15, g = lane >> 4;
    bf16_t* ATT = (bf16_t*)(P.ws + WS_ATT); float* SSQ = (float*)(P.ws + WS_SSQ);
    float* s_rpb = (float*)smem;
    for (int i = t; i < 8 * 465; i += 256) s_rpb[i] = P.na_rpb[i] * LOG2E;
    __syncthreads();
    constexpr int N_NA = 2 * 8 * 128, N_SW = 2 * 2 * 512;
    for (int it = blockIdx.x; it < N_NA + N_SW; it += gridDim.x) {
        if (it < N_NA) {
            const int r = it & 127, h = (it >> 7) & 7, b = it >> 10;
            const int c0 = 16 * w;
            int r0 = r - 4; r0 = r0 < 0 ? 0 : (r0 > 120 ? 120 : r0);
            int kc0 = c0 - 8; kc0 = kc0 < 0 ? 0 : (kc0 > 32 ? 32 : kc0);
            const bf16_t* Q = (const bf16_t*)(P.ws + WS_NAQ) + ((size_t)(b * 8 + h) * SEQ) * 64;
            const bf16_t* K = (const bf16_t*)(P.ws + WS_NAK) + ((size_t)(b * 8 + h) * SEQ) * 64;
            const bf16_t* VT = (const bf16_t*)(P.ws + WS_NAVT) + ((size_t)(b * 8 + h) * 64) * SEQ;
            const bf16_t* qp = Q + (size_t)(r * 64 + c0 + lr) * 64 + 8 * g;
            const bf16x8 q0 = *(const bf16x8*)qp, q1 = *(const bf16x8*)(qp + 32);
            f32x4 sc[16];
#pragma unroll
            for (int tt = 0; tt < 16; ++tt) {
                const bf16_t* kp = K + (size_t)((r0 + (tt >> 1)) * 64 + kc0 + (tt & 1) * 16 + lr) * 64 + 8 * g;
                const bf16x8 k0 = *(const bf16x8*)kp, k1 = *(const bf16x8*)(kp + 32);
                f32x4 a = {0.f, 0.f, 0.f, 0.f};
                a = __builtin_amdgcn_mfma_f32_16x16x32_bf16(k0, q0, a, 0, 0, 0);
                a = __builtin_amdgcn_mfma_f32_16x16x32_bf16(k1, q1, a, 0, 0, 0);
                sc[tt] = a;
            }
            const int c = c0 + lr; int cs = c - 8; cs = cs < 0 ? 0 : (cs > 48 ? 48 : cs);
            const float* rp = s_rpb + h * 465;
            float mx = -3.0e38f;
#pragma unroll
            for (int tt = 0; tt < 16; ++tt) {
                const int dr = r0 + (tt >> 1) - r + 7;
#pragma unroll
                for (int e = 0; e < 4; ++e) {
                    const int kc = kc0 + (tt & 1) * 16 + 4 * g + e;
                    const bool ok = (kc >= cs) && (kc < cs + 16);
                    int dc = kc - c + 15; dc = dc < 0 ? 0 : (dc > 30 ? 30 : dc);
                    const float v = ok ? sc[tt][e] + rp[dr * 31 + dc] : -3.0e38f;
                    sc[tt][e] = v; mx = fmaxf(mx, v);
                }
            }
            mx = fmaxf(mx, __shfl_xor(mx, 16)); mx = fmaxf(mx, __shfl_xor(mx, 32));
            float sum = 0.f;
#pragma unroll
            for (int tt = 0; tt < 16; ++tt)
#pragma unroll
                for (int e = 0; e < 4; ++e) { const float p = exp2f(sc[tt][e] - mx); sc[tt][e] = p; sum += p; }
            sum += __shfl_xor(sum, 16); sum += __shfl_xor(sum, 32);
            f32x4 o[4];
#pragma unroll
            for (int dt = 0; dt < 4; ++dt) o[dt] = (f32x4){0.f, 0.f, 0.f, 0.f};
#pragma unroll
            for (int kk = 0; kk < 8; ++kk) {
                union { bf16x8 v; unsigned u[4]; } pf;
                pf.u[0] = pk2(sc[2 * kk][0], sc[2 * kk][1]); pf.u[1] = pk2(sc[2 * kk][2], sc[2 * kk][3]);
                pf.u[2] = pk2(sc[2 * kk + 1][0], sc[2 * kk + 1][1]); pf.u[3] = pk2(sc[2 * kk + 1][2], sc[2 * kk + 1][3]);
                const int key0 = (r0 + kk) * 64 + kc0 + 4 * g;
#pragma unroll
                for (int dt = 0; dt < 4; ++dt) {
                    const bf16_t* vp = VT + (size_t)(16 * dt + lr) * SEQ + key0;
                    union { bf16x8 v; u32x2 h[2]; } vf;
                    vf.h[0] = *(const u32x2*)vp; vf.h[1] = *(const u32x2*)(vp + 16);
                    o[dt] = __builtin_amdgcn_mfma_f32_16x16x32_bf16(vf.v, pf.v, o[dt], 0, 0, 0);
                }
            }
            const float inv = 1.f / sum; float sq = 0.f;
            const int tok = b * SEQ + r * 64 + c0 + lr;
#pragma unroll
            for (int dt = 0; dt < 4; ++dt) {
                const f32x4 v = o[dt] * inv; sq += v.x * v.x + v.y * v.y + v.z * v.z + v.w * v.w;
                u32x2 ov; ov.x = pk2(v.x, v.y); ov.y = pk2(v.z, v.w);
                *(u32x2*)(ATT + (size_t)tok * DM + h * 64 + 16 * dt + 4 * g) = ov;
            }
            sq += __shfl_xor(sq, 16); sq += __shfl_xor(sq, 32);
            if (g == 0) SSQ[tok * 16 + h] = sq;
        } else {
            const int r = it - N_NA, qt = r & 511, kvh = (r >> 9) & 1, b = r >> 10;
            const int hq = kvh * 4 + w, q0p = qt * 16, kb = q0p - 128;
            const bf16_t* Q = (const bf16_t*)(P.ws + WS_SWQ) + ((size_t)(b * 8 + hq) * SEQ) * 64;
            const bf16_t* K = (const bf16_t*)(P.ws + WS_SWK) + ((size_t)(b * 2 + kvh) * SEQ) * 64;
            const bf16_t* VT = (const bf16_t*)(P.ws + WS_SWVT) + ((size_t)(b * 2 + kvh) * 64) * SEQ;
            const bf16_t* qp = Q + (size_t)(q0p + lr) * 64 + 8 * g;
            const bf16x8 q0 = *(const bf16x8*)qp, q1 = *(const bf16x8*)(qp + 32);
            f32x4 sc[18];
            const float sk = P.swa_sinks[hq] * LOG2E;
            float mx = sk;
#pragma unroll
            for (int tt = 0; tt < 18; ++tt) {
                const int kt0 = kb + 16 * tt;
                f32x4 a = {0.f, 0.f, 0.f, 0.f};
                const bool tile_ok = (tt < 17) && (kt0 >= 0) && (kt0 < SEQ);
                if (tile_ok) {
                    const bf16_t* kp = K + (size_t)(kt0 + lr) * 64 + 8 * g;
                    const bf16x8 k0 = *(const bf16x8*)kp, k1 = *(const bf16x8*)(kp + 32);
                    a = __builtin_amdgcn_mfma_f32_16x16x32_bf16(k0, q0, a, 0, 0, 0);
                    a = __builtin_amdgcn_mfma_f32_16x16x32_bf16(k1, q1, a, 0, 0, 0);
                }
#pragma unroll
                for (int e = 0; e < 4; ++e) {
                    const int dlt = 16 * tt + 4 * g + e - lr;
                    const bool ok = tile_ok && dlt >= 0 && dlt <= 256;
                    const float v = ok ? a[e] : -3.0e38f;
                    a[e] = v; mx = fmaxf(mx, v);
                }
                sc[tt] = a;
            }
            mx = fmaxf(mx, __shfl_xor(mx, 16)); mx = fmaxf(mx, __shfl_xor(mx, 32));
            float sum = 0.f;
#pragma unroll
            for (int tt = 0; tt < 18; ++tt)
#pragma unroll
                for (int e = 0; e < 4; ++e) { const float p = exp2f(sc[tt][e] - mx); sc[tt][e] = p; sum += p; }
            sum += __shfl_xor(sum, 16); sum += __shfl_xor(sum, 32);
            sum += exp2f(sk - mx);
            f32x4 o[4];
#pragma unroll
            for (int dt = 0; dt < 4; ++dt) o[dt] = (f32x4){0.f, 0.f, 0.f, 0.f};
#pragma unroll
            for (int kk = 0; kk < 9; ++kk) {
                union { bf16x8 v; unsigned u[4]; } pf;
                pf.u[0] = pk2(sc[2 * kk][0], sc[2 * kk][1]); pf.u[1] = pk2(sc[2 * kk][2], sc[2 * kk][3]);
                pf.u[2] = pk2(sc[2 * kk + 1][0], sc[2 * kk + 1][1]); pf.u[3] = pk2(sc[2 * kk + 1][2], sc[2 * kk + 1][3]);
                const int key0 = kb + 32 * kk + 4 * g, key1 = key0 + 16;
                const bool ok0 = key0 >= 0 && key0 < SEQ, ok1 = (2 * kk + 1 < 17) && key1 >= 0 && key1 < SEQ;
#pragma unroll
                for (int dt = 0; dt < 4; ++dt) {
                    const bf16_t* vp = VT + (size_t)(16 * dt + lr) * SEQ;
                    union { bf16x8 v; u32x2 h[2]; } vf;
                    vf.h[0] = ok0 ? *(const u32x2*)(vp + key0) : (u32x2){0u, 0u};
                    vf.h[1] = ok1 ? *(const u32x2*)(vp + key1) : (u32x2){0u, 0u};
                    o[dt] = __builtin_amdgcn_mfma_f32_16x16x32_bf16(vf.v, pf.v, o[dt], 0, 0, 0);
                }
            }
            const float inv = 1.f / sum; float sq = 0.f;
            const int tok = b * SEQ + q0p + lr;
#pragma unroll
            for (int dt = 0; dt < 4; ++dt) {
                const f32x4 v = o[dt] * inv; sq += v.x * v.x + v.y * v.y + v.z * v.z + v.w * v.w;
                u32x2 ov; ov.x = pk2(v.x, v.y); ov.y = pk2(v.z, v.w);
                *(u32x2*)(ATT + (size_t)tok * DM + 512 + hq * 64 + 16 * dt + 4 * g) = ov;
            }
            sq += __shfl_xor(sq, 16); sq += __shfl_xor(sq, 32);
            if (g == 0) SSQ[tok * 16 + 8 + hq] = sq;
        }
    }
}
#endif

DEVINL void phase4a(const Params& P, unsigned char* smem) {
    const int t = threadIdx.x, lane = t & 63, w = t >> 6, wm = w & 1, wn = w >> 1, lr = lane & 15, g = lane >> 4, ldrow = t >> 3;
    const bf16_t* A = (const bf16_t*)(P.ws + WS_ATT); const bf16_t* Wt = (const bf16_t*)(P.ws + WS_WOUT);
    const float* SSQ = (const float*)(P.ws + WS_SSQ);
    bf16_t* MIX = (bf16_t*)(P.ws + WS_H);
    constexpr int TN = 8, TM = NT / 128;
    for (int it = blockIdx.x; it < TN * TM; it += gridDim.x) {
        const int tm = it / TN, tn = it % TN, m0 = tm * 128, n0 = tn * 128;
        const bf16_t* ab = A + (size_t)(m0 + ldrow) * DM; const bf16_t* bb = Wt + (size_t)(n0 + ldrow) * DM;
        float rna[4], rsw[4];
#pragma unroll
        for (int mi = 0; mi < 4; ++mi) {
            const float* sp = SSQ + (size_t)(m0 + 64 * wm + 16 * mi + lr) * 16;
            const f32x4 a = *(const f32x4*)sp, b2 = *(const f32x4*)(sp + 4), c2 = *(const f32x4*)(sp + 8), d2 = *(const f32x4*)(sp + 12);
            rna[mi] = rsqrtf((a.x + a.y + a.z + a.w + b2.x + b2.y + b2.z + b2.w) * (1.f / 512.f) + EPS);
            rsw[mi] = rsqrtf((c2.x + c2.y + c2.z + c2.w + d2.x + d2.y + d2.z + d2.w) * (1.f / 512.f) + EPS);
        }
        f32x4 acc[4][4]; zero_acc(acc);
        gemm_core(acc, ab, ab + 32 * DM, ab + 64 * DM, ab + 96 * DM, bb, bb + 32 * DM, bb + 64 * DM, bb + 96 * DM, 0, 512, smem);
#pragma unroll
        for (int mi = 0; mi < 4; ++mi) { const float f = rna[mi] / rsw[mi];
#pragma unroll
            for (int ni = 0; ni < 4; ++ni) acc[ni][mi] = acc[ni][mi] * f; }
        gemm_core(acc, ab, ab + 32 * DM, ab + 64 * DM, ab + 96 * DM, bb, bb + 32 * DM, bb + 64 * DM, bb + 96 * DM, 512, 1024, smem);
#pragma unroll
        for (int mi = 0; mi < 4; ++mi) {
            const int m = m0 + 64 * wm + 16 * mi + lr;
#pragma unroll
            for (int ni = 0; ni < 4; ++ni) {
                const f32x4 v = acc[ni][mi] * rsw[mi];
                u32x2 o; o.x = pk2(v.x, v.y); o.y = pk2(v.z, v.w);
                *(u32x2*)(MIX + (size_t)m * DM + n0 + 64 * wn + 16 * ni + 4 * g) = o;
            }
        }
    }
}

DEVINL void phase4b(const Params& P) {
    const int lane = threadIdx.x & 63, gw = blockIdx.x * 4 + (threadIdx.x >> 6), ngw = gridDim.x * 4;
    const float* mod = (const float*)(P.ws + WS_MOD);
    bf16_t* H = (bf16_t*)(P.ws + WS_H);
    unsigned* cnt = (unsigned*)(P.ws + WS_CNT);
    int* ltok = (int*)(P.ws + WS_LTOK); float* lw = (float*)(P.ws + WS_LW);
    for (int row = gw; row < NT; row += ngw) {
        const float* mb = mod + (row >> 13) * 6144;
        f32x4 mx[4]; float ss = 0.f;
#pragma unroll
        for (int j = 0; j < 4; ++j) {
            const u32x2 raw = *(const u32x2*)(H + (size_t)row * DM + 4 * lane + 256 * j);
            mx[j] = (f32x4){bflo(raw.x), bfhi(raw.x), bflo(raw.y), bfhi(raw.y)};
            ss += mx[j].x * mx[j].x + mx[j].y * mx[j].y + mx[j].z * mx[j].z + mx[j].w * mx[j].w;
        }
        ss = wave_sum(ss);
        const float rstd = rsqrtf(ss * (1.f / DM) + EPS);
        f32x4 x1[4]; float s1 = 0.f;
#pragma unroll
        for (int j = 0; j < 4; ++j) {
            const int col = 4 * lane + 256 * j;
            const f32x4 xv = *(const f32x4*)(P.x + (size_t)row * DM + col), gp = *(const f32x4*)(P.g_post_mix + col), ga = *(const f32x4*)(mb + 2048 + col);
            x1[j] = xv + ga * (mx[j] * rstd * gp);
            *(f32x4*)(P.out + (size_t)row * DM + col) = x1[j];
            s1 += x1[j].x * x1[j].x + x1[j].y * x1[j].y + x1[j].z * x1[j].z + x1[j].w * x1[j].w;
        }
        s1 = wave_sum(s1);
        const float rstd1 = rsqrtf(s1 * (1.f / DM) + EPS);
        f32x4 hv[4];
#pragma unroll
        for (int j = 0; j < 4; ++j) {
            const int col = 4 * lane + 256 * j;
            const f32x4 gp = *(const f32x4*)(P.g_pre_ffn + col), sc = *(const f32x4*)(mb + 4096 + col), sh = *(const f32x4*)(mb + 3072 + col);
            hv[j] = x1[j] * rstd1 * gp * (sc + 1.f) + sh;
            u32x2 o; o.x = pk2(hv[j].x, hv[j].y); o.y = pk2(hv[j].z, hv[j].w);
            *(u32x2*)(H + (size_t)row * DM + col) = o;
        }
        f32x4 gl = {0.f, 0.f, 0.f, 0.f};
#pragma unroll
        for (int j = 0; j < 4; ++j) {
            const float* wp = P.w_gr + (size_t)(4 * lane + 256 * j) * 4;
            gl += *(const f32x4*)(wp) * hv[j].x; gl += *(const f32x4*)(wp + 4) * hv[j].y; gl += *(const f32x4*)(wp + 8) * hv[j].z; gl += *(const f32x4*)(wp + 12) * hv[j].w;
        }
        gl.x = wave_sum(gl.x); gl.y = wave_sum(gl.y); gl.z = wave_sum(gl.z); gl.w = wave_sum(gl.w);
        int gtop = 0; float gm = gl.x;
        if (gl.y > gm) { gm = gl.y; gtop = 1; } if (gl.z > gm) { gm = gl.z; gtop = 2; } if (gl.w > gm) { gm = gl.w; gtop = 3; }
        const float gwt = 1.f / (expf(gl.x - gm) + expf(gl.y - gm) + expf(gl.z - gm) + expf(gl.w - gm));
        const float* we = P.w_er + (size_t)gtop * 1024 * 8;
        f32x4 ea = {0.f, 0.f, 0.f, 0.f}, eb = {0.f, 0.f, 0.f, 0.f};
#pragma unroll
        for (int j = 0; j < 4; ++j) {
            const float* wp = we + (size_t)(4 * lane + 256 * j) * 8;
            ea += *(const f32x4*)(wp) * hv[j].x;      eb += *(const f32x4*)(wp + 4) * hv[j].x;
            ea += *(const f32x4*)(wp + 8) * hv[j].y;  eb += *(const f32x4*)(wp + 12) * hv[j].y;
            ea += *(const f32x4*)(wp + 16) * hv[j].z; eb += *(const f32x4*)(wp + 20) * hv[j].z;
            ea += *(const f32x4*)(wp + 24) * hv[j].w; eb += *(const f32x4*)(wp + 28) * hv[j].w;
        }
        const float e0 = wave_sum(ea.x), e1 = wave_sum(ea.y), e2 = wave_sum(ea.z), e3 = wave_sum(ea.w), e4 = wave_sum(eb.x), e5 = wave_sum(eb.y), e6 = wave_sum(eb.z), e7 = wave_sum(eb.w);
        int i1 = 0; float v1 = e0;
        if (e1 > v1) { v1 = e1; i1 = 1; } if (e2 > v1) { v1 = e2; i1 = 2; } if (e3 > v1) { v1 = e3; i1 = 3; }
        if (e4 > v1) { v1 = e4; i1 = 4; } if (e5 > v1) { v1 = e5; i1 = 5; } if (e6 > v1) { v1 = e6; i1 = 6; } if (e7 > v1) { v1 = e7; i1 = 7; }
        int i2 = -1; float v2 = -3.0e38f;
        if (i1 != 0 && e0 > v2) { v2 = e0; i2 = 0; } if (i1 != 1 && e1 > v2) { v2 = e1; i2 = 1; } if (i1 != 2 && e2 > v2) { v2 = e2; i2 = 2; } if (i1 != 3 && e3 > v2) { v2 = e3; i2 = 3; }
        if (i1 != 4 && e4 > v2) { v2 = e4; i2 = 4; } if (i1 != 5 && e5 > v2) { v2 = e5; i2 = 5; } if (i1 != 6 && e6 > v2) { v2 = e6; i2 = 6; } if (i1 != 7 && e7 > v2) { v2 = e7; i2 = 7; }
        const float ex = expf(v2 - v1), w1 = gwt / (1.f + ex), w2 = gwt * ex / (1.f + ex);
        if (lane == 0) {
            const int ea1 = gtop * 8 + i1, ea2 = gtop * 8 + i2;
            const unsigned p1 = atomicAdd(&cnt[ea1], 1u); ltok[ea1 * NT + p1] = row * 2;     lw[ea1 * NT + p1] = w1;
            const unsigned p2 = atomicAdd(&cnt[ea2], 1u); ltok[ea2 * NT + p2] = row * 2 + 1; lw[ea2 * NT + p2] = w2;
        }
    }
}

DEVINL void phase5a(const Params& P, unsigned char* smem) {
    const int t = threadIdx.x, lane = t & 63, w = t >> 6, wm = w & 1, wn = w >> 1, lr = lane & 15, g = lane >> 4, ldrow = t >> 3;
    const bf16_t* H = (const bf16_t*)(P.ws + WS_H); const bf16_t* Wgu = (const bf16_t*)(P.ws + WS_WGU);
    const unsigned* cnt = (const unsigned*)(P.ws + WS_CNT); const int* ltok = (const int*)(P.ws + WS_LTOK);
    bf16_t* HID = (bf16_t*)(P.ws + WS_HID);
    int total = 0;
    for (int e = 0; e < 32; ++e) total += ((int)cnt[e] + 127) >> 7;
    for (int it = blockIdx.x; it < total * 4; it += gridDim.x) {
        const int tn = it & 3; int mt = it >> 2, e = 0, off = 0;
        for (; e < 32; ++e) { const int c = (int)cnt[e], nt = (c + 127) >> 7; if (mt < nt) break; mt -= nt; off += c; }
        const int ce = (int)cnt[e], n0 = tn * 128;
        const bf16_t* ar[4];
#pragma unroll
        for (int i = 0; i < 4; ++i) { const int r = mt * 128 + ldrow + 32 * i; const int tok = (r < ce) ? (ltok[e * NT + r] >> 1) : 0; ar[i] = H + (size_t)tok * DM; }
        const bf16_t* bb = Wgu + ((size_t)e * 512 + n0 + ldrow) * DM;
        f32x4 acc[4][4]; zero_acc(acc);
        gemm_core(acc, ar[0], ar[1], ar[2], ar[3], bb, bb + 32 * DM, bb + 64 * DM, bb + 96 * DM, 0, DM, smem);
#pragma unroll
        for (int mi = 0; mi < 4; ++mi) {
            const int r = mt * 128 + 64 * wm + 16 * mi + lr;
            if (r < ce) {
#pragma unroll
                for (int p = 0; p < 2; ++p) {
                    const f32x4 gt = acc[2 * p][mi], up = acc[2 * p + 1][mi];
                    f32x4 hd; hd.x = silu_f(gt.x) * up.x; hd.y = silu_f(gt.y) * up.y; hd.z = silu_f(gt.z) * up.z; hd.w = silu_f(gt.w) * up.w;
                    u32x2 o; o.x = pk2(hd.x, hd.y); o.y = pk2(hd.z, hd.w);
                    *(u32x2*)(HID + (size_t)(off + r) * 256 + (n0 >> 1) + 32 * wn + 16 * p + 4 * g) = o;
                }
            }
        }
    }
}
DEVINL void phase5b(const Params& P, unsigned char* smem) {
    const int t = threadIdx.x, lane = t & 63, w = t >> 6, wm = w & 1, wn = w >> 1, lr = lane & 15, g = lane >> 4, ldrow = t >> 3;
    const bf16_t* HID = (const bf16_t*)(P.ws + WS_HID); const bf16_t* Wd = (const bf16_t*)(P.ws + WS_WD);
    const unsigned* cnt = (const unsigned*)(P.ws + WS_CNT); const int* ltok = (const int*)(P.ws + WS_LTOK); const float* lw = (const float*)(P.ws + WS_LW);
    bf16_t* Y = (bf16_t*)(P.ws + WS_Y);
    int total = 0;
    for (int e = 0; e < 32; ++e) total += ((int)cnt[e] + 127) >> 7;
    for (int it = blockIdx.x; it < total * 8; it += gridDim.x) {
        const int tn = it & 7; int mt = it >> 3, e = 0, off = 0;
        for (; e < 32; ++e) { const int c = (int)cnt[e], nt = (c + 127) >> 7; if (mt < nt) break; mt -= nt; off += c; }
        const int ce = (int)cnt[e], n0 = tn * 128;
        const bf16_t* ar[4];
#pragma unroll
        for (int i = 0; i < 4; ++i) { int r = mt * 128 + ldrow + 32 * i; r = r < ce ? r : ce - 1; ar[i] = HID + (size_t)(off + r) * 256; }
        const bf16_t* bb = Wd + ((size_t)e * 1024 + n0 + ldrow) * 256;
        f32x4 acc[4][4]; zero_acc(acc);
        gemm_core(acc, ar[0], ar[1], ar[2], ar[3], bb, bb + 32 * 256, bb + 64 * 256, bb + 96 * 256, 0, 256, smem);
#pragma unroll
        for (int mi = 0; mi < 4; ++mi) {
            const int r = mt * 128 + 64 * wm + 16 * mi + lr;
            if (r < ce) {
                const int ent = ltok[e * NT + r]; const float wt = lw[e * NT + r];
                bf16_t* yp = Y + ((size_t)(ent & 1) * NT + (ent >> 1)) * DM + n0 + 64 * wn + 4 * g;
#pragma unroll
                for (int ni = 0; ni < 4; ++ni) { const f32x4 v = acc[ni][mi] * wt; u32x2 o; o.x = pk2(v.x, v.y); o.y = pk2(v.z, v.w); *(u32x2*)(yp + 16 * ni) = o; }
            }
        }
    }
}
DEVINL void phase6(const Params& P) {
    const int lane = threadIdx.x & 63, gw = blockIdx.x * 4 + (threadIdx.x >> 6), ngw = gridDim.x * 4;
    const float* mod = (const float*)(P.ws + WS_MOD);
    const bf16_t* Y = (const bf16_t*)(P.ws + WS_Y);
    for (int row = gw; row < NT; row += ngw) {
        const float* mb = mod + (row >> 13) * 6144;
        f32x4 y[4]; float ss = 0.f;
#pragma unroll
        for (int j = 0; j < 4; ++j) {
            const int col = 4 * lane + 256 * j;
            const u32x2 a = *(const u32x2*)(Y + (size_t)row * DM + col), b = *(const u32x2*)(Y + ((size_t)NT + row) * DM + col);
            y[j] = (f32x4){bflo(a.x) + bflo(b.x), bfhi(a.x) + bfhi(b.x), bflo(a.y) + bflo(b.y), bfhi(a.y) + bfhi(b.y)};
            ss += y[j].x * y[j].x + y[j].y * y[j].y + y[j].z * y[j].z + y[j].w * y[j].w;
        }
        ss = wave_sum(ss);
        const float rstd = rsqrtf(ss * (1.f / DM) + EPS);
#pragma unroll
        for (int j = 0; j < 4; ++j) {
            const int col = 4 * lane + 256 * j;
            const f32x4 x1 = *(const f32x4*)(P.out + (size_t)row * DM + col), gp = *(const f32x4*)(P.g_post_ffn + col), gf = *(const f32x4*)(mb + 5120 + col);
            *(f32x4*)(P.out + (size_t)row * DM + col) = x1 + gf * (y[j] * rstd * gp);
        }
    }
}


#define LAS __attribute__((address_space(3)))
#define XB_TMO      128
#define XB_XCNT(j)  (256  + 64 * (j))
#define XB_XSUB(j)  (1280 + 64 * (j))
#define XB_XGEN(j)  (2304 + 64 * (j))
#define XB_TOP      3328
#define XB_TOPGEN   3392
#define XCD_BAR_WORDS 3456
#define XB_SPIN_CAP (1u << 18)
DEVINL unsigned xb_ld(unsigned* p)              { return __hip_atomic_load(p, __ATOMIC_RELAXED, __HIP_MEMORY_SCOPE_AGENT); }
DEVINL unsigned xb_add(unsigned* p, unsigned v) { return __hip_atomic_fetch_add(p, v, __ATOMIC_RELAXED, __HIP_MEMORY_SCOPE_AGENT); }
DEVINL unsigned xb_xcc_id() { return (unsigned)__builtin_amdgcn_s_getreg((3 << 11) | 20) & 0xFu; }
#define XB_SPIN(cond, bar) do { unsigned _sp = 0; while (cond) { __builtin_amdgcn_s_sleep(1); \
    if ((++_sp & 255u) == 0u) { if (xb_ld(&(bar)[XB_TMO])) break; if (_sp > XB_SPIN_CAP) { atomicAdd(&(bar)[XB_TMO], 1u); break; } } } } while (0)
struct XcdBarrier { unsigned* bar; unsigned x; volatile LAS unsigned* st; };
DEVINL XcdBarrier xcd_barrier_post(unsigned* bar, volatile LAS unsigned* st) {
    XcdBarrier b; b.bar = bar; b.x = xb_xcc_id(); b.st = st;
    if (threadIdx.x == 0) (void)xb_add(&bar[XB_XCNT(b.x)], 1u);
    return b;
}
DEVINL void xcd_barrier_complete(unsigned* bar, unsigned x, unsigned& nloc, unsigned& nx) {
    const unsigned G = gridDim.x * gridDim.y * gridDim.z;
    unsigned sum, cnt, mine, sp = 0u;
    for (;;) {
        sum = 0u; cnt = 0u; mine = 0u;
#pragma unroll
        for (unsigned j = 0; j < 16; ++j) { const unsigned c = xb_ld(&bar[XB_XCNT(j)]); sum += c; cnt += (c > 0u) ? 1u : 0u; mine = (j == x) ? c : mine; }
        if (sum == G) break;
        __builtin_amdgcn_s_sleep(1);
        if ((++sp & 255u) == 0u) { if (xb_ld(&bar[XB_TMO])) break; if (sp > XB_SPIN_CAP) { atomicAdd(&bar[XB_TMO], 1u); break; } }
    }
    nloc = mine > 0u ? mine : 1u; nx = cnt > 0u ? cnt : 1u;
}
DEVINL void xcd_barrier(const XcdBarrier& b) {
    asm volatile("s_waitcnt vmcnt(0)" ::: "memory");
    __syncthreads();
    if (threadIdx.x == 0) {
        unsigned* bar = b.bar;
        __builtin_amdgcn_s_waitcnt(0);
        unsigned nloc = b.st[0], nx = b.st[1];
        if (nloc == 0u) { xcd_barrier_complete(bar, b.x, nloc, nx); b.st[0] = nloc; b.st[1] = nx; }
        const unsigned old = xb_add(&bar[XB_XSUB(b.x)], 1u);
        const unsigned gen = old / nloc;
        if (old + 1u == (gen + 1u) * nloc) {
            __builtin_amdgcn_fence(__ATOMIC_RELEASE, "agent");
            asm volatile("s_waitcnt vmcnt(0)" ::: "memory");
            const unsigned og = xb_add(&bar[XB_TOP], 1u);
            const unsigned tg = og / nx;
            if (og + 1u == (tg + 1u) * nx) xb_add(&bar[XB_TOPGEN], 1u);
            else XB_SPIN(xb_ld(&bar[XB_TOPGEN]) == tg, bar);
            __builtin_amdgcn_fence(__ATOMIC_ACQUIRE, "agent");
            xb_add(&bar[XB_XGEN(b.x)], 1u);
            asm volatile("s_waitcnt vmcnt(0)" ::: "memory");
        } else {
            XB_SPIN(xb_ld(&bar[XB_XGEN(b.x)]) == gen, bar);
            __builtin_amdgcn_fence(__ATOMIC_ACQUIRE, "agent");
            asm volatile("s_waitcnt vmcnt(0)" ::: "memory");
        }
    }
    __syncthreads();
}
constexpr size_t WS_BAR = 16384;
constexpr size_t CTL_ZERO_BYTES = 65536;

constexpr int NPHASE = 9;
__global__ void __launch_bounds__(256, 2) fwd_kernel(Params P) {
    extern __shared__ __attribute__((aligned(16))) unsigned char smem[];
#if N_LAUNCH_MODE == 1
    cg::grid_group grid = cg::this_grid();
#define SEAM(k) do { if (P.ph_lo <= (k) && (k) + 1 < P.ph_hi) grid.sync(); } while (0)
#elif N_LAUNCH_MODE == 2
    volatile LAS unsigned* bst = (volatile LAS unsigned*)(smem + 65536 + 2048);
    if (threadIdx.x < 4) bst[threadIdx.x] = 0u;
    __syncthreads();
    const XcdBarrier xbar = xcd_barrier_post((unsigned*)(P.ws + WS_BAR), bst);
#define SEAM(k) do { if (P.ph_lo <= (k) && (k) + 1 < P.ph_hi) xcd_barrier(xbar); } while (0)
#else
#define SEAM(k) do { } while (0)
#endif
#define IN(k) (P.ph_lo <= (k) && (k) < P.ph_hi)
    if (IN(0)) { phase0(P, smem); }  SEAM(0);
    if (IN(1)) { phase1(P); }        SEAM(1);
    if (IN(2)) { phase2(P, smem); }  SEAM(2);
    if (IN(3)) { phase3(P, smem); }  SEAM(3);
    if (IN(4)) { phase4a(P, smem); } SEAM(4);
    if (IN(5)) { phase4b(P); }       SEAM(5);
    if (IN(6)) { phase5a(P, smem); } SEAM(6);
    if (IN(7)) { phase5b(P, smem); } SEAM(7);
    if (IN(8)) { phase6(P); }
#undef IN
#undef SEAM
}

extern "C" void kernel_launch(void* const* d_in, const int* in_sizes, int n_in, void* d_out, int out_size, void* d_ws, size_t ws_size, hipStream_t stream) {
    static int grid_blocks = 0;
    if (!grid_blocks) {
        if (ws_size < WS_END) { fprintf(stderr, "kernel_launch: workspace too small (%zu < %zu)\n", ws_size, (size_t)WS_END); grid_blocks = -1; return; }
        int dev = 0, cus = 0, per_cu = 0;
        hipGetDevice(&dev);
        hipDeviceGetAttribute(&cus, hipDeviceAttributeMultiprocessorCount, dev);
        hipFuncSetAttribute((const void*)fwd_kernel, hipFuncAttributeMaxDynamicSharedMemorySize, LDS_BYTES);
        hipOccupancyMaxActiveBlocksPerMultiprocessor(&per_cu, (const void*)fwd_kernel, 256, LDS_BYTES);
        if (per_cu > 2) per_cu = 2;
        if (per_cu < 1) per_cu = 1;
        grid_blocks = cus * per_cu;
        fprintf(stderr, "kernel_launch: %d CUs x %d blocks\n", cus, per_cu);
    }
    if (grid_blocks < 0) return;
    Params p{};
    const float** pp = (const float**)&p;
    for (int i = 0; i < 19; ++i) pp[i] = (const float*)d_in[i];
    p.out = (float*)d_out; p.ws = (unsigned char*)d_ws;
#if N_LAUNCH_MODE == 2
    p.ph_lo = 0; p.ph_hi = NPHASE;
    if (hipMemsetAsync(d_ws, 0, CTL_ZERO_BYTES, stream) != hipSuccess) { fprintf(stderr, "kernel_launch: memset failed\n"); return; }
    hipLaunchKernelGGL(fwd_kernel, dim3(grid_blocks), dim3(256), LDS_BYTES, stream, p);
#elif N_LAUNCH_MODE == 1
    p.ph_lo = 0; p.ph_hi = NPHASE;
    void* args[] = {&p};
    hipError_t e = hipLaunchCooperativeKernel((const void*)fwd_kernel, dim3(grid_blocks), dim3(256), args, LDS_BYTES, stream);
    if (e != hipSuccess) fprintf(stderr, "cooperative launch failed: %s (grid %d)\n", hipGetErrorString(e), grid_blocks);
#else
    for (int ph = 0; ph < NPHASE; ++ph) {
        p.ph_lo = ph; p.ph_hi = ph + 1;
        hipLaunchKernelGGL(fwd_kernel, dim3(grid_blocks), dim3(256), LDS_BYTES, stream, p);
    }
#endif
}
```

```cpp
#include <hip/hip_runtime.h>
#include <hip/hip_cooperative_groups.h>
#include <stdint.h>
#include <stdio.h>
namespace cg = cooperative_groups;

#ifndef NAIVE_GEMM
#define NAIVE_GEMM 0
#endif
#ifndef NAIVE_ATTN
#define NAIVE_ATTN 0
#endif
#ifndef REPEAT_MASK
#define REPEAT_MASK 0
#endif
#ifndef N_LAUNCH_MODE
#define N_LAUNCH_MODE 2
#endif

#define DEVINL __device__ __forceinline__

typedef unsigned short bf16_t;
typedef short bf16x8 __attribute__((ext_vector_type(8)));
typedef float f32x4 __attribute__((ext_vector_type(4)));
typedef unsigned u32x4 __attribute__((ext_vector_type(4)));
typedef unsigned u32x2 __attribute__((ext_vector_type(2)));

constexpr int SEQ = 8192, DM = 1024, NT = 2 * SEQ;
constexpr int QKVW = 2304;
constexpr float EPS = 1e-6f;
constexpr float LOG2E = 1.4426950408889634f;
constexpr float QSCALE = 0.125f * LOG2E;

constexpr size_t MiB = 1u << 20;
constexpr size_t WS_CNT  = 0;
constexpr size_t WS_MOD  = 1 * MiB;
constexpr size_t WS_ROPE = 2 * MiB;
constexpr size_t WS_WQKV = 4 * MiB;
constexpr size_t WS_WOF  = 9 * MiB;
constexpr size_t WS_WRF  = 1 * MiB + 512 * 1024;
constexpr size_t WS_WGU  = 11 * MiB;
constexpr size_t WS_WD   = 43 * MiB;
constexpr size_t WS_H    = 59 * MiB;
constexpr size_t WS_NAQ  = 91 * MiB;
constexpr size_t WS_NAK  = 107 * MiB;
constexpr size_t WS_NAV  = 123 * MiB;
constexpr size_t WS_SWQ  = 139 * MiB;
constexpr size_t WS_SWK  = 155 * MiB;
constexpr size_t WS_SWV  = 159 * MiB;
constexpr size_t WS_ATT  = 163 * MiB;
constexpr size_t WS_SSQ  = 195 * MiB;
constexpr size_t WS_LTOK = 196 * MiB;
constexpr size_t WS_LW   = 198 * MiB;
constexpr size_t WS_HID  = 200 * MiB;
constexpr size_t WS_Y    = 91 * MiB;
constexpr size_t WS_END  = 218 * MiB;

constexpr int LDS_MISC = 73728;
constexpr int LDS_BYTES = LDS_MISC + 4096;

struct Params {
    const float *x, *c, *w_ada, *b_ada, *g_pre_mix, *w_in, *na_rpb, *swa_sinks, *beta_na, *beta_swa, *w_out, *g_post_mix, *g_pre_ffn,
                *w_gr, *w_er, *w_gate, *w_up, *w_down, *g_post_ffn;
    float* out; unsigned char* ws; int ph_lo, ph_hi, flags, pad;
};

DEVINL unsigned f2bf(float f) { unsigned u = __float_as_uint(f); return (u + 0x7fffu + ((u >> 16) & 1u)) >> 16; }
DEVINL unsigned pk2(float lo, float hi) { return f2bf(lo) | (f2bf(hi) << 16); }
DEVINL float bf2f(bf16_t v) { return __uint_as_float(((unsigned)v) << 16); }
DEVINL float bflo(unsigned u) { return __uint_as_float(u << 16); }
DEVINL float bfhi(unsigned u) { return __uint_as_float(u & 0xffff0000u); }
DEVINL float wave_sum(float v) {
#pragma unroll
    for (int o = 32; o >= 1; o >>= 1) v += __shfl_xor(v, o);
    return v;
}
DEVINL float silu_f(float v) { return v / (1.f + expf(-v)); }

DEVINL void mod_item(const Params& P, int item, unsigned char* smem) {
    float* s_silu = (float*)smem;
    float* s_red  = s_silu + 2048;
    const int t = threadIdx.x;
    for (int i = t; i < 2048; i += 256) s_silu[i] = silu_f(P.c[i]);
    __syncthreads();
    const int c4 = t & 7, rg = t >> 3, col = item * 32 + c4 * 4;
    f32x4 a0 = {0.f, 0.f, 0.f, 0.f}, a1 = {0.f, 0.f, 0.f, 0.f};
#pragma unroll 4
    for (int i = 0; i < 32; ++i) {
        const int k = rg + 32 * i;
        const f32x4 w = *(const f32x4*)(P.w_ada + (size_t)k * 6144 + col);
        a0 += w * s_silu[k]; a1 += w * s_silu[1024 + k];
    }
    *(f32x4*)(s_red + (rg * 2 + 0) * 32 + c4 * 4) = a0;
    *(f32x4*)(s_red + (rg * 2 + 1) * 32 + c4 * 4) = a1;
    __syncthreads();
    if (t < 64) {
        const int b = t >> 5, cc = t & 31; float s = 0.f;
        for (int r = 0; r < 32; ++r) s += s_red[(r * 2 + b) * 32 + cc];
        ((float*)(P.ws + WS_MOD))[b * 6144 + item * 32 + cc] = s + P.b_ada[item * 32 + cc];
    }
    __syncthreads();
}
DEVINL void transpose_item(const float* src, int N, int k0, int n0, bf16_t* dst, int ldd, int mode, const float* kscale, unsigned char* smem) {
    float* scr = (float*)smem;
    const int t = threadIdx.x;
#pragma unroll
    for (int p = 0; p < 4; ++p) {
        const int r = (t >> 4) + 16 * p;
        f32x4 v = *(const f32x4*)(src + (size_t)(k0 + r) * N + n0 + (t & 15) * 4);
        const float sc = kscale ? kscale[r] : 1.f;
        float* d = scr + r * 65 + (t & 15) * 4;
        d[0] = v.x * sc; d[1] = v.y * sc; d[2] = v.z * sc; d[3] = v.w * sc;
    }
    __syncthreads();
    const int n = t >> 2, kq = t & 3;
    u32x4 w0, w1;
    const float* s = scr + (kq * 16) * 65 + n;
    w0.x = pk2(s[0 * 65], s[1 * 65]);   w0.y = pk2(s[2 * 65], s[3 * 65]);   w0.z = pk2(s[4 * 65], s[5 * 65]);   w0.w = pk2(s[6 * 65], s[7 * 65]);
    w1.x = pk2(s[8 * 65], s[9 * 65]);   w1.y = pk2(s[10 * 65], s[11 * 65]); w1.z = pk2(s[12 * 65], s[13 * 65]); w1.w = pk2(s[14 * 65], s[15 * 65]);
    const int j = n0 + n;
    int drow = j;
    if (mode == 1) drow = (j >> 4) * 32 + (j & 15);
    if (mode == 2) drow = (j >> 4) * 32 + 16 + (j & 15);
    bf16_t* o = dst + (size_t)drow * ldd + k0 + kq * 16;
    *(u32x4*)o = w0; *(u32x4*)(o + 8) = w1;
    __syncthreads();
}

DEVINL void wout_frag_item(const float* src, int kb, int nb, bf16_t* dst, const float* kscale, unsigned char* smem) {
    float* scr = (float*)smem;
    const int t = threadIdx.x, k0 = kb * 64, n0 = nb * 64;
#pragma unroll
    for (int p = 0; p < 4; ++p) {
        const int r = (t >> 4) + 16 * p;
        f32x4 v = *(const f32x4*)(src + (size_t)(k0 + r) * 1024 + n0 + (t & 15) * 4);
        const float sc = kscale[r];
        float* d = scr + r * 65 + (t & 15) * 4;
        d[0] = v.x * sc; d[1] = v.y * sc; d[2] = v.z * sc; d[3] = v.w * sc;
    }
    __syncthreads();
    const int lane = t & 63, lr = lane & 15, g = lane >> 4;
#pragma unroll
    for (int i = 0; i < 2; ++i) {
        const int combo = (t >> 6) + 4 * i, ksl = combo >> 2, ntl = combo & 3;
        const float* sp = scr + (32 * ksl + 8 * g) * 65 + 16 * ntl + lr;
        u32x4 o; o.x = pk2(sp[0], sp[65]); o.y = pk2(sp[2 * 65], sp[3 * 65]); o.z = pk2(sp[4 * 65], sp[5 * 65]); o.w = pk2(sp[6 * 65], sp[7 * 65]);
        *(u32x4*)(dst + ((size_t)((kb * 2 + ksl) * 64 + nb * 4 + ntl) * 64 + lane) * 8) = o;
    }
    __syncthreads();
}
DEVINL void router_frags(const Params& P) {
    bf16_t* dst = (bf16_t*)(P.ws + WS_WRF);
    for (int i = blockIdx.x * 256 + threadIdx.x; i < 4 * 8 * 3 * 64; i += gridDim.x * 256) {
        const int lane = i & 63, ot = (i >> 6) % 3, wp = (i >> 6) / 3, p = wp & 7, w = wp >> 3, lr = lane & 15, g = lane >> 4;
        const int o = 16 * ot + lr;
        unsigned hi[8], lo[8];
#pragma unroll
        for (int j = 0; j < 8; ++j) {
            const int n = 256 * w + 32 * p + (j < 4 ? 4 * g + j : 16 + 4 * g + (j - 4));
            float v = 0.f;
            if (o < 4) v = P.w_gr[n * 4 + o]; else if (o < 36) v = P.w_er[((size_t)((o - 4) >> 3) * 1024 + n) * 8 + ((o - 4) & 7)];
            const unsigned h = f2bf(v); hi[j] = h; lo[j] = f2bf(v - __uint_as_float(h << 16));
        }
        u32x4 a, b;
        a.x = hi[0] | (hi[1] << 16); a.y = hi[2] | (hi[3] << 16); a.z = hi[4] | (hi[5] << 16); a.w = hi[6] | (hi[7] << 16);
        b.x = lo[0] | (lo[1] << 16); b.y = lo[2] | (lo[3] << 16); b.z = lo[4] | (lo[5] << 16); b.w = lo[6] | (lo[7] << 16);
        *(u32x4*)(dst + (size_t)i * 8) = a;
        *(u32x4*)(dst + (size_t)(4 * 8 * 3 * 64 + i) * 8) = b;
    }
}
DEVINL void phase0(const Params& P, unsigned char* smem) {
    const int t = threadIdx.x;
    if (blockIdx.x == 0 && t < 64) ((unsigned*)(P.ws + WS_CNT))[t] = 0u;
    {
        float* rc = (float*)(P.ws + WS_ROPE); float* rs = rc + SEQ * 32;
        for (int i = blockIdx.x * 256 + t; i < SEQ * 32; i += gridDim.x * 256) {
            const int pos = i >> 5, fi = i & 31;
            const float ex = -((float)fi * 2.0f) / 64.0f;
            const float inv = exp2f(ex * 13.287712379549449f);
            const float ang = (float)pos * inv;
            double tt = (double)ang * 0.15915494309189535; tt -= floor(tt);
            const float fr = (float)tt;
            rc[i] = __builtin_amdgcn_cosf(fr); rs[i] = __builtin_amdgcn_sinf(fr);
        }
    }
    router_frags(P);
    bf16_t* Wqkv = (bf16_t*)(P.ws + WS_WQKV); bf16_t* Wout = (bf16_t*)(P.ws + WS_WOF);
    bf16_t* Wgu = (bf16_t*)(P.ws + WS_WGU);   bf16_t* Wd = (bf16_t*)(P.ws + WS_WD);
    constexpr int NMOD = 192, NI_IN = 16 * 36, NI_OUT = 256, NI_E = 2048;
    constexpr int total = NMOD + NI_IN + NI_OUT + 3 * NI_E;
    for (int it = blockIdx.x; it < total; it += gridDim.x) {
        int r = it;
        if (r < NMOD) { mod_item(P, r, smem); continue; } r -= NMOD;
        if (r < NI_IN) { const int kb = r / 36, nb = r % 36; transpose_item(P.w_in, QKVW, kb * 64, nb * 64, Wqkv, 1024, 0, nullptr, smem); continue; } r -= NI_IN;
        if (r < NI_OUT) { const int kb = r >> 4, nb = r & 15; const int k0 = kb * 64;
            const float* ks = (k0 < 512) ? (P.beta_na + k0) : (P.beta_swa + (k0 - 512));
            wout_frag_item(P.w_out, kb, nb, Wout, ks, smem); continue; } r -= NI_OUT;
        if (r < NI_E) { const int e = r >> 6, q = r & 63, kb = q >> 2, nb = q & 3;
            transpose_item(P.w_gate + (size_t)e * 1024 * 256, 256, kb * 64, nb * 64, Wgu + (size_t)e * 512 * 1024, 1024, 1, nullptr, smem); continue; } r -= NI_E;
        if (r < NI_E) { const int e = r >> 6, q = r & 63, kb = q >> 2, nb = q & 3;
            transpose_item(P.w_up + (size_t)e * 1024 * 256, 256, kb * 64, nb * 64, Wgu + (size_t)e * 512 * 1024, 1024, 2, nullptr, smem); continue; } r -= NI_E;
        { const int e = r >> 6, q = r & 63, kb = q >> 4, nb = q & 15;
            transpose_item(P.w_down + (size_t)e * 256 * 1024, 1024, kb * 64, nb * 64, Wd + (size_t)e * 1024 * 256, 256, 0, nullptr, smem); }
    }
}

DEVINL void phase1(const Params& P) {
    const int lane = threadIdx.x & 63, gw = blockIdx.x * 4 + (threadIdx.x >> 6), ngw = gridDim.x * 4;
    const float* mod = (const float*)(P.ws + WS_MOD);
    bf16_t* H = (bf16_t*)(P.ws + WS_H);
    for (int row = gw; row < NT; row += ngw) {
        const f32x4* xr = (const f32x4*)(P.x + (size_t)row * DM) + lane;
        f32x4 v[4]; float ss = 0.f;
#pragma unroll
        for (int j = 0; j < 4; ++j) { v[j] = xr[64 * j]; ss += v[j].x * v[j].x + v[j].y * v[j].y + v[j].z * v[j].z + v[j].w * v[j].w; }
        ss = wave_sum(ss);
        const float rstd = rsqrtf(ss * (1.f / DM) + EPS);
        const float* mb = mod + (row >> 13) * 6144;
#pragma unroll
        for (int j = 0; j < 4; ++j) {
            const int col = 4 * lane + 256 * j;
            const f32x4 g = *(const f32x4*)(P.g_pre_mix + col), sc = *(const f32x4*)(mb + 1024 + col), sh = *(const f32x4*)(mb + col);
            const f32x4 h = v[j] * rstd * g * (sc + 1.f) + sh;
            u32x2 o; o.x = pk2(h.x, h.y); o.y = pk2(h.z, h.w);
            *(u32x2*)(H + (size_t)row * DM + col) = o;
        }
    }
}

DEVINL int lds_off(int row, int chunk) { return row * 128 + ((chunk ^ ((row >> 1) & 7)) << 4); }

DEVINL void gemm_core(f32x4 (&acc)[4][4], const bf16_t* a0, const bf16_t* a1, const bf16_t* a2, const bf16_t* a3,
                      const bf16_t* b0, const bf16_t* b1, const bf16_t* b2, const bf16_t* b3, int kbeg, int kend, unsigned char* smem) {
    const int t = threadIdx.x, lane = t & 63, w = t >> 6, wm = w & 1, wn = w >> 1, lr = lane & 15, g = lane >> 4;
    const int ldrow = t >> 3, ldc = t & 7;
#if NAIVE_GEMM
    const bf16_t** sp = (const bf16_t**)(smem + LDS_MISC);
    __syncthreads();
    if (ldc == 0) { sp[ldrow] = a0; sp[ldrow + 32] = a1; sp[ldrow + 64] = a2; sp[ldrow + 96] = a3;
                    sp[128 + ldrow] = b0; sp[128 + ldrow + 32] = b1; sp[128 + ldrow + 64] = b2; sp[128 + ldrow + 96] = b3; }
    __syncthreads();
#pragma unroll
    for (int ni = 0; ni < 4; ++ni)
#pragma unroll
        for (int mi = 0; mi < 4; ++mi) {
            const bf16_t* ap = sp[64 * wm + 16 * mi + lr];
#pragma unroll
            for (int reg = 0; reg < 4; ++reg) {
                const bf16_t* bp = sp[128 + 64 * wn + 16 * ni + 4 * g + reg];
                float s = 0.f;
#pragma unroll 1
                for (int k = kbeg; k < kend; k += 8) {
                    const u32x4 av = *(const u32x4*)(ap + k), bv = *(const u32x4*)(bp + k);
                    s += bflo(av.x) * bflo(bv.x) + bfhi(av.x) * bfhi(bv.x) + bflo(av.y) * bflo(bv.y) + bfhi(av.y) * bfhi(bv.y)
                       + bflo(av.z) * bflo(bv.z) + bfhi(av.z) * bfhi(bv.z) + bflo(av.w) * bflo(bv.w) + bfhi(av.w) * bfhi(bv.w);
                }
                acc[ni][mi][reg] += s;
            }
        }
    __syncthreads();
#else
    u32x4 ra0, ra1, ra2, ra3, rb0, rb1, rb2, rb3;
    const int wo0 = lds_off(ldrow, ldc), wo1 = lds_off(ldrow + 32, ldc), wo2 = lds_off(ldrow + 64, ldc), wo3 = lds_off(ldrow + 96, ldc);
#define GLOAD(kk) do { const int ko_ = (kk) + ldc * 8; \
        ra0 = *(const u32x4*)(a0 + ko_); ra1 = *(const u32x4*)(a1 + ko_); ra2 = *(const u32x4*)(a2 + ko_); ra3 = *(const u32x4*)(a3 + ko_); \
        rb0 = *(const u32x4*)(b0 + ko_); rb1 = *(const u32x4*)(b1 + ko_); rb2 = *(const u32x4*)(b2 + ko_); rb3 = *(const u32x4*)(b3 + ko_); } while (0)
#define LWRITE(buf) do { unsigned char* a_ = smem + (buf) * 32768; unsigned char* b_ = a_ + 16384; \
        *(u32x4*)(a_ + wo0) = ra0; *(u32x4*)(a_ + wo1) = ra1; *(u32x4*)(a_ + wo2) = ra2; *(u32x4*)(a_ + wo3) = ra3; \
        *(u32x4*)(b_ + wo0) = rb0; *(u32x4*)(b_ + wo1) = rb1; *(u32x4*)(b_ + wo2) = rb2; *(u32x4*)(b_ + wo3) = rb3; } while (0)
    const int nk = (kend - kbeg) >> 6;
    __syncthreads();
    GLOAD(kbeg); LWRITE(0); __syncthreads();
    for (int kt = 0; kt < nk; ++kt) {
        if (kt + 1 < nk) GLOAD(kbeg + (kt + 1) * 64);
        const unsigned char* a_ = smem + (kt & 1) * 32768; const unsigned char* b_ = a_ + 16384;
#pragma unroll
        for (int ks = 0; ks < 2; ++ks) {
            bf16x8 fa[4], fb[4];
#pragma unroll
            for (int i = 0; i < 4; ++i) { fa[i] = *(const bf16x8*)(a_ + lds_off(64 * wm + 16 * i + lr, ks * 4 + g)); fb[i] = *(const bf16x8*)(b_ + lds_off(64 * wn + 16 * i + lr, ks * 4 + g)); }
#pragma unroll
            for (int ni = 0; ni < 4; ++ni)
#pragma unroll
                for (int mi = 0; mi < 4; ++mi) acc[ni][mi] = __builtin_amdgcn_mfma_f32_16x16x32_bf16(fb[ni], fa[mi], acc[ni][mi], 0, 0, 0);
        }
        if (kt + 1 < nk) LWRITE((kt + 1) & 1);
        __syncthreads();
    }
#undef GLOAD
#undef LWRITE
#endif
}
DEVINL void zero_acc(f32x4 (&acc)[4][4]) {
#pragma unroll
    for (int i = 0; i < 4; ++i)
#pragma unroll
        for (int j = 0; j < 4; ++j) acc[i][j] = (f32x4){0.f, 0.f, 0.f, 0.f};
}

DEVINL void phase2(const Params& P, unsigned char* smem) {
    const int t = threadIdx.x, lane = t & 63, w = t >> 6, wm = w & 1, wn = w >> 1, lr = lane & 15, g = lane >> 4, ldrow = t >> 3;
    const bf16_t* H = (const bf16_t*)(P.ws + WS_H); const bf16_t* Wt = (const bf16_t*)(P.ws + WS_WQKV);
    const float* rc = (const float*)(P.ws + WS_ROPE); const float* rs = rc + SEQ * 32;
    constexpr int TN = QKVW / 128, TM = NT / 128;
    for (int it = blockIdx.x; it < TN * TM; it += gridDim.x) {
        const int tm = it / TN, tn = it % TN, m0 = tm * 128, n0 = tn * 128;
        const bf16_t* ab = H + (size_t)(m0 + ldrow) * DM; const bf16_t* bb = Wt + (size_t)(n0 + ldrow) * DM;
        f32x4 acc[4][4]; zero_acc(acc);
        gemm_core(acc, ab, ab + 32 * DM, ab + 64 * DM, ab + 96 * DM, bb, bb + 32 * DM, bb + 64 * DM, bb + 96 * DM, 0, DM, smem);
        const int nW = n0 + 64 * wn;
        int region, hh;
        if (nW < 512) { region = 0; hh = nW >> 6; } else if (nW < 1024) { region = 1; hh = (nW - 512) >> 6; } else if (nW < 1536) { region = 2; hh = (nW - 1024) >> 6; }
        else if (nW < 2048) { region = 3; hh = (nW - 1536) >> 6; } else if (nW < 2176) { region = 4; hh = (nW - 2048) >> 6; } else { region = 5; hh = (nW - 2176) >> 6; }
#pragma unroll
        for (int mi = 0; mi < 4; ++mi) {
            const int m = m0 + 64 * wm + 16 * mi + lr, b = m >> 13, s = m & (SEQ - 1);
            f32x4 v[4];
#pragma unroll
            for (int ni = 0; ni < 4; ++ni) v[ni] = acc[ni][mi];
            if (region == 3 || region == 4) {
#pragma unroll
                for (int ni = 0; ni < 2; ++ni) {
                    const f32x4 cs = *(const f32x4*)(rc + s * 32 + 16 * ni + 4 * g), sn = *(const f32x4*)(rs + s * 32 + 16 * ni + 4 * g);
                    const f32x4 x1 = v[ni], x2 = v[ni + 2];
                    v[ni] = x1 * cs - x2 * sn; v[ni + 2] = x2 * cs + x1 * sn;
                }
            }
            if (region == 0 || region == 3) {
#pragma unroll
                for (int ni = 0; ni < 4; ++ni) v[ni] = v[ni] * QSCALE;
            }
            {
                const size_t off = region == 0 ? WS_NAQ : region == 1 ? WS_NAK : region == 2 ? WS_NAV : region == 3 ? WS_SWQ : region == 4 ? WS_SWK : WS_SWV;
                const int nh = (region >= 4) ? 2 : 8;
                bf16_t* base = (bf16_t*)(P.ws + off) + ((size_t)(b * nh + hh) * SEQ + s) * 64;
#pragma unroll
                for (int ni = 0; ni < 4; ++ni) { u32x2 o; o.x = pk2(v[ni].x, v[ni].y); o.y = pk2(v[ni].z, v[ni].w); *(u32x2*)(base + 16 * ni + 4 * g) = o; }
            }
        }
    }
}

#if NAIVE_ATTN
DEVINL void phase3(const Params& P, unsigned char* smem) {
    const int lane = threadIdx.x & 63, gw = blockIdx.x * 4 + (threadIdx.x >> 6), ngw = gridDim.x * 4;
    bf16_t* ATT = (bf16_t*)(P.ws + WS_ATT); float* SSQ = (float*)(P.ws + WS_SSQ);
    for (int it = gw; it < NT * 16; it += ngw) {
        const int isw = it >= NT * 8; const int r = isw ? it - NT * 8 : it;
        const int tok = r >> 3, h = r & 7, b = tok >> 13, s = tok & (SEQ - 1);
        float m = -3.0e38f, sum = 0.f, o = 0.f;
        if (!isw) {
            const bf16_t* Q = (const bf16_t*)(P.ws + WS_NAQ) + ((size_t)(b * 8 + h) * SEQ) * 64;
            const bf16_t* K = (const bf16_t*)(P.ws + WS_NAK) + ((size_t)(b * 8 + h) * SEQ) * 64;
            const bf16_t* VT = (const bf16_t*)(P.ws + WS_NAV) + ((size_t)(b * 8 + h) * SEQ) * 64;
            const float q = bf2f(Q[(size_t)s * 64 + lane]);
            const int row = s >> 6, col = s & 63;
            int r0 = row - 4; r0 = r0 < 0 ? 0 : (r0 > 120 ? 120 : r0);
            int cs = col - 8; cs = cs < 0 ? 0 : (cs > 48 ? 48 : cs);
            const float* rpb = P.na_rpb + h * 15 * 31;
            for (int pass = 0; pass < 2; ++pass)
                for (int i = 0; i < 8; ++i)
                    for (int j = 0; j < 16; ++j) {
                        const int key = (r0 + i) * 64 + cs + j;
                        float d = wave_sum(q * bf2f(K[(size_t)key * 64 + lane]));
                        d += rpb[(r0 + i - row + 7) * 31 + (cs + j - col + 15)] * LOG2E;
                        if (pass == 0) m = fmaxf(m, d);
                        else { const float p = exp2f(d - m); sum += p; o += p * bf2f(VT[(size_t)key * 64 + lane]); }
                    }
        } else {
            const int kvh = h >> 2;
            const bf16_t* Q = (const bf16_t*)(P.ws + WS_SWQ) + ((size_t)(b * 8 + h) * SEQ) * 64;
            const bf16_t* K = (const bf16_t*)(P.ws + WS_SWK) + ((size_t)(b * 2 + kvh) * SEQ) * 64;
            const bf16_t* VT = (const bf16_t*)(P.ws + WS_SWV) + ((size_t)(b * 2 + kvh) * SEQ) * 64;
            const float q = bf2f(Q[(size_t)s * 64 + lane]);
            const int klo = s - 128 < 0 ? 0 : s - 128, khi = s + 128 > SEQ - 1 ? SEQ - 1 : s + 128;
            const float sk = P.swa_sinks[h] * LOG2E;
            m = sk;
            for (int pass = 0; pass < 2; ++pass)
                for (int key = klo; key <= khi; ++key) {
                    const float d = wave_sum(q * bf2f(K[(size_t)key * 64 + lane]));
                    if (pass == 0) m = fmaxf(m, d);
                    else { const float p = exp2f(d - m); sum += p; o += p * bf2f(VT[(size_t)key * 64 + lane]); }
                }
            sum += exp2f(sk - m);
        }
        o /= sum;
        ATT[(size_t)tok * DM + (isw ? 512 : 0) + h * 64 + lane] = (bf16_t)f2bf(o);
        const float sq = wave_sum(o * o);
        if (lane == 0) SSQ[tok * 16 + (isw ? 8 : 0) + h] = sq;
    }
}
#else
typedef short s16x4 __attribute__((ext_vector_type(4)));
#define LAS3 __attribute__((address_space(3)))
DEVINL int k_off(int row, int c) { return row * 128 + ((c ^ ((row >> 1) & 7)) << 4); }
DEVINL int v_off(int row, int c) { return row * 128 + ((((c >> 1) ^ ((row >> 1) & 3)) << 5) | ((c & 1) << 4)); }
DEVINL bf16x8 tr_pair(const LAS3 unsigned char* p0, const LAS3 unsigned char* p1) {
    const s16x4 a = __builtin_amdgcn_ds_read_tr16_b64_v4i16((LAS3 s16x4*)p0), b = __builtin_amdgcn_ds_read_tr16_b64_v4i16((LAS3 s16x4*)p1);
    bf16x8 r; r[0] = a[0]; r[1] = a[1]; r[2] = a[2]; r[3] = a[3]; r[4] = b[0]; r[5] = b[1]; r[6] = b[2]; r[7] = b[3]; return r;
}
DEVINL void phase3(const Params& P, unsigned char* smem) {
    const int t = threadIdx.x, lane = t & 63, w = t >> 6, lr = lane & 15, g = lane >> 4;
    bf16_t* ATT = (bf16_t*)(P.ws + WS_ATT); float* SSQ = (float*)(P.ws + WS_SSQ);
    const LAS3 unsigned char* lsm = (const LAS3 unsigned char*)smem;
    constexpr int N_NA = 2 * 8 * 128, N_SW = 2 * 2 * 512;
    for (int it = blockIdx.x; it < N_NA + N_SW; it += gridDim.x) {
        if (it < N_NA) {
            const int r = it & 127, h = (it >> 7) & 7, b = it >> 10;
            const int c0 = 16 * w;
            int r0 = r - 4; r0 = r0 < 0 ? 0 : (r0 > 120 ? 120 : r0);
            int kc0 = c0 - 8; kc0 = kc0 < 0 ? 0 : (kc0 > 32 ? 32 : kc0);
            const bf16_t* Q = (const bf16_t*)(P.ws + WS_NAQ) + ((size_t)(b * 8 + h) * SEQ) * 64;
            const bf16_t* Kg = (const bf16_t*)(P.ws + WS_NAK) + ((size_t)(b * 8 + h) * SEQ + r0 * 64) * 64;
            const bf16_t* Vg = (const bf16_t*)(P.ws + WS_NAV) + ((size_t)(b * 8 + h) * SEQ + r0 * 64) * 64;
            __syncthreads();
            {
                u32x4 kr[16];
#pragma unroll
                for (int i = 0; i < 16; ++i) kr[i] = *(const u32x4*)(Kg + (size_t)(t + 256 * i) * 8);
#pragma unroll
                for (int i = 0; i < 16; ++i) { const int q = t + 256 * i; *(u32x4*)(smem + k_off(q >> 3, q & 7)) = kr[i]; }
            }
            const bf16_t* qp = Q + (size_t)(r * 64 + c0 + lr) * 64 + 8 * g;
            const bf16x8 q0 = *(const bf16x8*)qp, q1 = *(const bf16x8*)(qp + 32);
            __syncthreads();
            u32x4 vr[8];
#pragma unroll
            for (int i = 0; i < 8; ++i) vr[i] = *(const u32x4*)(Vg + (size_t)(t + 256 * i) * 8);
            f32x4 sc[16];
#pragma unroll
            for (int tt = 0; tt < 16; ++tt) {
                const int row = (tt >> 1) * 64 + kc0 + (tt & 1) * 16 + lr;
                const bf16x8 k0 = *(const bf16x8*)(smem + k_off(row, g)), k1 = *(const bf16x8*)(smem + k_off(row, 4 + g));
                f32x4 a = {0.f, 0.f, 0.f, 0.f};
                a = __builtin_amdgcn_mfma_f32_16x16x32_bf16(k0, q0, a, 0, 0, 0);
                a = __builtin_amdgcn_mfma_f32_16x16x32_bf16(k1, q1, a, 0, 0, 0);
                sc[tt] = a;
            }
            const int c = c0 + lr; int cs = c - 8; cs = cs < 0 ? 0 : (cs > 48 ? 48 : cs);
            const float* rp = P.na_rpb + h * 465;
            float mx = -3.0e38f;
#pragma unroll
            for (int tt = 0; tt < 16; ++tt) {
                const int dr = r0 + (tt >> 1) - r + 7;
#pragma unroll
                for (int e = 0; e < 4; ++e) {
                    const int kc = kc0 + (tt & 1) * 16 + 4 * g + e;
                    const bool ok = (kc >= cs) && (kc < cs + 16);
                    int dc = kc - c + 15; dc = dc < 0 ? 0 : (dc > 30 ? 30 : dc);
                    const float v = ok ? sc[tt][e] + rp[dr * 31 + dc] * LOG2E : -3.0e38f;
                    sc[tt][e] = v; mx = fmaxf(mx, v);
                }
            }
            mx = fmaxf(mx, __shfl_xor(mx, 16)); mx = fmaxf(mx, __shfl_xor(mx, 32));
            float sum = 0.f;
            bf16x8 pf[8];
#pragma unroll
            for (int kk = 0; kk < 8; ++kk) {
                float p[8];
#pragma unroll
                for (int e = 0; e < 4; ++e) { p[e] = __builtin_amdgcn_exp2f(sc[2 * kk][e] - mx); p[4 + e] = __builtin_amdgcn_exp2f(sc[2 * kk + 1][e] - mx); }
                sum += ((p[0] + p[1]) + (p[2] + p[3])) + ((p[4] + p[5]) + (p[6] + p[7]));
                union { bf16x8 v; unsigned u[4]; } pk; pk.u[0] = pk2(p[0], p[1]); pk.u[1] = pk2(p[2], p[3]); pk.u[2] = pk2(p[4], p[5]); pk.u[3] = pk2(p[6], p[7]);
                pf[kk] = pk.v;
            }
            sum += __shfl_xor(sum, 16); sum += __shfl_xor(sum, 32);
            __syncthreads();
#pragma unroll
            for (int i = 0; i < 8; ++i) { const int q = t + 256 * i; *(u32x4*)(smem + v_off(q >> 3, q & 7)) = vr[i]; }
#pragma unroll
            for (int i = 0; i < 8; ++i) vr[i] = *(const u32x4*)(Vg + (size_t)(2048 + t + 256 * i) * 8);
            __syncthreads();
            f32x4 o[4];
#pragma unroll
            for (int dt = 0; dt < 4; ++dt) o[dt] = (f32x4){0.f, 0.f, 0.f, 0.f};
            const int vrow = kc0 + 4 * g + (lr >> 2), vsw = (vrow >> 1) & 3, vbase = vrow * 128 + (lr & 3) * 8;
#pragma unroll
            for (int kk = 0; kk < 4; ++kk)
#pragma unroll
                for (int dt = 0; dt < 4; ++dt) {
                    const LAS3 unsigned char* ap = lsm + vbase + ((dt ^ vsw) << 5) + kk * 8192;
                    o[dt] = __builtin_amdgcn_mfma_f32_16x16x32_bf16(tr_pair(ap, ap + 2048), pf[kk], o[dt], 0, 0, 0);
                }
#pragma unroll
            for (int i = 0; i < 8; ++i) { const int q = t + 256 * i; *(u32x4*)(smem + 32768 + v_off(q >> 3, q & 7)) = vr[i]; }
            __syncthreads();
#pragma unroll
            for (int kk = 0; kk < 4; ++kk)
#pragma unroll
                for (int dt = 0; dt < 4; ++dt) {
                    const LAS3 unsigned char* ap = lsm + 32768 + vbase + ((dt ^ vsw) << 5) + kk * 8192;
                    o[dt] = __builtin_amdgcn_mfma_f32_16x16x32_bf16(tr_pair(ap, ap + 2048), pf[4 + kk], o[dt], 0, 0, 0);
                }
            const float inv = 1.f / sum; float sq = 0.f;
            const int tok = b * SEQ + r * 64 + c0 + lr;
#pragma unroll
            for (int dt = 0; dt < 4; ++dt) {
                const f32x4 v = o[dt] * inv; sq += v.x * v.x + v.y * v.y + v.z * v.z + v.w * v.w;
                u32x2 ov; ov.x = pk2(v.x, v.y); ov.y = pk2(v.z, v.w);
                *(u32x2*)(ATT + (size_t)tok * DM + h * 64 + 16 * dt + 4 * g) = ov;
            }
            sq += __shfl_xor(sq, 16); sq += __shfl_xor(sq, 32);
            if (g == 0) SSQ[tok * 16 + h] = sq;
        } else {
            const int r = it - N_NA, qt = r & 511, kvh = (r >> 9) & 1, b = r >> 10;
            const int hq = kvh * 4 + w, q0p = qt * 16, kb = q0p - 128;
            const bf16_t* Q = (const bf16_t*)(P.ws + WS_SWQ) + ((size_t)(b * 8 + hq) * SEQ) * 64;
            const bf16_t* Kg = (const bf16_t*)(P.ws + WS_SWK) + ((size_t)(b * 2 + kvh) * SEQ) * 64;
            const bf16_t* Vg = (const bf16_t*)(P.ws + WS_SWV) + ((size_t)(b * 2 + kvh) * SEQ) * 64;
            __syncthreads();
            {
                u32x4 kr[9], vr[9];
#pragma unroll
                for (int i = 0; i < 9; ++i) { const int q = t + 256 * i; int tokk = kb + (q >> 3); tokk = tokk < 0 ? 0 : (tokk > SEQ - 1 ? SEQ - 1 : tokk);
                    kr[i] = *(const u32x4*)(Kg + (size_t)tokk * 64 + (q & 7) * 8); vr[i] = *(const u32x4*)(Vg + (size_t)tokk * 64 + (q & 7) * 8); }
#pragma unroll
                for (int i = 0; i < 9; ++i) { const int q = t + 256 * i; *(u32x4*)(smem + k_off(q >> 3, q & 7)) = kr[i]; *(u32x4*)(smem + 36864 + v_off(q >> 3, q & 7)) = vr[i]; }
            }
            const bf16_t* qp = Q + (size_t)(q0p + lr) * 64 + 8 * g;
            const bf16x8 q0 = *(const bf16x8*)qp, q1 = *(const bf16x8*)(qp + 32);
            const float sk = P.swa_sinks[hq] * LOG2E;
            __syncthreads();
            f32x4 sc[18];
            float mx = sk;
#pragma unroll
            for (int tt = 0; tt < 18; ++tt) {
                const int kt0 = kb + 16 * tt;
                f32x4 a = {0.f, 0.f, 0.f, 0.f};
                const bool tile_ok = (tt < 17) && (kt0 >= 0) && (kt0 < SEQ);
                if (tt < 17) {
                    const int row = 16 * tt + lr;
                    const bf16x8 k0 = *(const bf16x8*)(smem + k_off(row, g)), k1 = *(const bf16x8*)(smem + k_off(row, 4 + g));
                    a = __builtin_amdgcn_mfma_f32_16x16x32_bf16(k0, q0, a, 0, 0, 0);
                    a = __builtin_amdgcn_mfma_f32_16x16x32_bf16(k1, q1, a, 0, 0, 0);
                }
#pragma unroll
                for (int e = 0; e < 4; ++e) {
                    const int dlt = 16 * tt + 4 * g + e - lr;
                    const bool ok = tile_ok && dlt >= 0 && dlt <= 256;
                    const float v = ok ? a[e] : -3.0e38f;
                    a[e] = v; mx = fmaxf(mx, v);
                }
                sc[tt] = a;
            }
            mx = fmaxf(mx, __shfl_xor(mx, 16)); mx = fmaxf(mx, __shfl_xor(mx, 32));
            float sum = 0.f;
            bf16x8 pf[9];
#pragma unroll
            for (int kk = 0; kk < 9; ++kk) {
                float p[8];
#pragma unroll
                for (int e = 0; e < 4; ++e) { p[e] = __builtin_amdgcn_exp2f(sc[2 * kk][e] - mx); p[4 + e] = __builtin_amdgcn_exp2f(sc[2 * kk + 1][e] - mx); }
                sum += ((p[0] + p[1]) + (p[2] + p[3])) + ((p[4] + p[5]) + (p[6] + p[7]));
                union { bf16x8 v; unsigned u[4]; } pk; pk.u[0] = pk2(p[0], p[1]); pk.u[1] = pk2(p[2], p[3]); pk.u[2] = pk2(p[4], p[5]); pk.u[3] = pk2(p[6], p[7]);
                pf[kk] = pk.v;
            }
            sum += __shfl_xor(sum, 16); sum += __shfl_xor(sum, 32);
            sum += __builtin_amdgcn_exp2f(sk - mx);
            f32x4 o[4];
#pragma unroll
            for (int dt = 0; dt < 4; ++dt) o[dt] = (f32x4){0.f, 0.f, 0.f, 0.f};
            const int vrow = 4 * g + (lr >> 2), vsw = (vrow >> 1) & 3, vbase = 36864 + vrow * 128 + (lr & 3) * 8;
#pragma unroll
            for (int kk = 0; kk < 9; ++kk)
#pragma unroll
                for (int dt = 0; dt < 4; ++dt) {
                    const LAS3 unsigned char* ap = lsm + vbase + ((dt ^ vsw) << 5) + kk * 4096;
                    o[dt] = __builtin_amdgcn_mfma_f32_16x16x32_bf16(tr_pair(ap, ap + 2048), pf[kk], o[dt], 0, 0, 0);
                }
            const float inv = 1.f / sum; float sq = 0.f;
            const int tok = b * SEQ + q0p + lr;
#pragma unroll
            for (int dt = 0; dt < 4; ++dt) {
                const f32x4 v = o[dt] * inv; sq += v.x * v.x + v.y * v.y + v.z * v.z + v.w * v.w;
                u32x2 ov; ov.x = pk2(v.x, v.y); ov.y = pk2(v.z, v.w);
                *(u32x2*)(ATT + (size_t)tok * DM + 512 + hq * 64 + 16 * dt + 4 * g) = ov;
            }
            sq += __shfl_xor(sq, 16); sq += __shfl_xor(sq, 32);
            if (g == 0) SSQ[tok * 16 + 8 + hq] = sq;
        }
    }
}
#endif

DEVINL void phase4(const Params& P, unsigned char* smem) {
    const int t = threadIdx.x, lane = t & 63, w = t >> 6, lr = lane & 15, g = lane >> 4;
    const bf16_t* ATT = (const bf16_t*)(P.ws + WS_ATT); const float* SSQ = (const float*)(P.ws + WS_SSQ);
    const bf16_t* WoF = (const bf16_t*)(P.ws + WS_WOF); const bf16_t* WrF = (const bf16_t*)(P.ws + WS_WRF);
    const float* mod = (const float*)(P.ws + WS_MOD);
    bf16_t* H2 = (bf16_t*)(P.ws + WS_H);
    unsigned* cnt = (unsigned*)(P.ws + WS_CNT); int* ltok = (int*)(P.ws + WS_LTOK); float* lw = (float*)(P.ws + WS_LW);
    float* s_part = (float*)smem;
    float* s_lg = (float*)(smem + 1024);
    for (int tile = blockIdx.x; tile < NT / 32; tile += gridDim.x) {
        const int m0 = tile * 32;
        __syncthreads();
        {
            const int row = t >> 3;
            const float* sp = SSQ + (size_t)(m0 + row) * 16;
            const f32x4 a = *(const f32x4*)sp, b2 = *(const f32x4*)(sp + 4), c2 = *(const f32x4*)(sp + 8), d2 = *(const f32x4*)(sp + 12);
            const float rna = rsqrtf((a.x + a.y + a.z + a.w + b2.x + b2.y + b2.z + b2.w) * (1.f / 512.f) + EPS);
            const float rsw = rsqrtf((c2.x + c2.y + c2.z + c2.w + d2.x + d2.y + d2.z + d2.w) * (1.f / 512.f) + EPS);
            const bf16_t* src = ATT + (size_t)(m0 + row) * DM;
#pragma unroll 4
            for (int i = 0; i < 16; ++i) {
                const int c = (t & 7) + 8 * i;
                u32x4 v = *(const u32x4*)(src + c * 8);
                const float sc = (c < 64) ? rna : rsw;
                v.x = pk2(bflo(v.x) * sc, bfhi(v.x) * sc); v.y = pk2(bflo(v.y) * sc, bfhi(v.y) * sc);
                v.z = pk2(bflo(v.z) * sc, bfhi(v.z) * sc); v.w = pk2(bflo(v.w) * sc, bfhi(v.w) * sc);
                *(u32x4*)(smem + row * 2048 + ((c ^ (row & 15)) << 4)) = v;
            }
        }
        __syncthreads();
        f32x4 acc[16][2];
#pragma unroll
        for (int i = 0; i < 16; ++i) { acc[i][0] = (f32x4){0.f, 0.f, 0.f, 0.f}; acc[i][1] = (f32x4){0.f, 0.f, 0.f, 0.f}; }
        {
            const unsigned char* wb = (const unsigned char*)WoF;
            unsigned voff = (unsigned)((16 * w * 64 + lane) * 16);
            asm volatile("" : "+v"(voff));
            bf16x8 b0[8], b1[8];
#define LOADB(dst, ks_, nt0_) do { const unsigned char* ub_ = wb + (size_t)((ks_) * 64 + (nt0_)) * 1024; \
        _Pragma("unroll") for (int j_ = 0; j_ < 8; ++j_) dst[j_] = *(const bf16x8*)(ub_ + j_ * 1024 + voff); } while (0)
#define MMA(src, nt0_) do { _Pragma("unroll") for (int j_ = 0; j_ < 8; ++j_) { acc[(nt0_) + j_][0] = __builtin_amdgcn_mfma_f32_16x16x32_bf16(src[j_], fa0, acc[(nt0_) + j_][0], 0, 0, 0); \
                                                                                acc[(nt0_) + j_][1] = __builtin_amdgcn_mfma_f32_16x16x32_bf16(src[j_], fa1, acc[(nt0_) + j_][1], 0, 0, 0); } } while (0)
            LOADB(b0, 0, 0);
#pragma unroll 1
            for (int ks = 0; ks < 32; ++ks) {
                LOADB(b1, ks, 8);
                const bf16x8 fa0 = *(const bf16x8*)(smem + lr * 2048 + (((4 * ks + g) ^ lr) << 4));
                const bf16x8 fa1 = *(const bf16x8*)(smem + (16 + lr) * 2048 + (((4 * ks + g) ^ lr) << 4));
                MMA(b0, 0);
                if (ks + 1 < 32) LOADB(b0, ks + 1, 0);
                MMA(b1, 8);
            }
#undef LOADB
#undef MMA
        }
        float ss0 = 0.f, ss1 = 0.f;
#pragma unroll
        for (int nt = 0; nt < 16; ++nt) {
            const f32x4 a = acc[nt][0], b2 = acc[nt][1];
            ss0 += a.x * a.x + a.y * a.y + a.z * a.z + a.w * a.w; ss1 += b2.x * b2.x + b2.y * b2.y + b2.z * b2.z + b2.w * b2.w;
        }
        ss0 += __shfl_xor(ss0, 16); ss0 += __shfl_xor(ss0, 32); ss1 += __shfl_xor(ss1, 16); ss1 += __shfl_xor(ss1, 32);
        __syncthreads();
        if (g == 0) { s_part[w * 32 + lr] = ss0; s_part[w * 32 + 16 + lr] = ss1; }
        __syncthreads();
        const float rs0 = rsqrtf((s_part[lr] + s_part[32 + lr] + s_part[64 + lr] + s_part[96 + lr]) * (1.f / DM) + EPS);
        const float rs1 = rsqrtf((s_part[16 + lr] + s_part[48 + lr] + s_part[80 + lr] + s_part[112 + lr]) * (1.f / DM) + EPS);
        const float* mb = mod + (m0 >> 13) * 6144;
        float q0 = 0.f, q1 = 0.f;
#pragma unroll
        for (int nt = 0; nt < 16; ++nt) {
            const int col = 256 * w + 16 * nt + 4 * g;
            const f32x4 gp = *(const f32x4*)(P.g_post_mix + col), ga = *(const f32x4*)(mb + 2048 + col);
            const size_t o0 = (size_t)(m0 + lr) * DM + col, o1 = o0 + 16 * DM;
            const f32x4 x0 = *(const f32x4*)(P.x + o0), x1v = *(const f32x4*)(P.x + o1);
            const f32x4 r0 = x0 + ga * (acc[nt][0] * rs0 * gp), r1 = x1v + ga * (acc[nt][1] * rs1 * gp);
            *(f32x4*)(P.out + o0) = r0; *(f32x4*)(P.out + o1) = r1;
            q0 += r0.x * r0.x + r0.y * r0.y + r0.z * r0.z + r0.w * r0.w; q1 += r1.x * r1.x + r1.y * r1.y + r1.z * r1.z + r1.w * r1.w;
            if (nt & 1) asm volatile("" ::: "memory");
        }
        q0 += __shfl_xor(q0, 16); q0 += __shfl_xor(q0, 32); q1 += __shfl_xor(q1, 16); q1 += __shfl_xor(q1, 32);
        if (g == 0) { s_part[128 + w * 32 + lr] = q0; s_part[128 + w * 32 + 16 + lr] = q1; }
        __syncthreads();
        const float rt0 = rsqrtf((s_part[128 + lr] + s_part[160 + lr] + s_part[192 + lr] + s_part[224 + lr]) * (1.f / DM) + EPS);
        const float rt1 = rsqrtf((s_part[144 + lr] + s_part[176 + lr] + s_part[208 + lr] + s_part[240 + lr]) * (1.f / DM) + EPS);
        f32x4 lg[3][2];
#pragma unroll
        for (int i = 0; i < 3; ++i) { lg[i][0] = (f32x4){0.f, 0.f, 0.f, 0.f}; lg[i][1] = (f32x4){0.f, 0.f, 0.f, 0.f}; }
        const bf16_t* wr = WrF + ((size_t)(w * 8) * 3 * 64 + lane) * 8;
#pragma unroll 1
        for (int p = 0; p < 8; ++p) {
            union { bf16x8 v; unsigned u[4]; } hh[2], hl[2];
#pragma unroll
            for (int q = 0; q < 2; ++q) {
                const int nt = 2 * p + q, col = 256 * w + 16 * nt + 4 * g;
                const f32x4 gpf = *(const f32x4*)(P.g_pre_ffn + col), sc = *(const f32x4*)(mb + 4096 + col), sh = *(const f32x4*)(mb + 3072 + col);
                const f32x4 mul = gpf * (sc + 1.f);
#pragma unroll
                for (int mi = 0; mi < 2; ++mi) {
                    const f32x4 x1r = *(const f32x4*)(P.out + (size_t)(m0 + 16 * mi + lr) * DM + col);
                    const f32x4 h = x1r * (mi ? rt1 : rt0) * mul + sh;
                    const unsigned a0 = f2bf(h.x), a1 = f2bf(h.y), a2 = f2bf(h.z), a3 = f2bf(h.w);
                    const unsigned u01 = a0 | (a1 << 16), u23 = a2 | (a3 << 16);
                    u32x2 ov; ov.x = u01; ov.y = u23;
                    *(u32x2*)(H2 + (size_t)(m0 + 16 * mi + lr) * DM + col) = ov;
                    hh[mi].u[2 * q] = u01; hh[mi].u[2 * q + 1] = u23;
                    hl[mi].u[2 * q] = pk2(h.x - __uint_as_float(a0 << 16), h.y - __uint_as_float(a1 << 16));
                    hl[mi].u[2 * q + 1] = pk2(h.z - __uint_as_float(a2 << 16), h.w - __uint_as_float(a3 << 16));
                }
            }
#pragma unroll
            for (int ot = 0; ot < 3; ++ot) {
                const bf16x8 whi = *(const bf16x8*)(wr + (size_t)(p * 3 + ot) * 512);
                const bf16x8 wlo = *(const bf16x8*)(wr + (size_t)(4 * 8 * 3 * 64) * 8 + (size_t)(p * 3 + ot) * 512);
#pragma unroll
                for (int mi = 0; mi < 2; ++mi) {
                    lg[ot][mi] = __builtin_amdgcn_mfma_f32_16x16x32_bf16(whi, hh[mi].v, lg[ot][mi], 0, 0, 0);
                    lg[ot][mi] = __builtin_amdgcn_mfma_f32_16x16x32_bf16(whi, hl[mi].v, lg[ot][mi], 0, 0, 0);
                    lg[ot][mi] = __builtin_amdgcn_mfma_f32_16x16x32_bf16(wlo, hh[mi].v, lg[ot][mi], 0, 0, 0);
                }
            }
            asm volatile("" ::: "memory");
        }
#pragma unroll
        for (int ot = 0; ot < 3; ++ot)
#pragma unroll
            for (int mi = 0; mi < 2; ++mi)
#pragma unroll
                for (int e = 0; e < 4; ++e) s_lg[(w * 48 + 16 * ot + 4 * g + e) * 32 + 16 * mi + lr] = lg[ot][mi][e];
        __syncthreads();
        if (t < 32 && !(P.flags & 1)) {
            const int row = m0 + t;
#define LG(o) (s_lg[(o) * 32 + t] + s_lg[(48 + (o)) * 32 + t] + s_lg[(96 + (o)) * 32 + t] + s_lg[(144 + (o)) * 32 + t])
            const float g0 = LG(0), g1 = LG(1), g2 = LG(2), g3 = LG(3);
            int gtop = 0; float gm = g0;
            if (g1 > gm) { gm = g1; gtop = 1; } if (g2 > gm) { gm = g2; gtop = 2; } if (g3 > gm) { gm = g3; gtop = 3; }
            const float gwt = 1.f / (expf(g0 - gm) + expf(g1 - gm) + expf(g2 - gm) + expf(g3 - gm));
            int i1 = 0, i2 = 0; float v1 = -3.0e38f, v2 = -3.0e38f;
            for (int e = 0; e < 8; ++e) {
                const float v = LG(4 + gtop * 8 + e);
                if (v > v1) { v2 = v1; i2 = i1; v1 = v; i1 = e; } else if (v > v2) { v2 = v; i2 = e; }
            }
#undef LG
            const float ex = expf(v2 - v1), w1 = gwt / (1.f + ex), w2 = gwt * ex / (1.f + ex);
            const int ea1 = gtop * 8 + i1, ea2 = gtop * 8 + i2;
            const unsigned p1 = atomicAdd(&cnt[ea1], 1u); ltok[ea1 * NT + p1] = row * 2;     lw[ea1 * NT + p1] = w1;
            const unsigned p2 = atomicAdd(&cnt[ea2], 1u); ltok[ea2 * NT + p2] = row * 2 + 1; lw[ea2 * NT + p2] = w2;
        }
    }
}

DEVINL void phase5a(const Params& P, unsigned char* smem) {
    const int t = threadIdx.x, lane = t & 63, w = t >> 6, wm = w & 1, wn = w >> 1, lr = lane & 15, g = lane >> 4, ldrow = t >> 3;
    const bf16_t* H = (const bf16_t*)(P.ws + WS_H); const bf16_t* Wgu = (const bf16_t*)(P.ws + WS_WGU);
    const unsigned* cnt = (const unsigned*)(P.ws + WS_CNT); const int* ltok = (const int*)(P.ws + WS_LTOK);
    bf16_t* HID = (bf16_t*)(P.ws + WS_HID);
    int total = 0;
    for (int e = 0; e < 32; ++e) total += ((int)cnt[e] + 127) >> 7;
    for (int it = blockIdx.x; it < total * 4; it += gridDim.x) {
        const int tn = it & 3; int mt = it >> 2, e = 0, off = 0;
        for (; e < 32; ++e) { const int c = (int)cnt[e], nt = (c + 127) >> 7; if (mt < nt) break; mt -= nt; off += c; }
        const int ce = (int)cnt[e], n0 = tn * 128;
        const bf16_t* ar[4];
#pragma unroll
        for (int i = 0; i < 4; ++i) { const int r = mt * 128 + ldrow + 32 * i; const int tok = (r < ce) ? (ltok[e * NT + r] >> 1) : 0; ar[i] = H + (size_t)tok * DM; }
        const bf16_t* bb = Wgu + ((size_t)e * 512 + n0 + ldrow) * DM;
        f32x4 acc[4][4]; zero_acc(acc);
        gemm_core(acc, ar[0], ar[1], ar[2], ar[3], bb, bb + 32 * DM, bb + 64 * DM, bb + 96 * DM, 0, DM, smem);
#pragma unroll
        for (int mi = 0; mi < 4; ++mi) {
            const int r = mt * 128 + 64 * wm + 16 * mi + lr;
            if (r < ce) {
#pragma unroll
                for (int p = 0; p < 2; ++p) {
                    const f32x4 gt = acc[2 * p][mi], up = acc[2 * p + 1][mi];
                    f32x4 hd; hd.x = silu_f(gt.x) * up.x; hd.y = silu_f(gt.y) * up.y; hd.z = silu_f(gt.z) * up.z; hd.w = silu_f(gt.w) * up.w;
                    u32x2 o; o.x = pk2(hd.x, hd.y); o.y = pk2(hd.z, hd.w);
                    *(u32x2*)(HID + (size_t)(off + r) * 256 + (n0 >> 1) + 32 * wn + 16 * p + 4 * g) = o;
                }
            }
        }
    }
}
DEVINL void phase5b(const Params& P, unsigned char* smem) {
    const int t = threadIdx.x, lane = t & 63, w = t >> 6, wm = w & 1, wn = w >> 1, lr = lane & 15, g = lane >> 4, ldrow = t >> 3;
    const bf16_t* HID = (const bf16_t*)(P.ws + WS_HID); const bf16_t* Wd = (const bf16_t*)(P.ws + WS_WD);
    const unsigned* cnt = (const unsigned*)(P.ws + WS_CNT); const int* ltok = (const int*)(P.ws + WS_LTOK); const float* lw = (const float*)(P.ws + WS_LW);
    bf16_t* Y = (bf16_t*)(P.ws + WS_Y);
    int total = 0;
    for (int e = 0; e < 32; ++e) total += ((int)cnt[e] + 127) >> 7;
    for (int it = blockIdx.x; it < total * 8; it += gridDim.x) {
        const int tn = it & 7; int mt = it >> 3, e = 0, off = 0;
        for (; e < 32; ++e) { const int c = (int)cnt[e], nt = (c + 127) >> 7; if (mt < nt) break; mt -= nt; off += c; }
        const int ce = (int)cnt[e], n0 = tn * 128;
        const bf16_t* ar[4];
#pragma unroll
        for (int i = 0; i < 4; ++i) { int r = mt * 128 + ldrow + 32 * i; r = r < ce ? r : ce - 1; ar[i] = HID + (size_t)(off + r) * 256; }
        const bf16_t* bb = Wd + ((size_t)e * 1024 + n0 + ldrow) * 256;
        f32x4 acc[4][4]; zero_acc(acc);
        gemm_core(acc, ar[0], ar[1], ar[2], ar[3], bb, bb + 32 * 256, bb + 64 * 256, bb + 96 * 256, 0, 256, smem);
#pragma unroll
        for (int mi = 0; mi < 4; ++mi) {
            const int r = mt * 128 + 64 * wm + 16 * mi + lr;
            if (r < ce) {
                const int ent = ltok[e * NT + r]; const float wt = lw[e * NT + r];
                bf16_t* yp = Y + ((size_t)(ent & 1) * NT + (ent >> 1)) * DM + n0 + 64 * wn + 4 * g;
#pragma unroll
                for (int ni = 0; ni < 4; ++ni) { const f32x4 v = acc[ni][mi] * wt; u32x2 o; o.x = pk2(v.x, v.y); o.y = pk2(v.z, v.w); *(u32x2*)(yp + 16 * ni) = o; }
            }
        }
    }
}
DEVINL void phase6(const Params& P) {
    const int lane = threadIdx.x & 63, gw = blockIdx.x * 4 + (threadIdx.x >> 6), ngw = gridDim.x * 4;
    const float* mod = (const float*)(P.ws + WS_MOD);
    const bf16_t* Y = (const bf16_t*)(P.ws + WS_Y);
    for (int row = gw; row < NT; row += ngw) {
        const float* mb = mod + (row >> 13) * 6144;
        f32x4 y[4]; float ss = 0.f;
#pragma unroll
        for (int j = 0; j < 4; ++j) {
            const int col = 4 * lane + 256 * j;
            const u32x2 a = *(const u32x2*)(Y + (size_t)row * DM + col), b = *(const u32x2*)(Y + ((size_t)NT + row) * DM + col);
            y[j] = (f32x4){bflo(a.x) + bflo(b.x), bfhi(a.x) + bfhi(b.x), bflo(a.y) + bflo(b.y), bfhi(a.y) + bfhi(b.y)};
            ss += y[j].x * y[j].x + y[j].y * y[j].y + y[j].z * y[j].z + y[j].w * y[j].w;
        }
        ss = wave_sum(ss);
        const float rstd = rsqrtf(ss * (1.f / DM) + EPS);
#pragma unroll
        for (int j = 0; j < 4; ++j) {
            const int col = 4 * lane + 256 * j;
            const f32x4 x1 = *(const f32x4*)(P.out + (size_t)row * DM + col), gp = *(const f32x4*)(P.g_post_ffn + col), gf = *(const f32x4*)(mb + 5120 + col);
            float* dst = (P.flags & 1) ? (float*)(P.ws + 155 * MiB) : P.out;
            *(f32x4*)(dst + (size_t)row * DM + col) = x1 + gf * (y[j] * rstd * gp);
        }
    }
}


#define LAS __attribute__((address_space(3)))
#define XB_TMO      128
#define XB_XCNT(j)  (256  + 64 * (j))
#define XB_XSUB(j)  (1280 + 64 * (j))
#define XB_XGEN(j)  (2304 + 64 * (j))
#define XB_TOP      3328
#define XB_TOPGEN   3392
#define XCD_BAR_WORDS 3456
#define XB_SPIN_CAP (1u << 18)
DEVINL unsigned xb_ld(unsigned* p)              { return __hip_atomic_load(p, __ATOMIC_RELAXED, __HIP_MEMORY_SCOPE_AGENT); }
DEVINL unsigned xb_add(unsigned* p, unsigned v) { return __hip_atomic_fetch_add(p, v, __ATOMIC_RELAXED, __HIP_MEMORY_SCOPE_AGENT); }
DEVINL unsigned xb_xcc_id() { return (unsigned)__builtin_amdgcn_s_getreg((3 << 11) | 20) & 0xFu; }
#define XB_SPIN(cond, bar) do { unsigned _sp = 0; while (cond) { __builtin_amdgcn_s_sleep(1); \
    if ((++_sp & 255u) == 0u) { if (xb_ld(&(bar)[XB_TMO])) break; if (_sp > XB_SPIN_CAP) { atomicAdd(&(bar)[XB_TMO], 1u); break; } } } } while (0)
struct XcdBarrier { unsigned* bar; unsigned x; volatile LAS unsigned* st; };
DEVINL XcdBarrier xcd_barrier_post(unsigned* bar, volatile LAS unsigned* st) {
    XcdBarrier b; b.bar = bar; b.x = xb_xcc_id(); b.st = st;
    if (threadIdx.x == 0) (void)xb_add(&bar[XB_XCNT(b.x)], 1u);
    return b;
}
DEVINL void xcd_barrier_complete(unsigned* bar, unsigned x, unsigned& nloc, unsigned& nx) {
    const unsigned G = gridDim.x * gridDim.y * gridDim.z;
    unsigned sum, cnt, mine, sp = 0u;
    for (;;) {
        sum = 0u; cnt = 0u; mine = 0u;
#pragma unroll
        for (unsigned j = 0; j < 16; ++j) { const unsigned c = xb_ld(&bar[XB_XCNT(j)]); sum += c; cnt += (c > 0u) ? 1u : 0u; mine = (j == x) ? c : mine; }
        if (sum == G) break;
        __builtin_amdgcn_s_sleep(1);
        if ((++sp & 255u) == 0u) { if (xb_ld(&bar[XB_TMO])) break; if (sp > XB_SPIN_CAP) { atomicAdd(&bar[XB_TMO], 1u); break; } }
    }
    nloc = mine > 0u ? mine : 1u; nx = cnt > 0u ? cnt : 1u;
}
DEVINL void xcd_barrier(const XcdBarrier& b) {
    asm volatile("s_waitcnt vmcnt(0)" ::: "memory");
    __syncthreads();
    if (threadIdx.x == 0) {
        unsigned* bar = b.bar;
        __builtin_amdgcn_s_waitcnt(0);
        unsigned nloc = b.st[0], nx = b.st[1];
        if (nloc == 0u) { xcd_barrier_complete(bar, b.x, nloc, nx); b.st[0] = nloc; b.st[1] = nx; }
        const unsigned old = xb_add(&bar[XB_XSUB(b.x)], 1u);
        const unsigned gen = old / nloc;
        if (old + 1u == (gen + 1u) * nloc) {
            __builtin_amdgcn_fence(__ATOMIC_RELEASE, "agent");
            asm volatile("s_waitcnt vmcnt(0)" ::: "memory");
            const unsigned og = xb_add(&bar[XB_TOP], 1u);
            const unsigned tg = og / nx;
            if (og + 1u == (tg + 1u) * nx) xb_add(&bar[XB_TOPGEN], 1u);
            else XB_SPIN(xb_ld(&bar[XB_TOPGEN]) == tg, bar);
            __builtin_amdgcn_fence(__ATOMIC_ACQUIRE, "agent");
            xb_add(&bar[XB_XGEN(b.x)], 1u);
            asm volatile("s_waitcnt vmcnt(0)" ::: "memory");
        } else {
            XB_SPIN(xb_ld(&bar[XB_XGEN(b.x)]) == gen, bar);
            __builtin_amdgcn_fence(__ATOMIC_ACQUIRE, "agent");
            asm volatile("s_waitcnt vmcnt(0)" ::: "memory");
        }
    }
    __syncthreads();
}
constexpr size_t WS_BAR = 16384;
constexpr size_t CTL_ZERO_BYTES = 65536;

constexpr int NPHASE = 8;
__global__ void __launch_bounds__(256, 2) fwd_kernel(Params P) {
    extern __shared__ __attribute__((aligned(16))) unsigned char smem[];
#if N_LAUNCH_MODE == 1
    cg::grid_group grid = cg::this_grid();
#define SEAM(k) do { if (P.ph_lo <= (k) && (k) + 1 < P.ph_hi) grid.sync(); } while (0)
#elif N_LAUNCH_MODE == 2
    volatile LAS unsigned* bst = (volatile LAS unsigned*)(smem + LDS_MISC + 2048);
    if (threadIdx.x < 4) bst[threadIdx.x] = 0u;
    __syncthreads();
    const XcdBarrier xbar = xcd_barrier_post((unsigned*)(P.ws + WS_BAR), bst);
#define SEAM(k) do { if (P.ph_lo <= (k) && (k) + 1 < P.ph_hi) xcd_barrier(xbar); } while (0)
#else
#define SEAM(k) do { } while (0)
#endif
#define IN(k) (P.ph_lo <= (k) && (k) < P.ph_hi)
    if (IN(0)) { phase0(P, smem); }  SEAM(0);
    if (IN(1)) { phase1(P); }        SEAM(1);
    if (IN(2)) { phase2(P, smem); }  SEAM(2);
    if (IN(3)) { phase3(P, smem); }  SEAM(3);
    if (IN(4)) { phase4(P, smem); }  SEAM(4);
    if (IN(5)) { phase5a(P, smem); } SEAM(5);
    if (IN(6)) { phase5b(P, smem); } SEAM(6);
    if (IN(7)) { phase6(P); }
#undef IN
#undef SEAM
}

extern "C" void kernel_launch(void* const* d_in, const int* in_sizes, int n_in, void* d_out, int out_size, void* d_ws, size_t ws_size, hipStream_t stream) {
    static int grid_blocks = 0;
    if (!grid_blocks) {
        if (ws_size < WS_END) { fprintf(stderr, "kernel_launch: workspace too small (%zu < %zu)\n", ws_size, (size_t)WS_END); grid_blocks = -1; return; }
        int dev = 0, cus = 0, per_cu = 0;
        hipGetDevice(&dev);
        hipDeviceGetAttribute(&cus, hipDeviceAttributeMultiprocessorCount, dev);
        hipFuncSetAttribute((const void*)fwd_kernel, hipFuncAttributeMaxDynamicSharedMemorySize, LDS_BYTES);
        hipOccupancyMaxActiveBlocksPerMultiprocessor(&per_cu, (const void*)fwd_kernel, 256, LDS_BYTES);
        if (per_cu > 2) per_cu = 2;
        if (per_cu < 1) per_cu = 1;
        grid_blocks = cus * per_cu;
        fprintf(stderr, "kernel_launch: %d CUs x %d blocks\n", cus, per_cu);
    }
    if (grid_blocks < 0) return;
    Params p{};
    const float** pp = (const float**)&p;
    for (int i = 0; i < 19; ++i) pp[i] = (const float*)d_in[i];
    p.out = (float*)d_out; p.ws = (unsigned char*)d_ws;
#if N_LAUNCH_MODE == 2
    p.ph_lo = 0; p.ph_hi = NPHASE;
    if (hipMemsetAsync(d_ws, 0, CTL_ZERO_BYTES, stream) != hipSuccess) { fprintf(stderr, "kernel_launch: memset failed\n"); return; }
    hipLaunchKernelGGL(fwd_kernel, dim3(grid_blocks), dim3(256), LDS_BYTES, stream, p);
#elif N_LAUNCH_MODE == 1
    p.ph_lo = 0; p.ph_hi = NPHASE;
    void* args[] = {&p};
    hipError_t e = hipLaunchCooperativeKernel((const void*)fwd_kernel, dim3(grid_blocks), dim3(256), args, LDS_BYTES, stream);
    if (e != hipSuccess) fprintf(stderr, "cooperative launch failed: %s (grid %d)\n", hipGetErrorString(e), grid_blocks);
#else
    for (int ph = 0; ph < NPHASE; ++ph) {
        p.ph_lo = ph; p.ph_hi = ph + 1;
        if (REPEAT_MASK & (1 << ph)) { p.flags = 1; hipLaunchKernelGGL(fwd_kernel, dim3(grid_blocks), dim3(256), LDS_BYTES, stream, p); }
        p.flags = 0;
        hipLaunchKernelGGL(fwd_kernel, dim3(grid_blocks), dim3(256), LDS_BYTES, stream, p);
    }
#endif
}
```

```cpp
#include <hip/hip_runtime.h>
#include <hip/hip_cooperative_groups.h>
#include <stdint.h>
#include <stdio.h>
namespace cg = cooperative_groups;

#ifndef NAIVE_ATTN
#define NAIVE_ATTN 0
#endif
#ifndef REPEAT_MASK
#define REPEAT_MASK 0
#endif
#ifndef N_LAUNCH_MODE
#define N_LAUNCH_MODE 2
#endif

#define DEVINL __device__ __forceinline__

typedef unsigned short bf16_t;
typedef short bf16x8 __attribute__((ext_vector_type(8)));
typedef float f32x4 __attribute__((ext_vector_type(4)));
typedef unsigned u32x4 __attribute__((ext_vector_type(4)));
typedef unsigned u32x2 __attribute__((ext_vector_type(2)));

constexpr int SEQ = 8192, DM = 1024, NT = 2 * SEQ;
constexpr int QKVW = 2304;
constexpr float EPS = 1e-6f;
constexpr float LOG2E = 1.4426950408889634f;
constexpr float QSCALE = 0.125f * LOG2E;

constexpr size_t MiB = 1u << 20;
constexpr size_t WS_CNT  = 0;
constexpr size_t WS_MOD  = 1 * MiB;
constexpr size_t WS_ROPE = 2 * MiB;
constexpr size_t WS_WQF  = 4 * MiB;
constexpr size_t WS_WOF  = 9 * MiB;
constexpr size_t WS_WRF  = 1 * MiB + 512 * 1024;
constexpr size_t WS_WGUF = 11 * MiB;
constexpr size_t WS_WDF  = 43 * MiB;
constexpr size_t WS_H    = 59 * MiB;
constexpr size_t WS_NAQ  = 91 * MiB;
constexpr size_t WS_NAK  = 107 * MiB;
constexpr size_t WS_NAV  = 123 * MiB;
constexpr size_t WS_SWQ  = 139 * MiB;
constexpr size_t WS_SWK  = 155 * MiB;
constexpr size_t WS_SWV  = 159 * MiB;
constexpr size_t WS_ATT  = 163 * MiB;
constexpr size_t WS_SSQ  = 195 * MiB;
constexpr size_t WS_LTOK = 196 * MiB;
constexpr size_t WS_LW   = 198 * MiB;
constexpr size_t WS_Y    = 91 * MiB;
constexpr size_t WS_END  = 220 * MiB;

constexpr int LDS_MISC = 73728;
constexpr int LDS_BYTES = LDS_MISC + 4096;

struct Params {
    const float *x, *c, *w_ada, *b_ada, *g_pre_mix, *w_in, *na_rpb, *swa_sinks, *beta_na, *beta_swa, *w_out, *g_post_mix, *g_pre_ffn,
                *w_gr, *w_er, *w_gate, *w_up, *w_down, *g_post_ffn;
    float* out; unsigned char* ws; int ph_lo, ph_hi, flags, pad;
};

DEVINL unsigned f2bf(float f) { unsigned u = __float_as_uint(f); return (u + 0x7fffu + ((u >> 16) & 1u)) >> 16; }
DEVINL unsigned pk2(float lo, float hi) { return f2bf(lo) | (f2bf(hi) << 16); }
DEVINL float bf2f(bf16_t v) { return __uint_as_float(((unsigned)v) << 16); }
DEVINL float bflo(unsigned u) { return __uint_as_float(u << 16); }
DEVINL float bfhi(unsigned u) { return __uint_as_float(u & 0xffff0000u); }
DEVINL float wave_sum(float v) {
#pragma unroll
    for (int o = 32; o >= 1; o >>= 1) v += __shfl_xor(v, o);
    return v;
}
DEVINL float silu_f(float v) { return v / (1.f + expf(-v)); }

DEVINL void mod_item(const Params& P, int item, unsigned char* smem) {
    float* s_silu = (float*)smem;
    float* s_red  = s_silu + 2048;
    const int t = threadIdx.x;
    for (int i = t; i < 2048; i += 256) s_silu[i] = silu_f(P.c[i]);
    __syncthreads();
    const int c4 = t & 7, rg = t >> 3, col = item * 32 + c4 * 4;
    f32x4 a0 = {0.f, 0.f, 0.f, 0.f}, a1 = {0.f, 0.f, 0.f, 0.f};
#pragma unroll 4
    for (int i = 0; i < 32; ++i) {
        const int k = rg + 32 * i;
        const f32x4 w = *(const f32x4*)(P.w_ada + (size_t)k * 6144 + col);
        a0 += w * s_silu[k]; a1 += w * s_silu[1024 + k];
    }
    *(f32x4*)(s_red + (rg * 2 + 0) * 32 + c4 * 4) = a0;
    *(f32x4*)(s_red + (rg * 2 + 1) * 32 + c4 * 4) = a1;
    __syncthreads();
    if (t < 64) {
        const int b = t >> 5, cc = t & 31; float s = 0.f;
        for (int r = 0; r < 32; ++r) s += s_red[(r * 2 + b) * 32 + cc];
        ((float*)(P.ws + WS_MOD))[b * 6144 + item * 32 + cc] = s + P.b_ada[item * 32 + cc];
    }
    __syncthreads();
}
DEVINL void frag_item(const float* src, int N, int kb, int nb, bf16_t* dst, int NTT, int mode, const float* kscale, unsigned char* smem) {
    float* scr = (float*)smem;
    const int t = threadIdx.x, k0 = kb * 64, n0 = nb * 64;
#pragma unroll
    for (int p = 0; p < 4; ++p) {
        const int r = (t >> 4) + 16 * p;
        f32x4 v = *(const f32x4*)(src + (size_t)(k0 + r) * N + n0 + (t & 15) * 4);
        const float sc = kscale ? kscale[r] : 1.f;
        float* d = scr + r * 65 + (t & 15) * 4;
        d[0] = v.x * sc; d[1] = v.y * sc; d[2] = v.z * sc; d[3] = v.w * sc;
    }
    __syncthreads();
    const int lane = t & 63, lr = lane & 15, g = lane >> 4;
#pragma unroll
    for (int i = 0; i < 2; ++i) {
        const int combo = (t >> 6) + 4 * i, ksl = combo >> 2, ntl = combo & 3;
        const float* sp = scr + (32 * ksl + 8 * g) * 65 + 16 * ntl + lr;
        u32x4 o; o.x = pk2(sp[0], sp[65]); o.y = pk2(sp[2 * 65], sp[3 * 65]); o.z = pk2(sp[4 * 65], sp[5 * 65]); o.w = pk2(sp[6 * 65], sp[7 * 65]);
        const int n16 = nb * 4 + ntl, nt = mode == 0 ? n16 : (mode == 1 ? 2 * n16 : 2 * n16 + 1);
        *(u32x4*)(dst + ((size_t)((kb * 2 + ksl) * NTT + nt) * 64 + lane) * 8) = o;
    }
    __syncthreads();
}
DEVINL void router_frags(const Params& P) {
    bf16_t* dst = (bf16_t*)(P.ws + WS_WRF);
    for (int i = blockIdx.x * 256 + threadIdx.x; i < 4 * 8 * 3 * 64; i += gridDim.x * 256) {
        const int lane = i & 63, ot = (i >> 6) % 3, wp = (i >> 6) / 3, p = wp & 7, w = wp >> 3, lr = lane & 15, g = lane >> 4;
        const int o = 16 * ot + lr;
        unsigned hi[8], lo[8];
#pragma unroll
        for (int j = 0; j < 8; ++j) {
            const int n = 256 * w + 32 * p + (j < 4 ? 4 * g + j : 16 + 4 * g + (j - 4));
            float v = 0.f;
            if (o < 4) v = P.w_gr[n * 4 + o]; else if (o < 36) v = P.w_er[((size_t)((o - 4) >> 3) * 1024 + n) * 8 + ((o - 4) & 7)];
            const unsigned h = f2bf(v); hi[j] = h; lo[j] = f2bf(v - __uint_as_float(h << 16));
        }
        u32x4 a, b;
        a.x = hi[0] | (hi[1] << 16); a.y = hi[2] | (hi[3] << 16); a.z = hi[4] | (hi[5] << 16); a.w = hi[6] | (hi[7] << 16);
        b.x = lo[0] | (lo[1] << 16); b.y = lo[2] | (lo[3] << 16); b.z = lo[4] | (lo[5] << 16); b.w = lo[6] | (lo[7] << 16);
        *(u32x4*)(dst + (size_t)i * 8) = a;
        *(u32x4*)(dst + (size_t)(4 * 8 * 3 * 64 + i) * 8) = b;
    }
}
DEVINL void phase0(const Params& P, unsigned char* smem) {
    const int t = threadIdx.x;
    if (blockIdx.x == 0 && t < 64) ((unsigned*)(P.ws + WS_CNT))[t] = 0u;
    {
        float* rc = (float*)(P.ws + WS_ROPE); float* rs = rc + SEQ * 32;
        for (int i = blockIdx.x * 256 + t; i < SEQ * 32; i += gridDim.x * 256) {
            const int pos = i >> 5, fi = i & 31;
            const float ex = -((float)fi * 2.0f) / 64.0f;
            const float inv = exp2f(ex * 13.287712379549449f);
            const float ang = (float)pos * inv;
            double tt = (double)ang * 0.15915494309189535; tt -= floor(tt);
            const float fr = (float)tt;
            rc[i] = __builtin_amdgcn_cosf(fr); rs[i] = __builtin_amdgcn_sinf(fr);
        }
    }
    router_frags(P);
    bf16_t* WqF = (bf16_t*)(P.ws + WS_WQF); bf16_t* WoF = (bf16_t*)(P.ws + WS_WOF);
    bf16_t* WguF = (bf16_t*)(P.ws + WS_WGUF); bf16_t* WdF = (bf16_t*)(P.ws + WS_WDF);
    constexpr int NMOD = 192, NI_IN = 16 * 36, NI_OUT = 256, NI_E = 2048;
    constexpr int total = NMOD + NI_IN + NI_OUT + 3 * NI_E;
    for (int it = blockIdx.x; it < total; it += gridDim.x) {
        int r = it;
        if (r < NMOD) { mod_item(P, r, smem); continue; } r -= NMOD;
        if (r < NI_IN) { const int kb = r / 36, nb = r % 36; frag_item(P.w_in, QKVW, kb, nb, WqF, 144, 0, nullptr, smem); continue; } r -= NI_IN;
        if (r < NI_OUT) { const int kb = r >> 4, nb = r & 15; const int k0 = kb * 64;
            const float* ks = (k0 < 512) ? (P.beta_na + k0) : (P.beta_swa + (k0 - 512));
            frag_item(P.w_out, 1024, kb, nb, WoF, 64, 0, ks, smem); continue; } r -= NI_OUT;
        if (r < NI_E) { const int e = r >> 6, q = r & 63, kb = q >> 2, nb = q & 3;
            frag_item(P.w_gate + (size_t)e * 1024 * 256, 256, kb, nb, WguF + (size_t)e * 512 * 1024, 32, 1, nullptr, smem); continue; } r -= NI_E;
        if (r < NI_E) { const int e = r >> 6, q = r & 63, kb = q >> 2, nb = q & 3;
            frag_item(P.w_up + (size_t)e * 1024 * 256, 256, kb, nb, WguF + (size_t)e * 512 * 1024, 32, 2, nullptr, smem); continue; } r -= NI_E;
        { const int e = r >> 6, q = r & 63, kb = q >> 4, nb = q & 15;
            frag_item(P.w_down + (size_t)e * 256 * 1024, 1024, kb, nb, WdF + (size_t)e * 1024 * 256, 64, 0, nullptr, smem); }
    }
}

DEVINL void phase2(const Params& P, unsigned char* smem) {
    const int t = threadIdx.x, lane = t & 63, wv = __builtin_amdgcn_readfirstlane(t >> 6), lr = lane & 15, g = lane >> 4;
    const float* mod = (const float*)(P.ws + WS_MOD);
    const float* rc = (const float*)(P.ws + WS_ROPE); const float* rs = rc + SEQ * 32;
    for (int tile = blockIdx.x; tile < NT / 32; tile += gridDim.x) {
        const int m0 = tile * 32;
        __syncthreads();
        {
            const float* mb = mod + (m0 >> 13) * 6144;
            f32x4 mul[4], sh[4];
#pragma unroll
            for (int j = 0; j < 4; ++j) { const int col = 4 * lane + 256 * j;
                mul[j] = *(const f32x4*)(P.g_pre_mix + col) * (*(const f32x4*)(mb + 1024 + col) + 1.f); sh[j] = *(const f32x4*)(mb + col); }
#pragma unroll 2
            for (int rr = 0; rr < 8; ++rr) {
                const int row = 8 * wv + rr;
                const f32x4* xr = (const f32x4*)(P.x + (size_t)(m0 + row) * DM) + lane;
                f32x4 v[4]; float ss = 0.f;
#pragma unroll
                for (int j = 0; j < 4; ++j) { v[j] = xr[64 * j]; ss += v[j].x * v[j].x + v[j].y * v[j].y + v[j].z * v[j].z + v[j].w * v[j].w; }
                ss = wave_sum(ss);
                const float rstd = rsqrtf(ss * (1.f / DM) + EPS);
#pragma unroll
                for (int j = 0; j < 4; ++j) {
                    const f32x4 h = v[j] * rstd * mul[j] + sh[j];
                    u32x2 o; o.x = pk2(h.x, h.y); o.y = pk2(h.z, h.w);
                    const int c = (lane >> 1) + 32 * j;
                    *(u32x2*)(smem + row * 2048 + ((c ^ (row & 15)) << 4) + (lane & 1) * 8) = o;
                }
            }
        }
        __syncthreads();
#pragma unroll 1
        for (int pass = 0; pass < 3; ++pass) {
            f32x4 acc[12][2];
#pragma unroll
            for (int i = 0; i < 12; ++i) { acc[i][0] = (f32x4){0.f, 0.f, 0.f, 0.f}; acc[i][1] = (f32x4){0.f, 0.f, 0.f, 0.f}; }
            {
                const unsigned char* wb = (const unsigned char*)(P.ws + WS_WQF) + (size_t)(36 * wv + 12 * pass) * 1024;
                unsigned voff = (unsigned)(lane * 16);
                asm volatile("" : "+v"(voff));
                bf16x8 b0[6], b1[6];
#define LOADB(dst, ks_, j0_) do { const unsigned char* ub_ = wb + (size_t)((ks_) * 144 + (j0_)) * 1024; \
        _Pragma("unroll") for (int j_ = 0; j_ < 6; ++j_) dst[j_] = *(const bf16x8*)(ub_ + j_ * 1024 + voff); } while (0)
#define MMA(src, j0_) do { _Pragma("unroll") for (int j_ = 0; j_ < 6; ++j_) { acc[(j0_) + j_][0] = __builtin_amdgcn_mfma_f32_16x16x32_bf16(src[j_], fa0, acc[(j0_) + j_][0], 0, 0, 0); \
                                                                               acc[(j0_) + j_][1] = __builtin_amdgcn_mfma_f32_16x16x32_bf16(src[j_], fa1, acc[(j0_) + j_][1], 0, 0, 0); } } while (0)
                LOADB(b0, 0, 0);
#pragma unroll 1
                for (int ks = 0; ks < 32; ++ks) {
                    LOADB(b1, ks, 6);
                    const bf16x8 fa0 = *(const bf16x8*)(smem + lr * 2048 + (((4 * ks + g) ^ lr) << 4));
                    const bf16x8 fa1 = *(const bf16x8*)(smem + (16 + lr) * 2048 + (((4 * ks + g) ^ lr) << 4));
                    MMA(b0, 0);
                    if (ks + 1 < 32) LOADB(b0, ks + 1, 0);
                    MMA(b1, 6);
                }
#undef LOADB
#undef MMA
            }
#pragma unroll
            for (int hh = 0; hh < 3; ++hh) {
                const int slot = 9 * wv + 3 * pass + hh;
                int region, hd;
                if (slot < 8) { region = 0; hd = slot; } else if (slot < 16) { region = 1; hd = slot - 8; } else if (slot < 24) { region = 2; hd = slot - 16; }
                else if (slot < 32) { region = 3; hd = slot - 24; } else if (slot < 34) { region = 4; hd = slot - 32; } else { region = 5; hd = slot - 34; }
                const size_t off = region == 0 ? WS_NAQ : region == 1 ? WS_NAK : region == 2 ? WS_NAV : region == 3 ? WS_SWQ : region == 4 ? WS_SWK : WS_SWV;
                const int nh = (region >= 4) ? 2 : 8;
#pragma unroll
                for (int mi = 0; mi < 2; ++mi) {
                    const int m = m0 + 16 * mi + lr, b = m >> 13, sq = m & (SEQ - 1);
                    f32x4 v[4];
#pragma unroll
                    for (int ni = 0; ni < 4; ++ni) v[ni] = acc[4 * hh + ni][mi];
                    if (region == 3 || region == 4) {
#pragma unroll
                        for (int ni = 0; ni < 2; ++ni) {
                            const f32x4 cs = *(const f32x4*)(rc + sq * 32 + 16 * ni + 4 * g), sn = *(const f32x4*)(rs + sq * 32 + 16 * ni + 4 * g);
                            const f32x4 x1 = v[ni], x2 = v[ni + 2];
                            v[ni] = x1 * cs - x2 * sn; v[ni + 2] = x2 * cs + x1 * sn;
                        }
                    }
                    if (region == 0 || region == 3) {
#pragma unroll
                        for (int ni = 0; ni < 4; ++ni) v[ni] = v[ni] * QSCALE;
                    }
                    bf16_t* base = (bf16_t*)(P.ws + off) + ((size_t)(b * nh + hd) * SEQ + sq) * 64;
#pragma unroll
                    for (int ni = 0; ni < 4; ++ni) { u32x2 o; o.x = pk2(v[ni].x, v[ni].y); o.y = pk2(v[ni].z, v[ni].w); *(u32x2*)(base + 16 * ni + 4 * g) = o; }
                }
            }
        }
    }
}

#if NAIVE_ATTN
DEVINL void phase3(const Params& P, unsigned char* smem) {
    const int lane = threadIdx.x & 63, gw = blockIdx.x * 4 + (threadIdx.x >> 6), ngw = gridDim.x * 4;
    bf16_t* ATT = (bf16_t*)(P.ws + WS_ATT); float* SSQ = (float*)(P.ws + WS_SSQ);
    for (int it = gw; it < NT * 16; it += ngw) {
        const int isw = it >= NT * 8; const int r = isw ? it - NT * 8 : it;
        const int tok = r >> 3, h = r & 7, b = tok >> 13, s = tok & (SEQ - 1);
        float m = -3.0e38f, sum = 0.f, o = 0.f;
        if (!isw) {
            const bf16_t* Q = (const bf16_t*)(P.ws + WS_NAQ) + ((size_t)(b * 8 + h) * SEQ) * 64;
            const bf16_t* K = (const bf16_t*)(P.ws + WS_NAK) + ((size_t)(b * 8 + h) * SEQ) * 64;
            const bf16_t* VT = (const bf16_t*)(P.ws + WS_NAV) + ((size_t)(b * 8 + h) * SEQ) * 64;
            const float q = bf2f(Q[(size_t)s * 64 + lane]);
            const int row = s >> 6, col = s & 63;
            int r0 = row - 4; r0 = r0 < 0 ? 0 : (r0 > 120 ? 120 : r0);
            int cs = col - 8; cs = cs < 0 ? 0 : (cs > 48 ? 48 : cs);
            const float* rpb = P.na_rpb + h * 15 * 31;
            for (int pass = 0; pass < 2; ++pass)
                for (int i = 0; i < 8; ++i)
                    for (int j = 0; j < 16; ++j) {
                        const int key = (r0 + i) * 64 + cs + j;
                        float d = wave_sum(q * bf2f(K[(size_t)key * 64 + lane]));
                        d += rpb[(r0 + i - row + 7) * 31 + (cs + j - col + 15)] * LOG2E;
                        if (pass == 0) m = fmaxf(m, d);
                        else { const float p = exp2f(d - m); sum += p; o += p * bf2f(VT[(size_t)key * 64 + lane]); }
                    }
        } else {
            const int kvh = h >> 2;
            const bf16_t* Q = (const bf16_t*)(P.ws + WS_SWQ) + ((size_t)(b * 8 + h) * SEQ) * 64;
            const bf16_t* K = (const bf16_t*)(P.ws + WS_SWK) + ((size_t)(b * 2 + kvh) * SEQ) * 64;
            const bf16_t* VT = (const bf16_t*)(P.ws + WS_SWV) + ((size_t)(b * 2 + kvh) * SEQ) * 64;
            const float q = bf2f(Q[(size_t)s * 64 + lane]);
            const int klo = s - 128 < 0 ? 0 : s - 128, khi = s + 128 > SEQ - 1 ? SEQ - 1 : s + 128;
            const float sk = P.swa_sinks[h] * LOG2E;
            m = sk;
            for (int pass = 0; pass < 2; ++pass)
                for (int key = klo; key <= khi; ++key) {
                    const float d = wave_sum(q * bf2f(K[(size_t)key * 64 + lane]));
                    if (pass == 0) m = fmaxf(m, d);
                    else { const float p = exp2f(d - m); sum += p; o += p * bf2f(VT[(size_t)key * 64 + lane]); }
                }
            sum += exp2f(sk - m);
        }
        o /= sum;
        ATT[(size_t)tok * DM + (isw ? 512 : 0) + h * 64 + lane] = (bf16_t)f2bf(o);
        const float sq = wave_sum(o * o);
        if (lane == 0) SSQ[tok * 16 + (isw ? 8 : 0) + h] = sq;
    }
}
#else
typedef short s16x4 __attribute__((ext_vector_type(4)));
#define LAS3 __attribute__((address_space(3)))
DEVINL int k_off(int row, int c) { return row * 128 + ((c ^ ((row >> 1) & 7)) << 4); }
DEVINL int v_off(int row, int c) { return row * 128 + ((((c >> 1) ^ ((row >> 1) & 3)) << 5) | ((c & 1) << 4)); }
DEVINL bf16x8 tr_pair(const LAS3 unsigned char* p0, const LAS3 unsigned char* p1) {
    const s16x4 a = __builtin_amdgcn_ds_read_tr16_b64_v4i16((LAS3 s16x4*)p0), b = __builtin_amdgcn_ds_read_tr16_b64_v4i16((LAS3 s16x4*)p1);
    bf16x8 r; r[0] = a[0]; r[1] = a[1]; r[2] = a[2]; r[3] = a[3]; r[4] = b[0]; r[5] = b[1]; r[6] = b[2]; r[7] = b[3]; return r;
}
DEVINL void phase3(const Params& P, unsigned char* smem) {
    const int t = threadIdx.x, lane = t & 63, w = t >> 6, lr = lane & 15, g = lane >> 4;
    bf16_t* ATT = (bf16_t*)(P.ws + WS_ATT); float* SSQ = (float*)(P.ws + WS_SSQ);
    const LAS3 unsigned char* lsm = (const LAS3 unsigned char*)smem;
    constexpr int N_NA = 2 * 8 * 128, N_SW = 2 * 2 * 512;
    for (int it = blockIdx.x; it < N_NA + N_SW; it += gridDim.x) {
        if (it < N_NA) {
            const int r = it & 127, h = (it >> 7) & 7, b = it >> 10;
            const int c0 = 16 * w;
            int r0 = r - 4; r0 = r0 < 0 ? 0 : (r0 > 120 ? 120 : r0);
            int kc0 = c0 - 8; kc0 = kc0 < 0 ? 0 : (kc0 > 32 ? 32 : kc0);
            const bf16_t* Q = (const bf16_t*)(P.ws + WS_NAQ) + ((size_t)(b * 8 + h) * SEQ) * 64;
            const bf16_t* Kg = (const bf16_t*)(P.ws + WS_NAK) + ((size_t)(b * 8 + h) * SEQ + r0 * 64) * 64;
            const bf16_t* Vg = (const bf16_t*)(P.ws + WS_NAV) + ((size_t)(b * 8 + h) * SEQ + r0 * 64) * 64;
            __syncthreads();
            {
                u32x4 kr[16];
#pragma unroll
                for (int i = 0; i < 16; ++i) kr[i] = *(const u32x4*)(Kg + (size_t)(t + 256 * i) * 8);
#pragma unroll
                for (int i = 0; i < 16; ++i) { const int q = t + 256 * i; *(u32x4*)(smem + k_off(q >> 3, q & 7)) = kr[i]; }
            }
            const bf16_t* qp = Q + (size_t)(r * 64 + c0 + lr) * 64 + 8 * g;
            const bf16x8 q0 = *(const bf16x8*)qp, q1 = *(const bf16x8*)(qp + 32);
            __syncthreads();
            u32x4 vr[8];
#pragma unroll
            for (int i = 0; i < 8; ++i) vr[i] = *(const u32x4*)(Vg + (size_t)(t + 256 * i) * 8);
            f32x4 sc[16];
#pragma unroll
            for (int tt = 0; tt < 16; ++tt) {
                const int row = (tt >> 1) * 64 + kc0 + (tt & 1) * 16 + lr;
                const bf16x8 k0 = *(const bf16x8*)(smem + k_off(row, g)), k1 = *(const bf16x8*)(smem + k_off(row, 4 + g));
                f32x4 a = {0.f, 0.f, 0.f, 0.f};
                a = __builtin_amdgcn_mfma_f32_16x16x32_bf16(k0, q0, a, 0, 0, 0);
                a = __builtin_amdgcn_mfma_f32_16x16x32_bf16(k1, q1, a, 0, 0, 0);
                sc[tt] = a;
            }
            const int c = c0 + lr; int cs = c - 8; cs = cs < 0 ? 0 : (cs > 48 ? 48 : cs);
            const float* rp = P.na_rpb + h * 465;
            float mx = -3.0e38f;
#pragma unroll
            for (int tt = 0; tt < 16; ++tt) {
                const int dr = r0 + (tt >> 1) - r + 7;
#pragma unroll
                for (int e = 0; e < 4; ++e) {
                    const int kc = kc0 + (tt & 1) * 16 + 4 * g + e;
                    const bool ok = (kc >= cs) && (kc < cs + 16);
                    int dc = kc - c + 15; dc = dc < 0 ? 0 : (dc > 30 ? 30 : dc);
                    const float v = ok ? sc[tt][e] + rp[dr * 31 + dc] * LOG2E : -3.0e38f;
                    sc[tt][e] = v; mx = fmaxf(mx, v);
                }
            }
            mx = fmaxf(mx, __shfl_xor(mx, 16)); mx = fmaxf(mx, __shfl_xor(mx, 32));
            float sum = 0.f;
            bf16x8 pf[8];
#pragma unroll
            for (int kk = 0; kk < 8; ++kk) {
                float p[8];
#pragma unroll
                for (int e = 0; e < 4; ++e) { p[e] = __builtin_amdgcn_exp2f(sc[2 * kk][e] - mx); p[4 + e] = __builtin_amdgcn_exp2f(sc[2 * kk + 1][e] - mx); }
                sum += ((p[0] + p[1]) + (p[2] + p[3])) + ((p[4] + p[5]) + (p[6] + p[7]));
                union { bf16x8 v; unsigned u[4]; } pk; pk.u[0] = pk2(p[0], p[1]); pk.u[1] = pk2(p[2], p[3]); pk.u[2] = pk2(p[4], p[5]); pk.u[3] = pk2(p[6], p[7]);
                pf[kk] = pk.v;
            }
            sum += __shfl_xor(sum, 16); sum += __shfl_xor(sum, 32);
            __syncthreads();
#pragma unroll
            for (int i = 0; i < 8; ++i) { const int q = t + 256 * i; *(u32x4*)(smem + v_off(q >> 3, q & 7)) = vr[i]; }
#pragma unroll
            for (int i = 0; i < 8; ++i) vr[i] = *(const u32x4*)(Vg + (size_t)(2048 + t + 256 * i) * 8);
            __syncthreads();
            f32x4 o[4];
#pragma unroll
            for (int dt = 0; dt < 4; ++dt) o[dt] = (f32x4){0.f, 0.f, 0.f, 0.f};
            const int vrow = kc0 + 4 * g + (lr >> 2), vsw = (vrow >> 1) & 3, vbase = vrow * 128 + (lr & 3) * 8;
#pragma unroll
            for (int kk = 0; kk < 4; ++kk)
#pragma unroll
                for (int dt = 0; dt < 4; ++dt) {
                    const LAS3 unsigned char* ap = lsm + vbase + ((dt ^ vsw) << 5) + kk * 8192;
                    o[dt] = __builtin_amdgcn_mfma_f32_16x16x32_bf16(tr_pair(ap, ap + 2048), pf[kk], o[dt], 0, 0, 0);
                }
#pragma unroll
            for (int i = 0; i < 8; ++i) { const int q = t + 256 * i; *(u32x4*)(smem + 32768 + v_off(q >> 3, q & 7)) = vr[i]; }
            __syncthreads();
#pragma unroll
            for (int kk = 0; kk < 4; ++kk)
#pragma unroll
                for (int dt = 0; dt < 4; ++dt) {
                    const LAS3 unsigned char* ap = lsm + 32768 + vbase + ((dt ^ vsw) << 5) + kk * 8192;
                    o[dt] = __builtin_amdgcn_mfma_f32_16x16x32_bf16(tr_pair(ap, ap + 2048), pf[4 + kk], o[dt], 0, 0, 0);
                }
            const float inv = 1.f / sum; float sq = 0.f;
            const int tok = b * SEQ + r * 64 + c0 + lr;
#pragma unroll
            for (int dt = 0; dt < 4; ++dt) {
                const f32x4 v = o[dt] * inv; sq += v.x * v.x + v.y * v.y + v.z * v.z + v.w * v.w;
                u32x2 ov; ov.x = pk2(v.x, v.y); ov.y = pk2(v.z, v.w);
                *(u32x2*)(ATT + (size_t)tok * DM + h * 64 + 16 * dt + 4 * g) = ov;
            }
            sq += __shfl_xor(sq, 16); sq += __shfl_xor(sq, 32);
            if (g == 0) SSQ[tok * 16 + h] = sq;
        } else {
            const int r = it - N_NA, qt = r & 511, kvh = (r >> 9) & 1, b = r >> 10;
            const int hq = kvh * 4 + w, q0p = qt * 16, kb = q0p - 128;
            const bf16_t* Q = (const bf16_t*)(P.ws + WS_SWQ) + ((size_t)(b * 8 + hq) * SEQ) * 64;
            const bf16_t* Kg = (const bf16_t*)(P.ws + WS_SWK) + ((size_t)(b * 2 + kvh) * SEQ) * 64;
            const bf16_t* Vg = (const bf16_t*)(P.ws + WS_SWV) + ((size_t)(b * 2 + kvh) * SEQ) * 64;
            __syncthreads();
            {
                u32x4 kr[9], vr[9];
#pragma unroll
                for (int i = 0; i < 9; ++i) { const int q = t + 256 * i; int tokk = kb + (q >> 3); tokk = tokk < 0 ? 0 : (tokk > SEQ - 1 ? SEQ - 1 : tokk);
                    kr[i] = *(const u32x4*)(Kg + (size_t)tokk * 64 + (q & 7) * 8); vr[i] = *(const u32x4*)(Vg + (size_t)tokk * 64 + (q & 7) * 8); }
#pragma unroll
                for (int i = 0; i < 9; ++i) { const int q = t + 256 * i; *(u32x4*)(smem + k_off(q >> 3, q & 7)) = kr[i]; *(u32x4*)(smem + 36864 + v_off(q >> 3, q & 7)) = vr[i]; }
            }
            const bf16_t* qp = Q + (size_t)(q0p + lr) * 64 + 8 * g;
            const bf16x8 q0 = *(const bf16x8*)qp, q1 = *(const bf16x8*)(qp + 32);
            const float sk = P.swa_sinks[hq] * LOG2E;
            __syncthreads();
            f32x4 sc[18];
            float mx = sk;
#pragma unroll
            for (int tt = 0; tt < 18; ++tt) {
                const int kt0 = kb + 16 * tt;
                f32x4 a = {0.f, 0.f, 0.f, 0.f};
                const bool tile_ok = (tt < 17) && (kt0 >= 0) && (kt0 < SEQ);
                if (tt < 17) {
                    const int row = 16 * tt + lr;
                    const bf16x8 k0 = *(const bf16x8*)(smem + k_off(row, g)), k1 = *(const bf16x8*)(smem + k_off(row, 4 + g));
                    a = __builtin_amdgcn_mfma_f32_16x16x32_bf16(k0, q0, a, 0, 0, 0);
                    a = __builtin_amdgcn_mfma_f32_16x16x32_bf16(k1, q1, a, 0, 0, 0);
                }
#pragma unroll
                for (int e = 0; e < 4; ++e) {
                    const int dlt = 16 * tt + 4 * g + e - lr;
                    const bool ok = tile_ok && dlt >= 0 && dlt <= 256;
                    const float v = ok ? a[e] : -3.0e38f;
                    a[e] = v; mx = fmaxf(mx, v);
                }
                sc[tt] = a;
            }
            mx = fmaxf(mx, __shfl_xor(mx, 16)); mx = fmaxf(mx, __shfl_xor(mx, 32));
            float sum = 0.f;
            bf16x8 pf[9];
#pragma unroll
            for (int kk = 0; kk < 9; ++kk) {
                float p[8];
#pragma unroll
                for (int e = 0; e < 4; ++e) { p[e] = __builtin_amdgcn_exp2f(sc[2 * kk][e] - mx); p[4 + e] = __builtin_amdgcn_exp2f(sc[2 * kk + 1][e] - mx); }
                sum += ((p[0] + p[1]) + (p[2] + p[3])) + ((p[4] + p[5]) + (p[6] + p[7]));
                union { bf16x8 v; unsigned u[4]; } pk; pk.u[0] = pk2(p[0], p[1]); pk.u[1] = pk2(p[2], p[3]); pk.u[2] = pk2(p[4], p[5]); pk.u[3] = pk2(p[6], p[7]);
                pf[kk] = pk.v;
            }
            sum += __shfl_xor(sum, 16); sum += __shfl_xor(sum, 32);
            sum += __builtin_amdgcn_exp2f(sk - mx);
            f32x4 o[4];
#pragma unroll
            for (int dt = 0; dt < 4; ++dt) o[dt] = (f32x4){0.f, 0.f, 0.f, 0.f};
            const int vrow = 4 * g + (lr >> 2), vsw = (vrow >> 1) & 3, vbase = 36864 + vrow * 128 + (lr & 3) * 8;
#pragma unroll
            for (int kk = 0; kk < 9; ++kk)
#pragma unroll
                for (int dt = 0; dt < 4; ++dt) {
                    const LAS3 unsigned char* ap = lsm + vbase + ((dt ^ vsw) << 5) + kk * 4096;
                    o[dt] = __builtin_amdgcn_mfma_f32_16x16x32_bf16(tr_pair(ap, ap + 2048), pf[kk], o[dt], 0, 0, 0);
                }
            const float inv = 1.f / sum; float sq = 0.f;
            const int tok = b * SEQ + q0p + lr;
#pragma unroll
            for (int dt = 0; dt < 4; ++dt) {
                const f32x4 v = o[dt] * inv; sq += v.x * v.x + v.y * v.y + v.z * v.z + v.w * v.w;
                u32x2 ov; ov.x = pk2(v.x, v.y); ov.y = pk2(v.z, v.w);
                *(u32x2*)(ATT + (size_t)tok * DM + 512 + hq * 64 + 16 * dt + 4 * g) = ov;
            }
            sq += __shfl_xor(sq, 16); sq += __shfl_xor(sq, 32);
            if (g == 0) SSQ[tok * 16 + 8 + hq] = sq;
        }
    }
}
#endif

DEVINL void phase4(const Params& P, unsigned char* smem) {
    const int t = threadIdx.x, lane = t & 63, w = t >> 6, lr = lane & 15, g = lane >> 4;
    const bf16_t* ATT = (const bf16_t*)(P.ws + WS_ATT); const float* SSQ = (const float*)(P.ws + WS_SSQ);
    const bf16_t* WoF = (const bf16_t*)(P.ws + WS_WOF); const bf16_t* WrF = (const bf16_t*)(P.ws + WS_WRF);
    const float* mod = (const float*)(P.ws + WS_MOD);
    bf16_t* H2 = (bf16_t*)(P.ws + WS_H);
    unsigned* cnt = (unsigned*)(P.ws + WS_CNT); int* ltok = (int*)(P.ws + WS_LTOK); float* lw = (float*)(P.ws + WS_LW);
    float* s_part = (float*)smem;
    float* s_lg = (float*)(smem + 1024);
    for (int tile = blockIdx.x; tile < NT / 32; tile += gridDim.x) {
        const int m0 = tile * 32;
        __syncthreads();
        {
            const int row = t >> 3;
            const float* sp = SSQ + (size_t)(m0 + row) * 16;
            const f32x4 a = *(const f32x4*)sp, b2 = *(const f32x4*)(sp + 4), c2 = *(const f32x4*)(sp + 8), d2 = *(const f32x4*)(sp + 12);
            const float rna = rsqrtf((a.x + a.y + a.z + a.w + b2.x + b2.y + b2.z + b2.w) * (1.f / 512.f) + EPS);
            const float rsw = rsqrtf((c2.x + c2.y + c2.z + c2.w + d2.x + d2.y + d2.z + d2.w) * (1.f / 512.f) + EPS);
            const bf16_t* src = ATT + (size_t)(m0 + row) * DM;
#pragma unroll 4
            for (int i = 0; i < 16; ++i) {
                const int c = (t & 7) + 8 * i;
                u32x4 v = *(const u32x4*)(src + c * 8);
                const float sc = (c < 64) ? rna : rsw;
                v.x = pk2(bflo(v.x) * sc, bfhi(v.x) * sc); v.y = pk2(bflo(v.y) * sc, bfhi(v.y) * sc);
                v.z = pk2(bflo(v.z) * sc, bfhi(v.z) * sc); v.w = pk2(bflo(v.w) * sc, bfhi(v.w) * sc);
                *(u32x4*)(smem + row * 2048 + ((c ^ (row & 15)) << 4)) = v;
            }
        }
        __syncthreads();
        f32x4 acc[16][2];
#ifndef P4_KREP
#define P4_KREP 1
#endif
#pragma unroll 1
        for (int krep = 0; krep < P4_KREP; ++krep) {
#pragma unroll
        for (int i = 0; i < 16; ++i) { acc[i][0] = (f32x4){0.f, 0.f, 0.f, 0.f}; acc[i][1] = (f32x4){0.f, 0.f, 0.f, 0.f}; }
        {
            const unsigned char* wb = (const unsigned char*)WoF;
            unsigned voff = (unsigned)((16 * w * 64 + lane) * 16);
            asm volatile("" : "+v"(voff));
            bf16x8 b0[8], b1[8];
#define LOADB(dst, ks_, nt0_) do { const unsigned char* ub_ = wb + (size_t)((ks_) * 64 + (nt0_)) * 1024; \
        _Pragma("unroll") for (int j_ = 0; j_ < 8; ++j_) dst[j_] = *(const bf16x8*)(ub_ + j_ * 1024 + voff); } while (0)
#define MMA(src, nt0_) do { _Pragma("unroll") for (int j_ = 0; j_ < 8; ++j_) { acc[(nt0_) + j_][0] = __builtin_amdgcn_mfma_f32_16x16x32_bf16(src[j_], fa0, acc[(nt0_) + j_][0], 0, 0, 0); \
                                                                                acc[(nt0_) + j_][1] = __builtin_amdgcn_mfma_f32_16x16x32_bf16(src[j_], fa1, acc[(nt0_) + j_][1], 0, 0, 0); } } while (0)
            LOADB(b0, 0, 0);
#pragma unroll 1
            for (int ks = 0; ks < 32; ++ks) {
                LOADB(b1, ks, 8);
                const bf16x8 fa0 = *(const bf16x8*)(smem + lr * 2048 + (((4 * ks + g) ^ lr) << 4));
                const bf16x8 fa1 = *(const bf16x8*)(smem + (16 + lr) * 2048 + (((4 * ks + g) ^ lr) << 4));
                MMA(b0, 0);
                if (ks + 1 < 32) LOADB(b0, ks + 1, 0);
                MMA(b1, 8);
            }
#undef LOADB
#undef MMA
        }
#if P4_KREP > 1
#pragma unroll
        for (int i = 0; i < 16; ++i) asm volatile("" : "+v"(acc[i][0]), "+v"(acc[i][1]));
#endif
        }
        float ss0 = 0.f, ss1 = 0.f;
#pragma unroll
        for (int nt = 0; nt < 16; ++nt) {
            const f32x4 a = acc[nt][0], b2 = acc[nt][1];
            ss0 += a.x * a.x + a.y * a.y + a.z * a.z + a.w * a.w; ss1 += b2.x * b2.x + b2.y * b2.y + b2.z * b2.z + b2.w * b2.w;
        }
        ss0 += __shfl_xor(ss0, 16); ss0 += __shfl_xor(ss0, 32); ss1 += __shfl_xor(ss1, 16); ss1 += __shfl_xor(ss1, 32);
        __syncthreads();
        if (g == 0) { s_part[w * 32 + lr] = ss0; s_part[w * 32 + 16 + lr] = ss1; }
        __syncthreads();
        const float rs0 = rsqrtf((s_part[lr] + s_part[32 + lr] + s_part[64 + lr] + s_part[96 + lr]) * (1.f / DM) + EPS);
        const float rs1 = rsqrtf((s_part[16 + lr] + s_part[48 + lr] + s_part[80 + lr] + s_part[112 + lr]) * (1.f / DM) + EPS);
        const float* mb = mod + (m0 >> 13) * 6144;
        float q0 = 0.f, q1 = 0.f;
#pragma unroll
        for (int nt = 0; nt < 16; ++nt) {
            const int col = 256 * w + 16 * nt + 4 * g;
            const f32x4 gp = *(const f32x4*)(P.g_post_mix + col), ga = *(const f32x4*)(mb + 2048 + col);
            const size_t o0 = (size_t)(m0 + lr) * DM + col, o1 = o0 + 16 * DM;
            const f32x4 x0 = *(const f32x4*)(P.x + o0), x1v = *(const f32x4*)(P.x + o1);
            const f32x4 r0 = x0 + ga * (acc[nt][0] * rs0 * gp), r1 = x1v + ga * (acc[nt][1] * rs1 * gp);
            *(f32x4*)(P.out + o0) = r0; *(f32x4*)(P.out + o1) = r1;
            q0 += r0.x * r0.x + r0.y * r0.y + r0.z * r0.z + r0.w * r0.w; q1 += r1.x * r1.x + r1.y * r1.y + r1.z * r1.z + r1.w * r1.w;
            if (nt & 1) asm volatile("" ::: "memory");
        }
        q0 += __shfl_xor(q0, 16); q0 += __shfl_xor(q0, 32); q1 += __shfl_xor(q1, 16); q1 += __shfl_xor(q1, 32);
        if (g == 0) { s_part[128 + w * 32 + lr] = q0; s_part[128 + w * 32 + 16 + lr] = q1; }
        __syncthreads();
        const float rt0 = rsqrtf((s_part[128 + lr] + s_part[160 + lr] + s_part[192 + lr] + s_part[224 + lr]) * (1.f / DM) + EPS);
        const float rt1 = rsqrtf((s_part[144 + lr] + s_part[176 + lr] + s_part[208 + lr] + s_part[240 + lr]) * (1.f / DM) + EPS);
        f32x4 lg[3][2];
#pragma unroll
        for (int i = 0; i < 3; ++i) { lg[i][0] = (f32x4){0.f, 0.f, 0.f, 0.f}; lg[i][1] = (f32x4){0.f, 0.f, 0.f, 0.f}; }
        const bf16_t* wr = WrF + ((size_t)(w * 8) * 3 * 64 + lane) * 8;
#pragma unroll 1
        for (int p = 0; p < 8; ++p) {
            union { bf16x8 v; unsigned u[4]; } hh[2], hl[2];
#pragma unroll
            for (int q = 0; q < 2; ++q) {
                const int nt = 2 * p + q, col = 256 * w + 16 * nt + 4 * g;
                const f32x4 gpf = *(const f32x4*)(P.g_pre_ffn + col), sc = *(const f32x4*)(mb + 4096 + col), sh = *(const f32x4*)(mb + 3072 + col);
                const f32x4 mul = gpf * (sc + 1.f);
#pragma unroll
                for (int mi = 0; mi < 2; ++mi) {
                    const f32x4 x1r = *(const f32x4*)(P.out + (size_t)(m0 + 16 * mi + lr) * DM + col);
                    const f32x4 h = x1r * (mi ? rt1 : rt0) * mul + sh;
                    const unsigned a0 = f2bf(h.x), a1 = f2bf(h.y), a2 = f2bf(h.z), a3 = f2bf(h.w);
                    const unsigned u01 = a0 | (a1 << 16), u23 = a2 | (a3 << 16);
                    u32x2 ov; ov.x = u01; ov.y = u23;
                    *(u32x2*)(H2 + (size_t)(m0 + 16 * mi + lr) * DM + col) = ov;
                    hh[mi].u[2 * q] = u01; hh[mi].u[2 * q + 1] = u23;
                    hl[mi].u[2 * q] = pk2(h.x - __uint_as_float(a0 << 16), h.y - __uint_as_float(a1 << 16));
                    hl[mi].u[2 * q + 1] = pk2(h.z - __uint_as_float(a2 << 16), h.w - __uint_as_float(a3 << 16));
                }
            }
#pragma unroll
            for (int ot = 0; ot < 3; ++ot) {
                const bf16x8 whi = *(const bf16x8*)(wr + (size_t)(p * 3 + ot) * 512);
                const bf16x8 wlo = *(const bf16x8*)(wr + (size_t)(4 * 8 * 3 * 64) * 8 + (size_t)(p * 3 + ot) * 512);
#pragma unroll
                for (int mi = 0; mi < 2; ++mi) {
                    lg[ot][mi] = __builtin_amdgcn_mfma_f32_16x16x32_bf16(whi, hh[mi].v, lg[ot][mi], 0, 0, 0);
                    lg[ot][mi] = __builtin_amdgcn_mfma_f32_16x16x32_bf16(whi, hl[mi].v, lg[ot][mi], 0, 0, 0);
                    lg[ot][mi] = __builtin_amdgcn_mfma_f32_16x16x32_bf16(wlo, hh[mi].v, lg[ot][mi], 0, 0, 0);
                }
            }
            asm volatile("" ::: "memory");
        }
#pragma unroll
        for (int ot = 0; ot < 3; ++ot)
#pragma unroll
            for (int mi = 0; mi < 2; ++mi)
#pragma unroll
                for (int e = 0; e < 4; ++e) s_lg[(w * 48 + 16 * ot + 4 * g + e) * 32 + 16 * mi + lr] = lg[ot][mi][e];
        __syncthreads();
        if (t < 32 && !(P.flags & 1)) {
            const int row = m0 + t;
#define LG(o) (s_lg[(o) * 32 + t] + s_lg[(48 + (o)) * 32 + t] + s_lg[(96 + (o)) * 32 + t] + s_lg[(144 + (o)) * 32 + t])
            const float g0 = LG(0), g1 = LG(1), g2 = LG(2), g3 = LG(3);
            int gtop = 0; float gm = g0;
            if (g1 > gm) { gm = g1; gtop = 1; } if (g2 > gm) { gm = g2; gtop = 2; } if (g3 > gm) { gm = g3; gtop = 3; }
            const float gwt = 1.f / (expf(g0 - gm) + expf(g1 - gm) + expf(g2 - gm) + expf(g3 - gm));
            int i1 = 0, i2 = 0; float v1 = -3.0e38f, v2 = -3.0e38f;
            for (int e = 0; e < 8; ++e) {
                const float v = LG(4 + gtop * 8 + e);
                if (v > v1) { v2 = v1; i2 = i1; v1 = v; i1 = e; } else if (v > v2) { v2 = v; i2 = e; }
            }
#undef LG
            const float ex = expf(v2 - v1), w1 = gwt / (1.f + ex), w2 = gwt * ex / (1.f + ex);
            const int ea1 = gtop * 8 + i1, ea2 = gtop * 8 + i2;
            const unsigned p1 = atomicAdd(&cnt[ea1], 1u); ltok[ea1 * NT + p1] = row * 2;     lw[ea1 * NT + p1] = w1;
            const unsigned p2 = atomicAdd(&cnt[ea2], 1u); ltok[ea2 * NT + p2] = row * 2 + 1; lw[ea2 * NT + p2] = w2;
        }
    }
}

DEVINL void phase5(const Params& P, unsigned char* smem) {
    const int t = threadIdx.x, lane = t & 63, wv = __builtin_amdgcn_readfirstlane(t >> 6), lr = lane & 15, g = lane >> 4;
    const bf16_t* H2 = (const bf16_t*)(P.ws + WS_H);
    const unsigned* cnt = (const unsigned*)(P.ws + WS_CNT); const int* ltok = (const int*)(P.ws + WS_LTOK); const float* lw = (const float*)(P.ws + WS_LW);
    bf16_t* Y = (bf16_t*)(P.ws + WS_Y);
    int total = 0;
    for (int e = 0; e < 32; ++e) total += ((int)cnt[e] + 31) >> 5;
    for (int it = blockIdx.x; it < total; it += gridDim.x) {
        int mt = it, e = 0;
        for (; e < 32; ++e) { const int nt_ = ((int)cnt[e] + 31) >> 5; if (mt < nt_) break; mt -= nt_; }
        const int ce = (int)cnt[e];
        __syncthreads();
        {
            const int row = t >> 3, r = mt * 32 + row;
            const int tok = (r < ce) ? (ltok[e * NT + r] >> 1) : 0;
            const bf16_t* src = H2 + (size_t)tok * DM;
#pragma unroll 4
            for (int i = 0; i < 16; ++i) { const int c = (t & 7) + 8 * i; *(u32x4*)(smem + row * 2048 + ((c ^ (row & 15)) << 4)) = *(const u32x4*)(src + c * 8); }
        }
        __syncthreads();
        unsigned voff = (unsigned)(lane * 16);
        asm volatile("" : "+v"(voff));
        {
            f32x4 acc[8][2];
#pragma unroll
            for (int i = 0; i < 8; ++i) { acc[i][0] = (f32x4){0.f, 0.f, 0.f, 0.f}; acc[i][1] = (f32x4){0.f, 0.f, 0.f, 0.f}; }
            const unsigned char* wb = (const unsigned char*)(P.ws + WS_WGUF) + (size_t)e * (32 * 32 * 1024) + (size_t)(8 * wv) * 1024;
            bf16x8 b0[8], b1[8];
#define LOADB(dst, ks_) do { const unsigned char* ub_ = wb + (size_t)((ks_) * 32) * 1024; \
        _Pragma("unroll") for (int j_ = 0; j_ < 8; ++j_) dst[j_] = *(const bf16x8*)(ub_ + j_ * 1024 + voff); } while (0)
#define MMA(src, ks_) do { const bf16x8 fa0 = *(const bf16x8*)(smem + lr * 2048 + (((4 * (ks_) + g) ^ lr) << 4)); \
        const bf16x8 fa1 = *(const bf16x8*)(smem + (16 + lr) * 2048 + (((4 * (ks_) + g) ^ lr) << 4)); \
        _Pragma("unroll") for (int j_ = 0; j_ < 8; ++j_) { acc[j_][0] = __builtin_amdgcn_mfma_f32_16x16x32_bf16(src[j_], fa0, acc[j_][0], 0, 0, 0); \
                                                          acc[j_][1] = __builtin_amdgcn_mfma_f32_16x16x32_bf16(src[j_], fa1, acc[j_][1], 0, 0, 0); } } while (0)
            LOADB(b0, 0);
#pragma unroll 1
            for (int ks = 0; ks < 32; ks += 2) {
                LOADB(b1, ks + 1);
                MMA(b0, ks);
                if (ks + 2 < 32) LOADB(b0, ks + 2);
                MMA(b1, ks + 1);
            }
#undef LOADB
#undef MMA
            __syncthreads();
#pragma unroll
            for (int p = 0; p < 4; ++p)
#pragma unroll
                for (int mi = 0; mi < 2; ++mi) {
                    const f32x4 gt = acc[2 * p][mi], up = acc[2 * p + 1][mi];
                    f32x4 hd; hd.x = gt.x / (1.f + __expf(-gt.x)) * up.x; hd.y = gt.y / (1.f + __expf(-gt.y)) * up.y; hd.z = gt.z / (1.f + __expf(-gt.z)) * up.z; hd.w = gt.w / (1.f + __expf(-gt.w)) * up.w;
                    u32x2 o; o.x = pk2(hd.x, hd.y); o.y = pk2(hd.z, hd.w);
                    const int row = 16 * mi + lr, c = 8 * wv + 2 * p + (g >> 1);
                    *(u32x2*)(smem + row * 512 + ((c ^ (row & 15)) << 4) + (g & 1) * 8) = o;
                }
        }
        __syncthreads();
        {
            f32x4 acc[16][2];
#pragma unroll
            for (int i = 0; i < 16; ++i) { acc[i][0] = (f32x4){0.f, 0.f, 0.f, 0.f}; acc[i][1] = (f32x4){0.f, 0.f, 0.f, 0.f}; }
            const unsigned char* wb = (const unsigned char*)(P.ws + WS_WDF) + (size_t)e * (8 * 64 * 1024) + (size_t)(16 * wv) * 1024;
            bf16x8 b0[8], b1[8];
#define LOADB(dst, ks_, j0_) do { const unsigned char* ub_ = wb + (size_t)((ks_) * 64 + (j0_)) * 1024; \
        _Pragma("unroll") for (int j_ = 0; j_ < 8; ++j_) dst[j_] = *(const bf16x8*)(ub_ + j_ * 1024 + voff); } while (0)
#define MMA(src, j0_) do { _Pragma("unroll") for (int j_ = 0; j_ < 8; ++j_) { acc[(j0_) + j_][0] = __builtin_amdgcn_mfma_f32_16x16x32_bf16(src[j_], fa0, acc[(j0_) + j_][0], 0, 0, 0); \
                                                                               acc[(j0_) + j_][1] = __builtin_amdgcn_mfma_f32_16x16x32_bf16(src[j_], fa1, acc[(j0_) + j_][1], 0, 0, 0); } } while (0)
            LOADB(b0, 0, 0);
#pragma unroll 1
            for (int ks = 0; ks < 8; ++ks) {
                LOADB(b1, ks, 8);
                const bf16x8 fa0 = *(const bf16x8*)(smem + lr * 512 + (((4 * ks + g) ^ lr) << 4));
                const bf16x8 fa1 = *(const bf16x8*)(smem + (16 + lr) * 512 + (((4 * ks + g) ^ lr) << 4));
                MMA(b0, 0);
                if (ks + 1 < 8) LOADB(b0, ks + 1, 0);
                MMA(b1, 8);
            }
#undef LOADB
#undef MMA
#pragma unroll
            for (int mi = 0; mi < 2; ++mi) {
                const int r = mt * 32 + 16 * mi + lr;
                if (r < ce) {
                    const int ent = ltok[e * NT + r]; const float wt = lw[e * NT + r];
                    bf16_t* yp = Y + ((size_t)(ent & 1) * NT + (ent >> 1)) * DM + 256 * wv + 4 * g;
#pragma unroll
                    for (int nt = 0; nt < 16; ++nt) { const f32x4 v = acc[nt][mi] * wt; u32x2 o; o.x = pk2(v.x, v.y); o.y = pk2(v.z, v.w); *(u32x2*)(yp + 16 * nt) = o; }
                }
            }
        }
    }
}

DEVINL void phase6(const Params& P) {
    const int lane = threadIdx.x & 63, gw = blockIdx.x * 4 + (threadIdx.x >> 6), ngw = gridDim.x * 4;
    const float* mod = (const float*)(P.ws + WS_MOD);
    const bf16_t* Y = (const bf16_t*)(P.ws + WS_Y);
    for (int row = gw; row < NT; row += ngw) {
        const float* mb = mod + (row >> 13) * 6144;
        f32x4 y[4]; float ss = 0.f;
#pragma unroll
        for (int j = 0; j < 4; ++j) {
            const int col = 4 * lane + 256 * j;
            const u32x2 a = *(const u32x2*)(Y + (size_t)row * DM + col), b = *(const u32x2*)(Y + ((size_t)NT + row) * DM + col);
            y[j] = (f32x4){bflo(a.x) + bflo(b.x), bfhi(a.x) + bfhi(b.x), bflo(a.y) + bflo(b.y), bfhi(a.y) + bfhi(b.y)};
            ss += y[j].x * y[j].x + y[j].y * y[j].y + y[j].z * y[j].z + y[j].w * y[j].w;
        }
        ss = wave_sum(ss);
        const float rstd = rsqrtf(ss * (1.f / DM) + EPS);
#pragma unroll
        for (int j = 0; j < 4; ++j) {
            const int col = 4 * lane + 256 * j;
            const f32x4 x1 = *(const f32x4*)(P.out + (size_t)row * DM + col), gp = *(const f32x4*)(P.g_post_ffn + col), gf = *(const f32x4*)(mb + 5120 + col);
            float* dst = (P.flags & 1) ? (float*)(P.ws + 155 * MiB) : P.out;
            *(f32x4*)(dst + (size_t)row * DM + col) = x1 + gf * (y[j] * rstd * gp);
        }
    }
}


#define LAS __attribute__((address_space(3)))
#define XB_TMO      128
#define XB_XCNT(j)  (256  + 64 * (j))
#define XB_XSUB(j)  (1280 + 64 * (j))
#define XB_XGEN(j)  (2304 + 64 * (j))
#define XB_TOP      3328
#define XB_TOPGEN   3392
#define XCD_BAR_WORDS 3456
#define XB_SPIN_CAP (1u << 18)
DEVINL unsigned xb_ld(unsigned* p)              { return __hip_atomic_load(p, __ATOMIC_RELAXED, __HIP_MEMORY_SCOPE_AGENT); }
DEVINL unsigned xb_add(unsigned* p, unsigned v) { return __hip_atomic_fetch_add(p, v, __ATOMIC_RELAXED, __HIP_MEMORY_SCOPE_AGENT); }
DEVINL unsigned xb_xcc_id() { return (unsigned)__builtin_amdgcn_s_getreg((3 << 11) | 20) & 0xFu; }
#define XB_SPIN(cond, bar) do { unsigned _sp = 0; while (cond) { __builtin_amdgcn_s_sleep(1); \
    if ((++_sp & 255u) == 0u) { if (xb_ld(&(bar)[XB_TMO])) break; if (_sp > XB_SPIN_CAP) { atomicAdd(&(bar)[XB_TMO], 1u); break; } } } } while (0)
struct XcdBarrier { unsigned* bar; unsigned x; volatile LAS unsigned* st; };
DEVINL XcdBarrier xcd_barrier_post(unsigned* bar, volatile LAS unsigned* st) {
    XcdBarrier b; b.bar = bar; b.x = xb_xcc_id(); b.st = st;
    if (threadIdx.x == 0) (void)xb_add(&bar[XB_XCNT(b.x)], 1u);
    return b;
}
DEVINL void xcd_barrier_complete(unsigned* bar, unsigned x, unsigned& nloc, unsigned& nx) {
    const unsigned G = gridDim.x * gridDim.y * gridDim.z;
    unsigned sum, cnt, mine, sp = 0u;
    for (;;) {
        sum = 0u; cnt = 0u; mine = 0u;
#pragma unroll
        for (unsigned j = 0; j < 16; ++j) { const unsigned c = xb_ld(&bar[XB_XCNT(j)]); sum += c; cnt += (c > 0u) ? 1u : 0u; mine = (j == x) ? c : mine; }
        if (sum == G) break;
        __builtin_amdgcn_s_sleep(1);
        if ((++sp & 255u) == 0u) { if (xb_ld(&bar[XB_TMO])) break; if (sp > XB_SPIN_CAP) { atomicAdd(&bar[XB_TMO], 1u); break; } }
    }
    nloc = mine > 0u ? mine : 1u; nx = cnt > 0u ? cnt : 1u;
}
DEVINL void xcd_barrier(const XcdBarrier& b) {
    asm volatile("s_waitcnt vmcnt(0)" ::: "memory");
    __syncthreads();
    if (threadIdx.x == 0) {
        unsigned* bar = b.bar;
        __builtin_amdgcn_s_waitcnt(0);
        unsigned nloc = b.st[0], nx = b.st[1];
        if (nloc == 0u) { xcd_barrier_complete(bar, b.x, nloc, nx); b.st[0] = nloc; b.st[1] = nx; }
        const unsigned old = xb_add(&bar[XB_XSUB(b.x)], 1u);
        const unsigned gen = old / nloc;
        if (old + 1u == (gen + 1u) * nloc) {
            __builtin_amdgcn_fence(__ATOMIC_RELEASE, "agent");
            asm volatile("s_waitcnt vmcnt(0)" ::: "memory");
            const unsigned og = xb_add(&bar[XB_TOP], 1u);
            const unsigned tg = og / nx;
            if (og + 1u == (tg + 1u) * nx) xb_add(&bar[XB_TOPGEN], 1u);
            else XB_SPIN(xb_ld(&bar[XB_TOPGEN]) == tg, bar);
            __builtin_amdgcn_fence(__ATOMIC_ACQUIRE, "agent");
            xb_add(&bar[XB_XGEN(b.x)], 1u);
            asm volatile("s_waitcnt vmcnt(0)" ::: "memory");
        } else {
            XB_SPIN(xb_ld(&bar[XB_XGEN(b.x)]) == gen, bar);
            __builtin_amdgcn_fence(__ATOMIC_ACQUIRE, "agent");
            asm volatile("s_waitcnt vmcnt(0)" ::: "memory");
        }
    }
    __syncthreads();
}
constexpr size_t WS_BAR = 16384;
constexpr size_t CTL_ZERO_BYTES = 65536;

constexpr int NPHASE = 6;
__global__ void __launch_bounds__(256, 2) fwd_kernel(Params P) {
    extern __shared__ __attribute__((aligned(16))) unsigned char smem[];
#if N_LAUNCH_MODE == 1
    cg::grid_group grid = cg::this_grid();
#define SEAM(k) do { if (P.ph_lo <= (k) && (k) + 1 < P.ph_hi) grid.sync(); } while (0)
#elif N_LAUNCH_MODE == 2
    volatile LAS unsigned* bst = (volatile LAS unsigned*)(smem + LDS_MISC + 2048);
    if (threadIdx.x < 4) bst[threadIdx.x] = 0u;
    __syncthreads();
    const XcdBarrier xbar = xcd_barrier_post((unsigned*)(P.ws + WS_BAR), bst);
#define SEAM(k) do { if (P.ph_lo <= (k) && (k) + 1 < P.ph_hi) xcd_barrier(xbar); } while (0)
#else
#define SEAM(k) do { } while (0)
#endif
#define IN(k) (P.ph_lo <= (k) && (k) < P.ph_hi)
    if (IN(0)) { phase0(P, smem); }  SEAM(0);
    if (IN(1)) { phase2(P, smem); }  SEAM(1);
    if (IN(2)) { phase3(P, smem); }  SEAM(2);
    if (IN(3)) { phase4(P, smem); }  SEAM(3);
    if (IN(4)) { phase5(P, smem); }  SEAM(4);
    if (IN(5)) { phase6(P); }
#undef IN
#undef SEAM
}

extern "C" void kernel_launch(void* const* d_in, const int* in_sizes, int n_in, void* d_out, int out_size, void* d_ws, size_t ws_size, hipStream_t stream) {
    static int grid_blocks = 0;
    if (!grid_blocks) {
        if (ws_size < WS_END) { fprintf(stderr, "kernel_launch: workspace too small (%zu < %zu)\n", ws_size, (size_t)WS_END); grid_blocks = -1; return; }
        int dev = 0, cus = 0, per_cu = 0;
        hipGetDevice(&dev);
        hipDeviceGetAttribute(&cus, hipDeviceAttributeMultiprocessorCount, dev);
        hipFuncSetAttribute((const void*)fwd_kernel, hipFuncAttributeMaxDynamicSharedMemorySize, LDS_BYTES);
        hipOccupancyMaxActiveBlocksPerMultiprocessor(&per_cu, (const void*)fwd_kernel, 256, LDS_BYTES);
        if (per_cu > 2) per_cu = 2;
        if (per_cu < 1) per_cu = 1;
        grid_blocks = cus * per_cu;
        fprintf(stderr, "kernel_launch: %d CUs x %d blocks\n", cus, per_cu);
    }
    if (grid_blocks < 0) return;
    Params p{};
    const float** pp = (const float**)&p;
    for (int i = 0; i < 19; ++i) pp[i] = (const float*)d_in[i];
    p.out = (float*)d_out; p.ws = (unsigned char*)d_ws;
#if N_LAUNCH_MODE == 2
    p.ph_lo = 0; p.ph_hi = NPHASE;
    if (hipMemsetAsync(d_ws, 0, CTL_ZERO_BYTES, stream) != hipSuccess) { fprintf(stderr, "kernel_launch: memset failed\n"); return; }
    hipLaunchKernelGGL(fwd_kernel, dim3(grid_blocks), dim3(256), LDS_BYTES, stream, p);
#elif N_LAUNCH_MODE == 1
    p.ph_lo = 0; p.ph_hi = NPHASE;
    void* args[] = {&p};
    hipError_t e = hipLaunchCooperativeKernel((const void*)fwd_kernel, dim3(grid_blocks), dim3(256), args, LDS_BYTES, stream);
    if (e != hipSuccess) fprintf(stderr, "cooperative launch failed: %s (grid %d)\n", hipGetErrorString(e), grid_blocks);
#else
    for (int ph = 0; ph < NPHASE; ++ph) {
        p.ph_lo = ph; p.ph_hi = ph + 1;
        if (REPEAT_MASK & (1 << ph)) { p.flags = 1; hipLaunchKernelGGL(fwd_kernel, dim3(grid_blocks), dim3(256), LDS_BYTES, stream, p); }
        p.flags = 0;
        hipLaunchKernelGGL(fwd_kernel, dim3(grid_blocks), dim3(256), LDS_BYTES, stream, p);
    }
#endif
}
```

```cpp
#include <hip/hip_runtime.h>
#include <hip/hip_cooperative_groups.h>
#include <stdint.h>
#include <stdio.h>
namespace cg = cooperative_groups;

#ifndef NAIVE_ATTN
#define NAIVE_ATTN 0
#endif
#ifndef REPEAT_MASK
#define REPEAT_MASK 0
#endif
#ifndef P2_RS
#define P2_RS 1
#endif
#ifndef P2_RK
#define P2_RK 1
#endif
#ifndef P2_RE
#define P2_RE 1
#endif
#ifndef P3_RNA
#define P3_RNA 1
#endif
#ifndef P3_RSW
#define P3_RSW 1
#endif
#ifndef P5_RG
#define P5_RG 1
#endif
#ifndef P5_RK1
#define P5_RK1 1
#endif
#ifndef P5_RK2
#define P5_RK2 1
#endif
#ifndef P5_RE2
#define P5_RE2 1
#endif
#define REP(n) _Pragma("unroll 1") for (int rep_ = 0; rep_ < (n); ++rep_)
#ifndef N_LAUNCH_MODE
#define N_LAUNCH_MODE 2
#endif

#define DEVINL __device__ __forceinline__

typedef unsigned short bf16_t;
typedef short bf16x8 __attribute__((ext_vector_type(8)));
typedef float f32x4 __attribute__((ext_vector_type(4)));
typedef unsigned u32x4 __attribute__((ext_vector_type(4)));
typedef unsigned u32x2 __attribute__((ext_vector_type(2)));

constexpr int SEQ = 8192, DM = 1024, NT = 2 * SEQ;
constexpr int QKVW = 2304;
constexpr float EPS = 1e-6f;
constexpr float LOG2E = 1.4426950408889634f;
constexpr float QSCALE = 0.125f * LOG2E;

constexpr size_t MiB = 1u << 20;
constexpr size_t WS_CNT  = 0;
constexpr size_t WS_MOD  = 1 * MiB;
constexpr size_t WS_ROPE = 2 * MiB;
constexpr size_t WS_WQF  = 4 * MiB;
constexpr size_t WS_WOF  = 9 * MiB;
constexpr size_t WS_WRF  = 1 * MiB + 512 * 1024;
constexpr size_t WS_WGUF = 11 * MiB;
constexpr size_t WS_WDF  = 43 * MiB;
constexpr size_t WS_H    = 59 * MiB;
constexpr size_t WS_NAQ  = 91 * MiB;
constexpr size_t WS_NAK  = 107 * MiB;
constexpr size_t WS_NAV  = 123 * MiB;
constexpr size_t WS_SWQ  = 139 * MiB;
constexpr size_t WS_SWK  = 155 * MiB;
constexpr size_t WS_SWV  = 159 * MiB;
constexpr size_t WS_ATT  = 163 * MiB;
constexpr size_t WS_SSQ  = 195 * MiB;
constexpr size_t WS_LTOK = 196 * MiB;
constexpr size_t WS_LW   = 198 * MiB;
constexpr size_t WS_Y    = 91 * MiB;
constexpr size_t WS_END  = 220 * MiB;

constexpr int NTHR = 512;
constexpr int LDS_HALF = 73728;
constexpr int LDS_MISC = 147456;
constexpr int LDS_BYTES = LDS_MISC + 4096;

struct Params {
    const float *x, *c, *w_ada, *b_ada, *g_pre_mix, *w_in, *na_rpb, *swa_sinks, *beta_na, *beta_swa, *w_out, *g_post_mix, *g_pre_ffn,
                *w_gr, *w_er, *w_gate, *w_up, *w_down, *g_post_ffn;
    float* out; unsigned char* ws; int ph_lo, ph_hi, flags, pad;
};

DEVINL unsigned f2bf(float f) { unsigned u = __float_as_uint(f); return (u + 0x7fffu + ((u >> 16) & 1u)) >> 16; }
typedef __bf16 bf16v2 __attribute__((ext_vector_type(2)));
typedef float f32x2 __attribute__((ext_vector_type(2)));
DEVINL unsigned pk2(float lo, float hi) { const f32x2 v = {lo, hi}; return __builtin_bit_cast(unsigned, __builtin_convertvector(v, bf16v2)); }
DEVINL void store_pair16(bf16_t* rowbase, u32x2 a, u32x2 b, int fa, int fb, int g, bool pred) {
    const auto rx = __builtin_amdgcn_permlane16_swap(a.x, b.x, false, false);
    const auto ry = __builtin_amdgcn_permlane16_swap(a.y, b.y, false, false);
    u32x4 o; o.x = rx[0]; o.y = ry[0]; o.z = rx[1]; o.w = ry[1];
    if (pred) *(u32x4*)(rowbase + 16 * ((g & 1) ? fb : fa) + 8 * (g >> 1)) = o;
}
DEVINL float bf2f(bf16_t v) { return __uint_as_float(((unsigned)v) << 16); }
DEVINL float bflo(unsigned u) { return __uint_as_float(u << 16); }
DEVINL float bfhi(unsigned u) { return __uint_as_float(u & 0xffff0000u); }
DEVINL float wave_sum(float v) {
#pragma unroll
    for (int o = 32; o >= 1; o >>= 1) v += __shfl_xor(v, o);
    return v;
}
DEVINL float silu_f(float v) { return v / (1.f + expf(-v)); }

DEVINL void mod_item(const Params& P, int item, unsigned char* smem, const int t) {
    float* s_silu = (float*)smem;
    float* s_red  = s_silu + 2048;
    for (int i = t; i < 2048; i += 256) s_silu[i] = silu_f(P.c[i]);
    __syncthreads();
    const int c4 = t & 7, rg = t >> 3, col = item * 32 + c4 * 4;
    f32x4 a0 = {0.f, 0.f, 0.f, 0.f}, a1 = {0.f, 0.f, 0.f, 0.f};
#pragma unroll 4
    for (int i = 0; i < 32; ++i) {
        const int k = rg + 32 * i;
        const f32x4 w = *(const f32x4*)(P.w_ada + (size_t)k * 6144 + col);
        a0 += w * s_silu[k]; a1 += w * s_silu[1024 + k];
    }
    *(f32x4*)(s_red + (rg * 2 + 0) * 32 + c4 * 4) = a0;
    *(f32x4*)(s_red + (rg * 2 + 1) * 32 + c4 * 4) = a1;
    __syncthreads();
    if (t < 64) {
        const int b = t >> 5, cc = t & 31; float s = 0.f;
        for (int r = 0; r < 32; ++r) s += s_red[(r * 2 + b) * 32 + cc];
        ((float*)(P.ws + WS_MOD))[b * 6144 + item * 32 + cc] = s + P.b_ada[item * 32 + cc];
    }
    __syncthreads();
}
DEVINL void frag_item(const float* src, int N, int kb, int nb, bf16_t* dst, int NTT, int mode, const float* kscale, unsigned char* smem, const int t) {
    float* scr = (float*)smem;
    const int k0 = kb * 64, n0 = nb * 64;
#pragma unroll
    for (int p = 0; p < 4; ++p) {
        const int r = (t >> 4) + 16 * p;
        f32x4 v = *(const f32x4*)(src + (size_t)(k0 + r) * N + n0 + (t & 15) * 4);
        const float sc = kscale ? kscale[r] : 1.f;
        float* d = scr + r * 65 + (t & 15) * 4;
        d[0] = v.x * sc; d[1] = v.y * sc; d[2] = v.z * sc; d[3] = v.w * sc;
    }
    __syncthreads();
    const int lane = t & 63, lr = lane & 15, g = lane >> 4;
#pragma unroll
    for (int i = 0; i < 2; ++i) {
        const int combo = (t >> 6) + 4 * i, ksl = combo >> 2, ntl = combo & 3;
        const float* sp = scr + (32 * ksl + 8 * g) * 65 + 16 * ntl + lr;
        u32x4 o; o.x = pk2(sp[0], sp[65]); o.y = pk2(sp[2 * 65], sp[3 * 65]); o.z = pk2(sp[4 * 65], sp[5 * 65]); o.w = pk2(sp[6 * 65], sp[7 * 65]);
        const int n16 = nb * 4 + ntl, nt = mode == 0 ? n16 : (mode == 1 ? 2 * n16 : 2 * n16 + 1);
        *(u32x4*)(dst + ((size_t)((kb * 2 + ksl) * NTT + nt) * 64 + lane) * 8) = o;
    }
    __syncthreads();
}
DEVINL void router_frags(const Params& P) {
    bf16_t* dst = (bf16_t*)(P.ws + WS_WRF);
    for (int i = blockIdx.x * NTHR + threadIdx.x; i < 4 * 8 * 3 * 64; i += gridDim.x * NTHR) {
        const int lane = i & 63, ot = (i >> 6) % 3, wp = (i >> 6) / 3, p = wp & 7, w = wp >> 3, lr = lane & 15, g = lane >> 4;
        const int o = 16 * ot + lr;
        unsigned hi[8], lo[8];
#pragma unroll
        for (int j = 0; j < 8; ++j) {
            const int n = 256 * w + 32 * p + (j < 4 ? 4 * g + j : 16 + 4 * g + (j - 4));
            float v = 0.f;
            if (o < 4) v = P.w_gr[n * 4 + o]; else if (o < 36) v = P.w_er[((size_t)((o - 4) >> 3) * 1024 + n) * 8 + ((o - 4) & 7)];
            const unsigned h = f2bf(v); hi[j] = h; lo[j] = f2bf(v - __uint_as_float(h << 16));
        }
        u32x4 a, b;
        a.x = hi[0] | (hi[1] << 16); a.y = hi[2] | (hi[3] << 16); a.z = hi[4] | (hi[5] << 16); a.w = hi[6] | (hi[7] << 16);
        b.x = lo[0] | (lo[1] << 16); b.y = lo[2] | (lo[3] << 16); b.z = lo[4] | (lo[5] << 16); b.w = lo[6] | (lo[7] << 16);
        *(u32x4*)(dst + (size_t)i * 8) = a;
        *(u32x4*)(dst + (size_t)(4 * 8 * 3 * 64 + i) * 8) = b;
    }
}
DEVINL void phase0(const Params& P, unsigned char* smem) {
    const int t = threadIdx.x;
    if (blockIdx.x == 0 && t < 64) ((unsigned*)(P.ws + WS_CNT))[t] = 0u;
    {
        float* rc = (float*)(P.ws + WS_ROPE); float* rs = rc + SEQ * 32;
        for (int i = blockIdx.x * NTHR + t; i < SEQ * 32; i += gridDim.x * NTHR) {
            const int pos = i >> 5, fi = i & 31;
            const float ex = -((float)fi * 2.0f) / 64.0f;
            const float inv = exp2f(ex * 13.287712379549449f);
            const float ang = (float)pos * inv;
            double tt = (double)ang * 0.15915494309189535; tt -= floor(tt);
            const float fr = (float)tt;
            rc[i] = __builtin_amdgcn_cosf(fr); rs[i] = __builtin_amdgcn_sinf(fr);
        }
    }
    router_frags(P);
    bf16_t* WqF = (bf16_t*)(P.ws + WS_WQF); bf16_t* WoF = (bf16_t*)(P.ws + WS_WOF);
    bf16_t* WguF = (bf16_t*)(P.ws + WS_WGUF); bf16_t* WdF = (bf16_t*)(P.ws + WS_WDF);
    constexpr int NMOD = 192, NI_IN = 16 * 36, NI_OUT = 256, NI_E = 2048;
    constexpr int total = NMOD + NI_IN + NI_OUT + 3 * NI_E;
    const int half = t >> 8, th = t & 255; unsigned char* hsm = smem + half * LDS_HALF;
    static_assert((NMOD | NI_IN | NI_OUT | NI_E) % 2 == 0, "item pairs must be of one type (equal barrier counts in both half-blocks)");
    for (int it = 2 * blockIdx.x + half; it < total; it += 2 * gridDim.x) {
        int r = it;
        if (r < NMOD) { mod_item(P, r, hsm, th); continue; } r -= NMOD;
        if (r < NI_IN) { const int kb = r / 36, nb = r % 36; frag_item(P.w_in, QKVW, kb, nb, WqF, 144, 0, nullptr, hsm, th); continue; } r -= NI_IN;
        if (r < NI_OUT) { const int kb = r >> 4, nb = r & 15; const int k0 = kb * 64;
            const float* ks = (k0 < 512) ? (P.beta_na + k0) : (P.beta_swa + (k0 - 512));
            frag_item(P.w_out, 1024, kb, nb, WoF, 64, 0, ks, hsm, th); continue; } r -= NI_OUT;
        if (r < NI_E) { const int e = r >> 6, q = r & 63, kb = q >> 2, nb = q & 3;
            frag_item(P.w_gate + (size_t)e * 1024 * 256, 256, kb, nb, WguF + (size_t)e * 512 * 1024, 32, 1, nullptr, hsm, th); continue; } r -= NI_E;
        if (r < NI_E) { const int e = r >> 6, q = r & 63, kb = q >> 2, nb = q & 3;
            frag_item(P.w_up + (size_t)e * 1024 * 256, 256, kb, nb, WguF + (size_t)e * 512 * 1024, 32, 2, nullptr, hsm, th); continue; } r -= NI_E;
        { const int e = r >> 6, q = r & 63, kb = q >> 4, nb = q & 15;
            frag_item(P.w_down + (size_t)e * 256 * 1024, 1024, kb, nb, WdF + (size_t)e * 1024 * 256, 64, 0, nullptr, hsm, th); }
    }
}

DEVINL void qkv_store_head(const Params& P, const f32x4 (&v0)[4], int slot, int m, int g, const float* rc, const float* rs, int nfr, int fr0) {
    int region, hd;
    if (slot < 8) { region = 0; hd = slot; } else if (slot < 16) { region = 1; hd = slot - 8; } else if (slot < 24) { region = 2; hd = slot - 16; }
    else if (slot < 32) { region = 3; hd = slot - 24; } else if (slot < 34) { region = 4; hd = slot - 32; } else { region = 5; hd = slot - 34; }
    const size_t off = region == 0 ? WS_NAQ : region == 1 ? WS_NAK : region == 2 ? WS_NAV : region == 3 ? WS_SWQ : region == 4 ? WS_SWK : WS_SWV;
    const int nh = (region >= 4) ? 2 : 8, b = m >> 13, sq = m & (SEQ - 1), hp = nfr >> 1, fstep = (nfr == 4) ? 1 : 2;
    f32x4 v[4];
#pragma unroll
    for (int ni = 0; ni < 4; ++ni) v[ni] = v0[ni];
    if (region == 3 || region == 4) {
#pragma unroll
        for (int ni = 0; ni < 2; ++ni) if (ni < hp) {
            const int fr = fr0 + ni * fstep;
            const f32x4 cs = *(const f32x4*)(rc + sq * 32 + 16 * fr + 4 * g), sn = *(const f32x4*)(rs + sq * 32 + 16 * fr + 4 * g);
            const f32x4 x1 = v[ni], x2 = v[ni + hp];
            v[ni] = x1 * cs - x2 * sn; v[ni + hp] = x2 * cs + x1 * sn;
        }
    }
    if (region == 0 || region == 3) {
#pragma unroll
        for (int ni = 0; ni < 4; ++ni) v[ni] = v[ni] * QSCALE;
    }
    bf16_t* base = (bf16_t*)(P.ws + off) + ((size_t)(b * nh + hd) * SEQ + sq) * 64;
#pragma unroll
    for (int ni = 0; ni < 4; ni += 2) if (ni < nfr) {
        u32x2 a, b2; a.x = pk2(v[ni].x, v[ni].y); a.y = pk2(v[ni].z, v[ni].w); b2.x = pk2(v[ni + 1].x, v[ni + 1].y); b2.y = pk2(v[ni + 1].z, v[ni + 1].w);
        store_pair16(base, a, b2, fr0 + ni * fstep, fr0 + (ni + 1) * fstep, g, true);
    }
}
DEVINL void phase2(const Params& P, unsigned char* smem) {
    const int t = threadIdx.x, wv = __builtin_amdgcn_readfirstlane(t >> 6);
    const float* mod = (const float*)(P.ws + WS_MOD);
    const float* rc = (const float*)(P.ws + WS_ROPE); const float* rs = rc + SEQ * 32;
    for (int tile = blockIdx.x; tile < NT / 64; tile += gridDim.x) {
        const int m0 = tile * 64;
        int lane = t & 63;
        asm volatile("" : "+v"(lane));
        const int lr = lane & 15, g = lane >> 4;
        __syncthreads();
        REP(P2_RS) {
            asm volatile("" ::: "memory");
            const float* mb = mod + (m0 >> 13) * 6144;
            f32x4 mul[4], sh[4];
#pragma unroll
            for (int j = 0; j < 4; ++j) { const int col = 4 * lane + 256 * j;
                mul[j] = *(const f32x4*)(P.g_pre_mix + col) * (*(const f32x4*)(mb + 1024 + col) + 1.f); sh[j] = *(const f32x4*)(mb + col); }
#pragma unroll 4
            for (int rr = 0; rr < 8; ++rr) {
                const int row = 8 * wv + rr;
                const f32x4* xr = (const f32x4*)(P.x + (size_t)(m0 + row) * DM) + lane;
                f32x4 v[4]; float ss = 0.f;
#pragma unroll
                for (int j = 0; j < 4; ++j) { v[j] = xr[64 * j]; ss += v[j].x * v[j].x + v[j].y * v[j].y + v[j].z * v[j].z + v[j].w * v[j].w; }
                ss = wave_sum(ss);
                const float rstd = rsqrtf(ss * (1.f / DM) + EPS);
#pragma unroll
                for (int j = 0; j < 4; ++j) {
                    const f32x4 h = v[j] * rstd * mul[j] + sh[j];
                    u32x2 o; o.x = pk2(h.x, h.y); o.y = pk2(h.z, h.w);
                    const int c = (lane >> 1) + 32 * j;
                    *(u32x2*)(smem + row * 2048 + ((c ^ (row & 15)) << 4) + (lane & 1) * 8) = o;
                }
            }
        }
        __syncthreads();
        unsigned voff = (unsigned)(lane * 16);
        asm volatile("" : "+v"(voff));
        const int aoff = lr * 2048;
#define AFRAG(mi_, ks_) (*(const bf16x8*)(smem + aoff + (mi_) * 32768 + (((4 * (ks_) + g) ^ lr) << 4)))
#pragma unroll 1
        for (int pass = 0; pass < 2; ++pass) {
            f32x4 acc[8][4];
            REP(P2_RK) {
#pragma unroll
            for (int i = 0; i < 8; ++i)
#pragma unroll
                for (int mi = 0; mi < 4; ++mi) acc[i][mi] = (f32x4){0.f, 0.f, 0.f, 0.f};
            {
                const unsigned char* wb = (const unsigned char*)(P.ws + WS_WQF) + (size_t)(64 * pass + 8 * wv) * 1024;
                bf16x8 b0[8], b1[8];
#define LOADB(dst, ks_) do { const unsigned char* ub_ = wb + (size_t)((ks_) * 144) * 1024; \
        _Pragma("unroll") for (int j_ = 0; j_ < 8; ++j_) dst[j_] = *(const bf16x8*)(ub_ + j_ * 1024 + voff); } while (0)
#define MMA(src, ks_) do { const bf16x8 f0 = AFRAG(0, ks_), f1 = AFRAG(1, ks_), f2 = AFRAG(2, ks_), f3 = AFRAG(3, ks_); \
        _Pragma("unroll") for (int j_ = 0; j_ < 8; ++j_) { acc[j_][0] = __builtin_amdgcn_mfma_f32_16x16x32_bf16(src[j_], f0, acc[j_][0], 0, 0, 0); \
            acc[j_][1] = __builtin_amdgcn_mfma_f32_16x16x32_bf16(src[j_], f1, acc[j_][1], 0, 0, 0); \
            acc[j_][2] = __builtin_amdgcn_mfma_f32_16x16x32_bf16(src[j_], f2, acc[j_][2], 0, 0, 0); \
            acc[j_][3] = __builtin_amdgcn_mfma_f32_16x16x32_bf16(src[j_], f3, acc[j_][3], 0, 0, 0); } } while (0)
                LOADB(b0, 0);
#pragma unroll 1
                for (int ks = 0; ks < 32; ks += 2) {
                    LOADB(b1, ks + 1);
                    MMA(b0, ks);
                    if (ks + 2 < 32) LOADB(b0, ks + 2);
                    MMA(b1, ks + 1);
                }
#undef LOADB
#undef MMA
            }
#if P2_RK > 1
#pragma unroll
            for (int i = 0; i < 8; ++i) asm volatile("" : "+v"(acc[i][0]), "+v"(acc[i][1]), "+v"(acc[i][2]), "+v"(acc[i][3]));
#endif
            }
            REP(P2_RE) {
            int l2 = lane;
            asm volatile("" : "+v"(l2));
            const int lr2 = l2 & 15, g2 = l2 >> 4;
#pragma unroll
            for (int hh = 0; hh < 2; ++hh)
#pragma unroll
                for (int mi = 0; mi < 4; ++mi) {
                    f32x4 v[4];
#pragma unroll
                    for (int ni = 0; ni < 4; ++ni) v[ni] = acc[4 * hh + ni][mi];
                    qkv_store_head(P, v, 16 * pass + 2 * wv + hh, m0 + 16 * mi + lr2, g2, rc, rs, 4, 0);
                    asm volatile("" ::: "memory");
                }
            }
        }
        {
            f32x4 acc[2][4];
#pragma unroll
            for (int i = 0; i < 2; ++i)
#pragma unroll
                for (int mi = 0; mi < 4; ++mi) acc[i][mi] = (f32x4){0.f, 0.f, 0.f, 0.f};
            const int slot = 32 + (wv >> 1), fr0 = wv & 1;
            const unsigned char* wb = (const unsigned char*)(P.ws + WS_WQF) + (size_t)(4 * slot + fr0) * 1024;
#pragma unroll 2
            for (int ks = 0; ks < 32; ++ks) {
                const bf16x8 ba = *(const bf16x8*)(wb + (size_t)(ks * 144) * 1024 + voff), bb = *(const bf16x8*)(wb + (size_t)(ks * 144 + 2) * 1024 + voff);
#pragma unroll
                for (int mi = 0; mi < 4; ++mi) { const bf16x8 f = AFRAG(mi, ks);
                    acc[0][mi] = __builtin_amdgcn_mfma_f32_16x16x32_bf16(ba, f, acc[0][mi], 0, 0, 0); acc[1][mi] = __builtin_amdgcn_mfma_f32_16x16x32_bf16(bb, f, acc[1][mi], 0, 0, 0); }
            }
            int l2 = lane;
            asm volatile("" : "+v"(l2));
            const int lr2 = l2 & 15, g2 = l2 >> 4;
#pragma unroll
            for (int mi = 0; mi < 4; ++mi) {
                f32x4 v[4]; v[0] = acc[0][mi]; v[1] = acc[1][mi]; v[2] = v[0]; v[3] = v[1];
                qkv_store_head(P, v, slot, m0 + 16 * mi + lr2, g2, rc, rs, 2, fr0);
                asm volatile("" ::: "memory");
            }
        }
#undef AFRAG
    }
}

#if NAIVE_ATTN
DEVINL void phase3(const Params& P, unsigned char* smem) {
    const int lane = threadIdx.x & 63, gw = blockIdx.x * 8 + (threadIdx.x >> 6), ngw = gridDim.x * 8;
    bf16_t* ATT = (bf16_t*)(P.ws + WS_ATT); float* SSQ = (float*)(P.ws + WS_SSQ);
    for (int it = gw; it < NT * 16; it += ngw) {
        const int isw = it >= NT * 8; const int r = isw ? it - NT * 8 : it;
        const int tok = r >> 3, h = r & 7, b = tok >> 13, s = tok & (SEQ - 1);
        float m = -3.0e38f, sum = 0.f, o = 0.f;
        if (!isw) {
            const bf16_t* Q = (const bf16_t*)(P.ws + WS_NAQ) + ((size_t)(b * 8 + h) * SEQ) * 64;
            const bf16_t* K = (const bf16_t*)(P.ws + WS_NAK) + ((size_t)(b * 8 + h) * SEQ) * 64;
            const bf16_t* VT = (const bf16_t*)(P.ws + WS_NAV) + ((size_t)(b * 8 + h) * SEQ) * 64;
            const float q = bf2f(Q[(size_t)s * 64 + lane]);
            const int row = s >> 6, col = s & 63;
            int r0 = row - 4; r0 = r0 < 0 ? 0 : (r0 > 120 ? 120 : r0);
            int cs = col - 8; cs = cs < 0 ? 0 : (cs > 48 ? 48 : cs);
            const float* rpb = P.na_rpb + h * 15 * 31;
            for (int pass = 0; pass < 2; ++pass)
                for (int i = 0; i < 8; ++i)
                    for (int j = 0; j < 16; ++j) {
                        const int key = (r0 + i) * 64 + cs + j;
                        float d = wave_sum(q * bf2f(K[(size_t)key * 64 + lane]));
                        d += rpb[(r0 + i - row + 7) * 31 + (cs + j - col + 15)] * LOG2E;
                        if (pass == 0) m = fmaxf(m, d);
                        else { const float p = exp2f(d - m); sum += p; o += p * bf2f(VT[(size_t)key * 64 + lane]); }
                    }
        } else {
            const int kvh = h >> 2;
            const bf16_t* Q = (const bf16_t*)(P.ws + WS_SWQ) + ((size_t)(b * 8 + h) * SEQ) * 64;
            const bf16_t* K = (const bf16_t*)(P.ws + WS_SWK) + ((size_t)(b * 2 + kvh) * SEQ) * 64;
            const bf16_t* VT = (const bf16_t*)(P.ws + WS_SWV) + ((size_t)(b * 2 + kvh) * SEQ) * 64;
            const float q = bf2f(Q[(size_t)s * 64 + lane]);
            const int klo = s - 128 < 0 ? 0 : s - 128, khi = s + 128 > SEQ - 1 ? SEQ - 1 : s + 128;
            const float sk = P.swa_sinks[h] * LOG2E;
            m = sk;
            for (int pass = 0; pass < 2; ++pass)
                for (int key = klo; key <= khi; ++key) {
                    const float d = wave_sum(q * bf2f(K[(size_t)key * 64 + lane]));
                    if (pass == 0) m = fmaxf(m, d);
                    else { const float p = exp2f(d - m); sum += p; o += p * bf2f(VT[(size_t)key * 64 + lane]); }
                }
            sum += exp2f(sk - m);
        }
        o /= sum;
        ATT[(size_t)tok * DM + (isw ? 512 : 0) + h * 64 + lane] = (bf16_t)f2bf(o);
        const float sq = wave_sum(o * o);
        if (lane == 0) SSQ[tok * 16 + (isw ? 8 : 0) + h] = sq;
    }
}
#else
typedef short s16x4 __attribute__((ext_vector_type(4)));
#define LAS3 __attribute__((address_space(3)))
DEVINL int k_off(int row, int c) { return row * 128 + ((c ^ ((row >> 1) & 7)) << 4); }
DEVINL int v_off(int row, int c) { return row * 128 + ((((c >> 1) ^ ((row >> 1) & 3)) << 5) | ((c & 1) << 4)); }
DEVINL bf16x8 tr_pair(const LAS3 unsigned char* p0, const LAS3 unsigned char* p1) {
    const s16x4 a = __builtin_amdgcn_ds_read_tr16_b64_v4i16((LAS3 s16x4*)p0), b = __builtin_amdgcn_ds_read_tr16_b64_v4i16((LAS3 s16x4*)p1);
    bf16x8 r; r[0] = a[0]; r[1] = a[1]; r[2] = a[2]; r[3] = a[3]; r[4] = b[0]; r[5] = b[1]; r[6] = b[2]; r[7] = b[3]; return r;
}
DEVINL void phase3(const Params& P, unsigned char* smem_all) {
    const int half = threadIdx.x >> 8, t = threadIdx.x & 255, lane = t & 63, w = t >> 6, lr = lane & 15, g = lane >> 4;
    unsigned char* smem = smem_all + half * LDS_HALF;
    bf16_t* ATT = (bf16_t*)(P.ws + WS_ATT); float* SSQ = (float*)(P.ws + WS_SSQ);
    const LAS3 unsigned char* lsm = (const LAS3 unsigned char*)smem;
    constexpr int N_NA = 2 * 8 * 128, N_SW = 2 * 2 * 512;
    static_assert(N_NA % 2 == 0 && N_SW % 2 == 0, "item pairs must be of one type");
    for (int it = 2 * blockIdx.x + half; it < N_NA + N_SW; it += 2 * gridDim.x) {
        if (it < N_NA) REP(P3_RNA) {
            const int r = it & 127, h = (it >> 7) & 7, b = it >> 10;
            const int c0 = 16 * w;
            int r0 = r - 4; r0 = r0 < 0 ? 0 : (r0 > 120 ? 120 : r0);
            int kc0 = c0 - 8; kc0 = kc0 < 0 ? 0 : (kc0 > 32 ? 32 : kc0);
            const bf16_t* Q = (const bf16_t*)(P.ws + WS_NAQ) + ((size_t)(b * 8 + h) * SEQ) * 64;
            const bf16_t* Kg = (const bf16_t*)(P.ws + WS_NAK) + ((size_t)(b * 8 + h) * SEQ + r0 * 64) * 64;
            const bf16_t* Vg = (const bf16_t*)(P.ws + WS_NAV) + ((size_t)(b * 8 + h) * SEQ + r0 * 64) * 64;
            __syncthreads();
            float* s_rpb = (float*)(smem + 65536);
            for (int i = t; i < 465; i += 256) s_rpb[i] = P.na_rpb[h * 465 + i] * LOG2E;
            {
                u32x4 kr[16];
#pragma unroll
                for (int i = 0; i < 16; ++i) kr[i] = *(const u32x4*)(Kg + (size_t)(t + 256 * i) * 8);
#pragma unroll
                for (int i = 0; i < 16; ++i) { const int q = t + 256 * i; *(u32x4*)(smem + k_off(q >> 3, q & 7)) = kr[i]; }
            }
            const bf16_t* qp = Q + (size_t)(r * 64 + c0 + lr) * 64 + 8 * g;
            const bf16x8 q0 = *(const bf16x8*)qp, q1 = *(const bf16x8*)(qp + 32);
            __syncthreads();
            u32x4 vr[8];
#pragma unroll
            for (int i = 0; i < 8; ++i) vr[i] = *(const u32x4*)(Vg + (size_t)(t + 256 * i) * 8);
            f32x4 sc[16];
#pragma unroll
            for (int tt = 0; tt < 16; ++tt) {
                const int row = (tt >> 1) * 64 + kc0 + (tt & 1) * 16 + lr;
                const bf16x8 k0 = *(const bf16x8*)(smem + k_off(row, g)), k1 = *(const bf16x8*)(smem + k_off(row, 4 + g));
                f32x4 a = {0.f, 0.f, 0.f, 0.f};
                a = __builtin_amdgcn_mfma_f32_16x16x32_bf16(k0, q0, a, 0, 0, 0);
                a = __builtin_amdgcn_mfma_f32_16x16x32_bf16(k1, q1, a, 0, 0, 0);
                sc[tt] = a;
            }
            const int c = c0 + lr; int cs = c - 8; cs = cs < 0 ? 0 : (cs > 48 ? 48 : cs);
            const float* rp = s_rpb;
            float mx = -3.0e38f;
#pragma unroll
            for (int tt = 0; tt < 16; ++tt) {
                const int dr = r0 + (tt >> 1) - r + 7;
#pragma unroll
                for (int e = 0; e < 4; ++e) {
                    const int kc = kc0 + (tt & 1) * 16 + 4 * g + e;
                    const bool ok = (kc >= cs) && (kc < cs + 16);
                    int dc = kc - c + 15; dc = dc < 0 ? 0 : (dc > 30 ? 30 : dc);
                    const float v = ok ? sc[tt][e] + rp[dr * 31 + dc] : -3.0e38f;
                    sc[tt][e] = v; mx = fmaxf(mx, v);
                }
            }
            mx = fmaxf(mx, __shfl_xor(mx, 16)); mx = fmaxf(mx, __shfl_xor(mx, 32));
            float sum = 0.f;
            bf16x8 pf[8];
#pragma unroll
            for (int kk = 0; kk < 8; ++kk) {
                float p[8];
#pragma unroll
                for (int e = 0; e < 4; ++e) { p[e] = __builtin_amdgcn_exp2f(sc[2 * kk][e] - mx); p[4 + e] = __builtin_amdgcn_exp2f(sc[2 * kk + 1][e] - mx); }
                sum += ((p[0] + p[1]) + (p[2] + p[3])) + ((p[4] + p[5]) + (p[6] + p[7]));
                union { bf16x8 v; unsigned u[4]; } pk; pk.u[0] = pk2(p[0], p[1]); pk.u[1] = pk2(p[2], p[3]); pk.u[2] = pk2(p[4], p[5]); pk.u[3] = pk2(p[6], p[7]);
                pf[kk] = pk.v;
            }
            sum += __shfl_xor(sum, 16); sum += __shfl_xor(sum, 32);
            __syncthreads();
#pragma unroll
            for (int i = 0; i < 8; ++i) { const int q = t + 256 * i; *(u32x4*)(smem + v_off(q >> 3, q & 7)) = vr[i]; }
#pragma unroll
            for (int i = 0; i < 8; ++i) vr[i] = *(const u32x4*)(Vg + (size_t)(2048 + t + 256 * i) * 8);
            __syncthreads();
            f32x4 o[4];
#pragma unroll
            for (int dt = 0; dt < 4; ++dt) o[dt] = (f32x4){0.f, 0.f, 0.f, 0.f};
            const int vrow = kc0 + 4 * g + (lr >> 2), vsw = (vrow >> 1) & 3, vbase = vrow * 128 + (lr & 3) * 8;
#pragma unroll
            for (int kk = 0; kk < 4; ++kk)
#pragma unroll
                for (int dt = 0; dt < 4; ++dt) {
                    const LAS3 unsigned char* ap = lsm + vbase + ((dt ^ vsw) << 5) + kk * 8192;
                    o[dt] = __builtin_amdgcn_mfma_f32_16x16x32_bf16(tr_pair(ap, ap + 2048), pf[kk], o[dt], 0, 0, 0);
                }
#pragma unroll
            for (int i = 0; i < 8; ++i) { const int q = t + 256 * i; *(u32x4*)(smem + 32768 + v_off(q >> 3, q & 7)) = vr[i]; }
            __syncthreads();
#pragma unroll
            for (int kk = 0; kk < 4; ++kk)
#pragma unroll
                for (int dt = 0; dt < 4; ++dt) {
                    const LAS3 unsigned char* ap = lsm + 32768 + vbase + ((dt ^ vsw) << 5) + kk * 8192;
                    o[dt] = __builtin_amdgcn_mfma_f32_16x16x32_bf16(tr_pair(ap, ap + 2048), pf[4 + kk], o[dt], 0, 0, 0);
                }
            const float inv = 1.f / sum; float sq = 0.f;
            const int tok = b * SEQ + r * 64 + c0 + lr;
#pragma unroll
            for (int dt = 0; dt < 4; dt += 2) {
                const f32x4 v = o[dt] * inv, v2 = o[dt + 1] * inv;
                sq += (v.x * v.x + v.y * v.y + v.z * v.z + v.w * v.w) + (v2.x * v2.x + v2.y * v2.y + v2.z * v2.z + v2.w * v2.w);
                u32x2 oa, ob; oa.x = pk2(v.x, v.y); oa.y = pk2(v.z, v.w); ob.x = pk2(v2.x, v2.y); ob.y = pk2(v2.z, v2.w);
                store_pair16(ATT + (size_t)tok * DM + h * 64, oa, ob, dt, dt + 1, g, true);
            }
            sq += __shfl_xor(sq, 16); sq += __shfl_xor(sq, 32);
            if (g == 0) SSQ[tok * 16 + h] = sq;
        } else REP(P3_RSW) {
            const int r = it - N_NA, qt = r & 511, kvh = (r >> 9) & 1, b = r >> 10;
            const int hq = kvh * 4 + w, q0p = qt * 16, kb = q0p - 128;
            const bf16_t* Q = (const bf16_t*)(P.ws + WS_SWQ) + ((size_t)(b * 8 + hq) * SEQ) * 64;
            const bf16_t* Kg = (const bf16_t*)(P.ws + WS_SWK) + ((size_t)(b * 2 + kvh) * SEQ) * 64;
            const bf16_t* Vg = (const bf16_t*)(P.ws + WS_SWV) + ((size_t)(b * 2 + kvh) * SEQ) * 64;
            __syncthreads();
            {
                u32x4 kr[9], vr[9];
#pragma unroll
                for (int i = 0; i < 9; ++i) { const int q = t + 256 * i; int tokk = kb + (q >> 3); tokk = tokk < 0 ? 0 : (tokk > SEQ - 1 ? SEQ - 1 : tokk);
                    kr[i] = *(const u32x4*)(Kg + (size_t)tokk * 64 + (q & 7) * 8); vr[i] = *(const u32x4*)(Vg + (size_t)tokk * 64 + (q & 7) * 8); }
#pragma unroll
                for (int i = 0; i < 9; ++i) { const int q = t + 256 * i; *(u32x4*)(smem + k_off(q >> 3, q & 7)) = kr[i]; *(u32x4*)(smem + 36864 + v_off(q >> 3, q & 7)) = vr[i]; }
            }
            const bf16_t* qp = Q + (size_t)(q0p + lr) * 64 + 8 * g;
            const bf16x8 q0 = *(const bf16x8*)qp, q1 = *(const bf16x8*)(qp + 32);
            const float sk = P.swa_sinks[hq] * LOG2E;
            __syncthreads();
            f32x4 sc[18];
            float mx = sk;
#pragma unroll
            for (int tt = 0; tt < 18; ++tt) {
                const int kt0 = kb + 16 * tt;
                f32x4 a = {0.f, 0.f, 0.f, 0.f};
                const bool tile_ok = (tt < 17) && (kt0 >= 0) && (kt0 < SEQ);
                if (tt < 17) {
                    const int row = 16 * tt + lr;
                    const bf16x8 k0 = *(const bf16x8*)(smem + k_off(row, g)), k1 = *(const bf16x8*)(smem + k_off(row, 4 + g));
                    a = __builtin_amdgcn_mfma_f32_16x16x32_bf16(k0, q0, a, 0, 0, 0);
                    a = __builtin_amdgcn_mfma_f32_16x16x32_bf16(k1, q1, a, 0, 0, 0);
                }
#pragma unroll
                for (int e = 0; e < 4; ++e) {
                    const int dlt = 16 * tt + 4 * g + e - lr;
                    const bool ok = tile_ok && dlt >= 0 && dlt <= 256;
                    const float v = ok ? a[e] : -3.0e38f;
                    a[e] = v; mx = fmaxf(mx, v);
                }
                sc[tt] = a;
            }
            mx = fmaxf(mx, __shfl_xor(mx, 16)); mx = fmaxf(mx, __shfl_xor(mx, 32));
            float sum = 0.f;
            bf16x8 pf[9];
#pragma unroll
            for (int kk = 0; kk < 9; ++kk) {
                float p[8];
#pragma unroll
                for (int e = 0; e < 4; ++e) { p[e] = __builtin_amdgcn_exp2f(sc[2 * kk][e] - mx); p[4 + e] = __builtin_amdgcn_exp2f(sc[2 * kk + 1][e] - mx); }
                sum += ((p[0] + p[1]) + (p[2] + p[3])) + ((p[4] + p[5]) + (p[6] + p[7]));
                union { bf16x8 v; unsigned u[4]; } pk; pk.u[0] = pk2(p[0], p[1]); pk.u[1] = pk2(p[2], p[3]); pk.u[2] = pk2(p[4], p[5]); pk.u[3] = pk2(p[6], p[7]);
                pf[kk] = pk.v;
            }
            sum += __shfl_xor(sum, 16); sum += __shfl_xor(sum, 32);
            sum += __builtin_amdgcn_exp2f(sk - mx);
            f32x4 o[4];
#pragma unroll
            for (int dt = 0; dt < 4; ++dt) o[dt] = (f32x4){0.f, 0.f, 0.f, 0.f};
            const int vrow = 4 * g + (lr >> 2), vsw = (vrow >> 1) & 3, vbase = 36864 + vrow * 128 + (lr & 3) * 8;
#pragma unroll
            for (int kk = 0; kk < 9; ++kk)
#pragma unroll
                for (int dt = 0; dt < 4; ++dt) {
                    const LAS3 unsigned char* ap = lsm + vbase + ((dt ^ vsw) << 5) + kk * 4096;
                    o[dt] = __builtin_amdgcn_mfma_f32_16x16x32_bf16(tr_pair(ap, ap + 2048), pf[kk], o[dt], 0, 0, 0);
                }
            const float inv = 1.f / sum; float sq = 0.f;
            const int tok = b * SEQ + q0p + lr;
#pragma unroll
            for (int dt = 0; dt < 4; dt += 2) {
                const f32x4 v = o[dt] * inv, v2 = o[dt + 1] * inv;
                sq += (v.x * v.x + v.y * v.y + v.z * v.z + v.w * v.w) + (v2.x * v2.x + v2.y * v2.y + v2.z * v2.z + v2.w * v2.w);
                u32x2 oa, ob; oa.x = pk2(v.x, v.y); oa.y = pk2(v.z, v.w); ob.x = pk2(v2.x, v2.y); ob.y = pk2(v2.z, v2.w);
                store_pair16(ATT + (size_t)tok * DM + 512 + hq * 64, oa, ob, dt, dt + 1, g, true);
            }
            sq += __shfl_xor(sq, 16); sq += __shfl_xor(sq, 32);
            if (g == 0) SSQ[tok * 16 + 8 + hq] = sq;
        }
    }
}
#endif

DEVINL void phase4(const Params& P, unsigned char* smem) {
    const int t = threadIdx.x, lane = t & 63, wv = __builtin_amdgcn_readfirstlane(t >> 6), lr = lane & 15, g = lane >> 4;
    const bf16_t* ATT = (const bf16_t*)(P.ws + WS_ATT); const float* SSQ = (const float*)(P.ws + WS_SSQ);
    const bf16_t* WrF = (const bf16_t*)(P.ws + WS_WRF);
    const float* mod = (const float*)(P.ws + WS_MOD);
    bf16_t* H2 = (bf16_t*)(P.ws + WS_H);
    unsigned* cnt = (unsigned*)(P.ws + WS_CNT); int* ltok = (int*)(P.ws + WS_LTOK); float* lw = (float*)(P.ws + WS_LW);
    float* s_part = (float*)(smem + 131072);
    float* s_lg = (float*)smem;
    for (int tile = blockIdx.x; tile < NT / 64; tile += gridDim.x) {
        const int m0 = tile * 64;
        __syncthreads();
        {
            const int row = t >> 3;
            const float* sp = SSQ + (size_t)(m0 + row) * 16;
            const f32x4 a = *(const f32x4*)sp, b2 = *(const f32x4*)(sp + 4), c2 = *(const f32x4*)(sp + 8), d2 = *(const f32x4*)(sp + 12);
            const float rna = rsqrtf((a.x + a.y + a.z + a.w + b2.x + b2.y + b2.z + b2.w) * (1.f / 512.f) + EPS);
            const float rsw = rsqrtf((c2.x + c2.y + c2.z + c2.w + d2.x + d2.y + d2.z + d2.w) * (1.f / 512.f) + EPS);
            const bf16_t* src = ATT + (size_t)(m0 + row) * DM;
#pragma unroll 4
            for (int i = 0; i < 16; ++i) {
                const int c = (t & 7) + 8 * i;
                u32x4 v = *(const u32x4*)(src + c * 8);
                const float sc = (c < 64) ? rna : rsw;
                v.x = pk2(bflo(v.x) * sc, bfhi(v.x) * sc); v.y = pk2(bflo(v.y) * sc, bfhi(v.y) * sc);
                v.z = pk2(bflo(v.z) * sc, bfhi(v.z) * sc); v.w = pk2(bflo(v.w) * sc, bfhi(v.w) * sc);
                *(u32x4*)(smem + row * 2048 + ((c ^ (row & 15)) << 4)) = v;
            }
        }
        __syncthreads();
        f32x4 acc[8][4];
#pragma unroll
        for (int i = 0; i < 8; ++i)
#pragma unroll
            for (int mi = 0; mi < 4; ++mi) acc[i][mi] = (f32x4){0.f, 0.f, 0.f, 0.f};
        {
            const unsigned char* wb = (const unsigned char*)(P.ws + WS_WOF) + (size_t)(8 * wv) * 1024;
            unsigned voff = (unsigned)(lane * 16);
            asm volatile("" : "+v"(voff));
            const int aoff = lr * 2048;
#define AFRAG(mi_, ks_) (*(const bf16x8*)(smem + aoff + (mi_) * 32768 + (((4 * (ks_) + g) ^ lr) << 4)))
            bf16x8 b0[8], b1[8];
#define LOADB(dst, ks_) do { const unsigned char* ub_ = wb + (size_t)((ks_) * 64) * 1024; \
        _Pragma("unroll") for (int j_ = 0; j_ < 8; ++j_) dst[j_] = *(const bf16x8*)(ub_ + j_ * 1024 + voff); } while (0)
#define MMA(src, ks_) do { const bf16x8 f0 = AFRAG(0, ks_), f1 = AFRAG(1, ks_), f2 = AFRAG(2, ks_), f3 = AFRAG(3, ks_); \
        _Pragma("unroll") for (int j_ = 0; j_ < 8; ++j_) { acc[j_][0] = __builtin_amdgcn_mfma_f32_16x16x32_bf16(src[j_], f0, acc[j_][0], 0, 0, 0); \
            acc[j_][1] = __builtin_amdgcn_mfma_f32_16x16x32_bf16(src[j_], f1, acc[j_][1], 0, 0, 0); \
            acc[j_][2] = __builtin_amdgcn_mfma_f32_16x16x32_bf16(src[j_], f2, acc[j_][2], 0, 0, 0); \
            acc[j_][3] = __builtin_amdgcn_mfma_f32_16x16x32_bf16(src[j_], f3, acc[j_][3], 0, 0, 0); } } while (0)
            LOADB(b0, 0);
#pragma unroll 1
            for (int ks = 0; ks < 32; ks += 2) {
                LOADB(b1, ks + 1);
                MMA(b0, ks);
                if (ks + 2 < 32) LOADB(b0, ks + 2);
                MMA(b1, ks + 1);
            }
#undef LOADB
#undef MMA
#undef AFRAG
        }
        float ss[4];
#pragma unroll
        for (int mi = 0; mi < 4; ++mi) {
            float q = 0.f;
#pragma unroll
            for (int nt = 0; nt < 8; ++nt) { const f32x4 a = acc[nt][mi]; q += a.x * a.x + a.y * a.y + a.z * a.z + a.w * a.w; }
            q += __shfl_xor(q, 16); q += __shfl_xor(q, 32); ss[mi] = q;
        }
        if (g == 0) {
#pragma unroll
            for (int mi = 0; mi < 4; ++mi) s_part[wv * 64 + 16 * mi + lr] = ss[mi];
        }
        __syncthreads();
        float rs_[4];
#pragma unroll
        for (int mi = 0; mi < 4; ++mi) { float q = 0.f;
#pragma unroll
            for (int w2 = 0; w2 < 8; ++w2) q += s_part[w2 * 64 + 16 * mi + lr];
            rs_[mi] = rsqrtf(q * (1.f / DM) + EPS); }
        const float* mb = mod + (m0 >> 13) * 6144;
        float q1[4] = {0.f, 0.f, 0.f, 0.f};
#pragma unroll
        for (int nt = 0; nt < 8; ++nt) {
            const int col = 128 * wv + 16 * nt + 4 * g;
            const f32x4 gp = *(const f32x4*)(P.g_post_mix + col), ga = *(const f32x4*)(mb + 2048 + col);
#pragma unroll
            for (int mi = 0; mi < 4; ++mi) {
                const size_t o0 = (size_t)(m0 + 16 * mi + lr) * DM + col;
                const f32x4 r0 = *(const f32x4*)(P.x + o0) + ga * (acc[nt][mi] * rs_[mi] * gp);
                *(f32x4*)(P.out + o0) = r0;
                q1[mi] += r0.x * r0.x + r0.y * r0.y + r0.z * r0.z + r0.w * r0.w;
            }
            asm volatile("" ::: "memory");
        }
#pragma unroll
        for (int mi = 0; mi < 4; ++mi) { q1[mi] += __shfl_xor(q1[mi], 16); q1[mi] += __shfl_xor(q1[mi], 32); }
        if (g == 0) {
#pragma unroll
            for (int mi = 0; mi < 4; ++mi) s_part[512 + wv * 64 + 16 * mi + lr] = q1[mi];
        }
        __syncthreads();
        float rt_[4];
#pragma unroll
        for (int mi = 0; mi < 4; ++mi) { float q = 0.f;
#pragma unroll
            for (int w2 = 0; w2 < 8; ++w2) q += s_part[512 + w2 * 64 + 16 * mi + lr];
            rt_[mi] = rsqrtf(q * (1.f / DM) + EPS); }
        f32x4 lg[3][4];
#pragma unroll
        for (int i = 0; i < 3; ++i)
#pragma unroll
            for (int mi = 0; mi < 4; ++mi) lg[i][mi] = (f32x4){0.f, 0.f, 0.f, 0.f};
        const bf16_t* wr = WrF + ((size_t)(wv * 4) * 3 * 64 + lane) * 8;
#pragma unroll 1
        for (int p = 0; p < 4; ++p) {
            union { bf16x8 v; unsigned u[4]; } hh[4], hl[4];
#pragma unroll
            for (int q = 0; q < 2; ++q) {
                const int nt = 2 * p + q, col = 128 * wv + 16 * nt + 4 * g;
                const f32x4 gpf = *(const f32x4*)(P.g_pre_ffn + col), sc = *(const f32x4*)(mb + 4096 + col), sh = *(const f32x4*)(mb + 3072 + col);
                const f32x4 mul = gpf * (sc + 1.f);
#pragma unroll
                for (int mi = 0; mi < 4; ++mi) {
                    const f32x4 x1r = *(const f32x4*)(P.out + (size_t)(m0 + 16 * mi + lr) * DM + col);
                    const f32x4 h = x1r * rt_[mi] * mul + sh;
                    const unsigned u01 = pk2(h.x, h.y), u23 = pk2(h.z, h.w);
                    hh[mi].u[2 * q] = u01; hh[mi].u[2 * q + 1] = u23;
                    hl[mi].u[2 * q] = pk2(h.x - bflo(u01), h.y - bfhi(u01));
                    hl[mi].u[2 * q + 1] = pk2(h.z - bflo(u23), h.w - bfhi(u23));
                }
            }
#pragma unroll
            for (int mi = 0; mi < 4; ++mi) {
                u32x2 oa, ob; oa.x = hh[mi].u[0]; oa.y = hh[mi].u[1]; ob.x = hh[mi].u[2]; ob.y = hh[mi].u[3];
                store_pair16(H2 + (size_t)(m0 + 16 * mi + lr) * DM + 128 * wv, oa, ob, 2 * p, 2 * p + 1, g, true);
            }
#pragma unroll
            for (int ot = 0; ot < 3; ++ot) {
                const bf16x8 whi = *(const bf16x8*)(wr + (size_t)(p * 3 + ot) * 512);
                const bf16x8 wlo = *(const bf16x8*)(wr + (size_t)(4 * 8 * 3 * 64) * 8 + (size_t)(p * 3 + ot) * 512);
#pragma unroll
                for (int mi = 0; mi < 4; ++mi) {
                    lg[ot][mi] = __builtin_amdgcn_mfma_f32_16x16x32_bf16(whi, hh[mi].v, lg[ot][mi], 0, 0, 0);
                    lg[ot][mi] = __builtin_amdgcn_mfma_f32_16x16x32_bf16(whi, hl[mi].v, lg[ot][mi], 0, 0, 0);
                    lg[ot][mi] = __builtin_amdgcn_mfma_f32_16x16x32_bf16(wlo, hh[mi].v, lg[ot][mi], 0, 0, 0);
                }
            }
            asm volatile("" ::: "memory");
        }
#pragma unroll
        for (int ot = 0; ot < 3; ++ot)
#pragma unroll
            for (int mi = 0; mi < 4; ++mi)
#pragma unroll
                for (int e = 0; e < 4; ++e) s_lg[(wv * 48 + 16 * ot + 4 * g + e) * 64 + 16 * mi + lr] = lg[ot][mi][e];
        __syncthreads();
        if (t < 64 && !(P.flags & 1)) {
            const int row = m0 + t;
#define LG(o) (((s_lg[(o) * 64 + t] + s_lg[(48 + (o)) * 64 + t]) + (s_lg[(96 + (o)) * 64 + t] + s_lg[(144 + (o)) * 64 + t])) + \
               ((s_lg[(192 + (o)) * 64 + t] + s_lg[(240 + (o)) * 64 + t]) + (s_lg[(288 + (o)) * 64 + t] + s_lg[(336 + (o)) * 64 + t])))
            const float g0 = LG(0), g1 = LG(1), g2 = LG(2), g3 = LG(3);
            int gtop = 0; float gm = g0;
            if (g1 > gm) { gm = g1; gtop = 1; } if (g2 > gm) { gm = g2; gtop = 2; } if (g3 > gm) { gm = g3; gtop = 3; }
            const float gwt = 1.f / (expf(g0 - gm) + expf(g1 - gm) + expf(g2 - gm) + expf(g3 - gm));
            int i1 = 0, i2 = 0; float v1 = -3.0e38f, v2 = -3.0e38f;
            for (int e = 0; e < 8; ++e) {
                const float v = LG(4 + gtop * 8 + e);
                if (v > v1) { v2 = v1; i2 = i1; v1 = v; i1 = e; } else if (v > v2) { v2 = v; i2 = e; }
            }
#undef LG
            const float ex = expf(v2 - v1), w1 = gwt / (1.f + ex), w2 = gwt * ex / (1.f + ex);
            const int ea1 = gtop * 8 + i1, ea2 = gtop * 8 + i2;
            const unsigned p1 = atomicAdd(&cnt[ea1], 1u); ltok[ea1 * NT + p1] = row * 2;     lw[ea1 * NT + p1] = w1;
            const unsigned p2 = atomicAdd(&cnt[ea2], 1u); ltok[ea2 * NT + p2] = row * 2 + 1; lw[ea2 * NT + p2] = w2;
        }
    }
}

DEVINL void phase5(const Params& P, unsigned char* smem) {
    const int t = threadIdx.x, lane = t & 63, wv = __builtin_amdgcn_readfirstlane(t >> 6), lr = lane & 15, g = lane >> 4;
    const bf16_t* H2 = (const bf16_t*)(P.ws + WS_H);
    const unsigned* cnt = (const unsigned*)(P.ws + WS_CNT); const int* ltok = (const int*)(P.ws + WS_LTOK); const float* lw = (const float*)(P.ws + WS_LW);
    bf16_t* Y = (bf16_t*)(P.ws + WS_Y);
    int total = 0;
    for (int e = 0; e < 32; ++e) total += ((int)cnt[e] + 63) >> 6;
    const int G = gridDim.x, vb = (G % 8 == 0) ? (int)(blockIdx.x % 8) * (G / 8) + (int)(blockIdx.x / 8) : (int)blockIdx.x;
    for (int it = vb; it < total; it += G) {
        int mt = it, e = 0;
        for (; e < 32; ++e) { const int nt_ = ((int)cnt[e] + 63) >> 6; if (mt < nt_) break; mt -= nt_; }
        const int ce = (int)cnt[e], ntl = (ce + 63) >> 6, rpt = (ce + ntl - 1) / ntl;
        const int rbeg = mt * rpt, rend = (rbeg + rpt < ce) ? rbeg + rpt : ce;
        __syncthreads();
        REP(P5_RG) {
            asm volatile("" ::: "memory");
            const int row = t >> 3, r = rbeg + row;
            const int tok = (r < rend) ? (ltok[e * NT + r] >> 1) : 0;
            const bf16_t* src = H2 + (size_t)tok * DM;
#pragma unroll 4
            for (int i = 0; i < 16; ++i) { const int c = (t & 7) + 8 * i; *(u32x4*)(smem + row * 2048 + ((c ^ (row & 15)) << 4)) = *(const u32x4*)(src + c * 8); }
        }
        __syncthreads();
        unsigned voff = (unsigned)(lane * 16);
        asm volatile("" : "+v"(voff));
        {
            f32x4 acc[4][4];
            REP(P5_RK1) {
#pragma unroll
            for (int i = 0; i < 4; ++i)
#pragma unroll
                for (int mi = 0; mi < 4; ++mi) acc[i][mi] = (f32x4){0.f, 0.f, 0.f, 0.f};
            const unsigned char* wb = (const unsigned char*)(P.ws + WS_WGUF) + (size_t)e * (32 * 32 * 1024) + (size_t)(4 * wv) * 1024;
            const int aoff = lr * 2048;
#define AFRAG(mi_, ks_) (*(const bf16x8*)(smem + aoff + (mi_) * 32768 + (((4 * (ks_) + g) ^ lr) << 4)))
            bf16x8 b0[4], b1[4], b2[4], b3[4];
#define LOADB(dst, ks_) do { const unsigned char* ub_ = wb + (size_t)((ks_) * 32) * 1024; \
        _Pragma("unroll") for (int j_ = 0; j_ < 4; ++j_) dst[j_] = *(const bf16x8*)(ub_ + j_ * 1024 + voff); } while (0)
#define MMA(src, ks_) do { const bf16x8 f0 = AFRAG(0, ks_), f1 = AFRAG(1, ks_), f2 = AFRAG(2, ks_), f3 = AFRAG(3, ks_); \
        _Pragma("unroll") for (int j_ = 0; j_ < 4; ++j_) { acc[j_][0] = __builtin_amdgcn_mfma_f32_16x16x32_bf16(src[j_], f0, acc[j_][0], 0, 0, 0); \
            acc[j_][1] = __builtin_amdgcn_mfma_f32_16x16x32_bf16(src[j_], f1, acc[j_][1], 0, 0, 0); \
            acc[j_][2] = __builtin_amdgcn_mfma_f32_16x16x32_bf16(src[j_], f2, acc[j_][2], 0, 0, 0); \
            acc[j_][3] = __builtin_amdgcn_mfma_f32_16x16x32_bf16(src[j_], f3, acc[j_][3], 0, 0, 0); } } while (0)
            LOADB(b0, 0); LOADB(b1, 1); LOADB(b2, 2);
#pragma unroll 1
            for (int ks = 0; ks < 32; ks += 4) {
                LOADB(b3, ks + 3);
                MMA(b0, ks);
                if (ks + 4 < 32) LOADB(b0, ks + 4);
                MMA(b1, ks + 1);
                if (ks + 5 < 32) LOADB(b1, ks + 5);
                MMA(b2, ks + 2);
                if (ks + 6 < 32) LOADB(b2, ks + 6);
                MMA(b3, ks + 3);
            }
#undef LOADB
#undef MMA
#undef AFRAG
#if P5_RK1 > 1
#pragma unroll
            for (int i = 0; i < 4; ++i) asm volatile("" : "+v"(acc[i][0]), "+v"(acc[i][1]), "+v"(acc[i][2]), "+v"(acc[i][3]));
#endif
            }
            __syncthreads();
#pragma unroll
            for (int p = 0; p < 2; ++p)
#pragma unroll
                for (int mi = 0; mi < 4; ++mi) {
                    const f32x4 gt = acc[2 * p][mi], up = acc[2 * p + 1][mi];
                    f32x4 hd; hd.x = gt.x / (1.f + __expf(-gt.x)) * up.x; hd.y = gt.y / (1.f + __expf(-gt.y)) * up.y; hd.z = gt.z / (1.f + __expf(-gt.z)) * up.z; hd.w = gt.w / (1.f + __expf(-gt.w)) * up.w;
                    u32x2 o; o.x = pk2(hd.x, hd.y); o.y = pk2(hd.z, hd.w);
                    const int row = 16 * mi + lr, c = 4 * wv + 2 * p + (g >> 1);
                    *(u32x2*)(smem + row * 512 + ((c ^ (row & 15)) << 4) + (g & 1) * 8) = o;
                }
        }
        __syncthreads();
        {
            f32x4 acc[8][4];
            REP(P5_RK2) {
#pragma unroll
            for (int i = 0; i < 8; ++i)
#pragma unroll
                for (int mi = 0; mi < 4; ++mi) acc[i][mi] = (f32x4){0.f, 0.f, 0.f, 0.f};
            const unsigned char* wb = (const unsigned char*)(P.ws + WS_WDF) + (size_t)e * (8 * 64 * 1024) + (size_t)(8 * wv) * 1024;
            const int aoff = lr * 512;
#define AFRAG(mi_, ks_) (*(const bf16x8*)(smem + aoff + (mi_) * 8192 + (((4 * (ks_) + g) ^ lr) << 4)))
            bf16x8 b0[8], b1[8];
#define LOADB(dst, ks_) do { const unsigned char* ub_ = wb + (size_t)((ks_) * 64) * 1024; \
        _Pragma("unroll") for (int j_ = 0; j_ < 8; ++j_) dst[j_] = *(const bf16x8*)(ub_ + j_ * 1024 + voff); } while (0)
#define MMA(src, ks_) do { const bf16x8 f0 = AFRAG(0, ks_), f1 = AFRAG(1, ks_), f2 = AFRAG(2, ks_), f3 = AFRAG(3, ks_); \
        _Pragma("unroll") for (int j_ = 0; j_ < 8; ++j_) { acc[j_][0] = __builtin_amdgcn_mfma_f32_16x16x32_bf16(src[j_], f0, acc[j_][0], 0, 0, 0); \
            acc[j_][1] = __builtin_amdgcn_mfma_f32_16x16x32_bf16(src[j_], f1, acc[j_][1], 0, 0, 0); \
            acc[j_][2] = __builtin_amdgcn_mfma_f32_16x16x32_bf16(src[j_], f2, acc[j_][2], 0, 0, 0); \
            acc[j_][3] = __builtin_amdgcn_mfma_f32_16x16x32_bf16(src[j_], f3, acc[j_][3], 0, 0, 0); } } while (0)
            LOADB(b0, 0);
#pragma unroll 1
            for (int ks = 0; ks < 8; ks += 2) {
                LOADB(b1, ks + 1);
                MMA(b0, ks);
                if (ks + 2 < 8) LOADB(b0, ks + 2);
                MMA(b1, ks + 1);
            }
#undef LOADB
#undef MMA
#undef AFRAG
#if P5_RK2 > 1
#pragma unroll
            for (int i = 0; i < 8; ++i) asm volatile("" : "+v"(acc[i][0]), "+v"(acc[i][1]), "+v"(acc[i][2]), "+v"(acc[i][3]));
#endif
            }
            REP(P5_RE2)
#pragma unroll
            for (int mi = 0; mi < 4; ++mi) {
                asm volatile("" ::: "memory");
                const int r = rbeg + 16 * mi + lr;
                const bool ok = r < rend;
                const int ent = ok ? ltok[e * NT + r] : 0; const float wt = ok ? lw[e * NT + r] : 0.f;
                bf16_t* yp = Y + ((size_t)(ent & 1) * NT + (ent >> 1)) * DM + 128 * wv;
#pragma unroll
                for (int nt = 0; nt < 8; nt += 2) {
                    const f32x4 v = acc[nt][mi] * wt, v2 = acc[nt + 1][mi] * wt;
                    u32x2 oa, ob; oa.x = pk2(v.x, v.y); oa.y = pk2(v.z, v.w); ob.x = pk2(v2.x, v2.y); ob.y = pk2(v2.z, v2.w);
                    store_pair16(yp, oa, ob, nt, nt + 1, g, ok);
                }
            }
        }
    }
}

DEVINL void phase6(const Params& P) {
    const int lane = threadIdx.x & 63, gw = blockIdx.x * 8 + (threadIdx.x >> 6), ngw = gridDim.x * 8;
    const float* mod = (const float*)(P.ws + WS_MOD);
    const bf16_t* Y = (const bf16_t*)(P.ws + WS_Y);
    for (int row = gw; row < NT; row += ngw) {
        const float* mb = mod + (row >> 13) * 6144;
        f32x4 y[4]; float ss = 0.f;
#pragma unroll
        for (int j = 0; j < 4; ++j) {
            const int col = 4 * lane + 256 * j;
            const u32x2 a = *(const u32x2*)(Y + (size_t)row * DM + col), b = *(const u32x2*)(Y + ((size_t)NT + row) * DM + col);
            y[j] = (f32x4){bflo(a.x) + bflo(b.x), bfhi(a.x) + bfhi(b.x), bflo(a.y) + bflo(b.y), bfhi(a.y) + bfhi(b.y)};
            ss += y[j].x * y[j].x + y[j].y * y[j].y + y[j].z * y[j].z + y[j].w * y[j].w;
        }
        ss = wave_sum(ss);
        const float rstd = rsqrtf(ss * (1.f / DM) + EPS);
#pragma unroll
        for (int j = 0; j < 4; ++j) {
            const int col = 4 * lane + 256 * j;
            const f32x4 x1 = *(const f32x4*)(P.out + (size_t)row * DM + col), gp = *(const f32x4*)(P.g_post_ffn + col), gf = *(const f32x4*)(mb + 5120 + col);
            float* dst = (P.flags & 1) ? (float*)(P.ws + 155 * MiB) : P.out;
            *(f32x4*)(dst + (size_t)row * DM + col) = x1 + gf * (y[j] * rstd * gp);
        }
    }
}


#define LAS __attribute__((address_space(3)))
#define XB_TMO      128
#define XB_XCNT(j)  (256  + 64 * (j))
#define XB_XSUB(j)  (1280 + 64 * (j))
#define XB_XGEN(j)  (2304 + 64 * (j))
#define XB_TOP      3328
#define XB_TOPGEN   3392
#define XCD_BAR_WORDS 3456
#define XB_SPIN_CAP (1u << 18)
DEVINL unsigned xb_ld(unsigned* p)              { return __hip_atomic_load(p, __ATOMIC_RELAXED, __HIP_MEMORY_SCOPE_AGENT); }
DEVINL unsigned xb_add(unsigned* p, unsigned v) { return __hip_atomic_fetch_add(p, v, __ATOMIC_RELAXED, __HIP_MEMORY_SCOPE_AGENT); }
DEVINL unsigned xb_xcc_id() { return (unsigned)__builtin_amdgcn_s_getreg((3 << 11) | 20) & 0xFu; }
#define XB_SPIN(cond, bar) do { unsigned _sp = 0; while (cond) { __builtin_amdgcn_s_sleep(1); \
    if ((++_sp & 255u) == 0u) { if (xb_ld(&(bar)[XB_TMO])) break; if (_sp > XB_SPIN_CAP) { atomicAdd(&(bar)[XB_TMO], 1u); break; } } } } while (0)
struct XcdBarrier { unsigned* bar; unsigned x; volatile LAS unsigned* st; };
DEVINL XcdBarrier xcd_barrier_post(unsigned* bar, volatile LAS unsigned* st) {
    XcdBarrier b; b.bar = bar; b.x = xb_xcc_id(); b.st = st;
    if (threadIdx.x == 0) (void)xb_add(&bar[XB_XCNT(b.x)], 1u);
    return b;
}
DEVINL void xcd_barrier_complete(unsigned* bar, unsigned x, unsigned& nloc, unsigned& nx) {
    const unsigned G = gridDim.x * gridDim.y * gridDim.z;
    unsigned sum, cnt, mine, sp = 0u;
    for (;;) {
        sum = 0u; cnt = 0u; mine = 0u;
#pragma unroll
        for (unsigned j = 0; j < 16; ++j) { const unsigned c = xb_ld(&bar[XB_XCNT(j)]); sum += c; cnt += (c > 0u) ? 1u : 0u; mine = (j == x) ? c : mine; }
        if (sum == G) break;
        __builtin_amdgcn_s_sleep(1);
        if ((++sp & 255u) == 0u) { if (xb_ld(&bar[XB_TMO])) break; if (sp > XB_SPIN_CAP) { atomicAdd(&bar[XB_TMO], 1u); break; } }
    }
    nloc = mine > 0u ? mine : 1u; nx = cnt > 0u ? cnt : 1u;
}
DEVINL void xcd_barrier(const XcdBarrier& b) {
    asm volatile("s_waitcnt vmcnt(0)" ::: "memory");
    __syncthreads();
    if (threadIdx.x == 0) {
        unsigned* bar = b.bar;
        __builtin_amdgcn_s_waitcnt(0);
        unsigned nloc = b.st[0], nx = b.st[1];
        if (nloc == 0u) { xcd_barrier_complete(bar, b.x, nloc, nx); b.st[0] = nloc; b.st[1] = nx; }
        const unsigned old = xb_add(&bar[XB_XSUB(b.x)], 1u);
        const unsigned gen = old / nloc;
        if (old + 1u == (gen + 1u) * nloc) {
            __builtin_amdgcn_fence(__ATOMIC_RELEASE, "agent");
            asm volatile("s_waitcnt vmcnt(0)" ::: "memory");
            const unsigned og = xb_add(&bar[XB_TOP], 1u);
            const unsigned tg = og / nx;
            if (og + 1u == (tg + 1u) * nx) xb_add(&bar[XB_TOPGEN], 1u);
            else XB_SPIN(xb_ld(&bar[XB_TOPGEN]) == tg, bar);
            __builtin_amdgcn_fence(__ATOMIC_ACQUIRE, "agent");
            xb_add(&bar[XB_XGEN(b.x)], 1u);
            asm volatile("s_waitcnt vmcnt(0)" ::: "memory");
        } else {
            XB_SPIN(xb_ld(&bar[XB_XGEN(b.x)]) == gen, bar);
            __builtin_amdgcn_fence(__ATOMIC_ACQUIRE, "agent");
            asm volatile("s_waitcnt vmcnt(0)" ::: "memory");
        }
    }
    __syncthreads();
}
constexpr size_t WS_BAR = 16384;
constexpr size_t CTL_ZERO_BYTES = 65536;

constexpr int NPHASE = 6;
__global__ void __launch_bounds__(NTHR, 2) fwd_kernel(Params P) {
    extern __shared__ __attribute__((aligned(16))) unsigned char smem[];
#if N_LAUNCH_MODE == 1
    cg::grid_group grid = cg::this_grid();
#define SEAM(k) do { if (P.ph_lo <= (k) && (k) + 1 < P.ph_hi) grid.sync(); } while (0)
#elif N_LAUNCH_MODE == 2
    volatile LAS unsigned* bst = (volatile LAS unsigned*)(smem + LDS_MISC + 2048);
    if (threadIdx.x < 4) bst[threadIdx.x] = 0u;
    __syncthreads();
    const XcdBarrier xbar = xcd_barrier_post((unsigned*)(P.ws + WS_BAR), bst);
#define SEAM(k) do { if (P.ph_lo <= (k) && (k) + 1 < P.ph_hi) xcd_barrier(xbar); } while (0)
#else
#define SEAM(k) do { } while (0)
#endif
#define IN(k) (P.ph_lo <= (k) && (k) < P.ph_hi)
    if (IN(0)) { phase0(P, smem); }  SEAM(0);
    if (IN(1)) { phase2(P, smem); }  SEAM(1);
    if (IN(2)) { phase3(P, smem); }  SEAM(2);
    if (IN(3)) { phase4(P, smem); }  SEAM(3);
    if (IN(4)) { phase5(P, smem); }  SEAM(4);
    if (IN(5)) { phase6(P); }
#undef IN
#undef SEAM
}

extern "C" void kernel_launch(void* const* d_in, const int* in_sizes, int n_in, void* d_out, int out_size, void* d_ws, size_t ws_size, hipStream_t stream) {
    static int grid_blocks = 0;
    if (!grid_blocks) {
        if (ws_size < WS_END) { fprintf(stderr, "kernel_launch: workspace too small (%zu < %zu)\n", ws_size, (size_t)WS_END); grid_blocks = -1; return; }
        int dev = 0, cus = 0, per_cu = 0;
        hipGetDevice(&dev);
        hipDeviceGetAttribute(&cus, hipDeviceAttributeMultiprocessorCount, dev);
        hipFuncSetAttribute((const void*)fwd_kernel, hipFuncAttributeMaxDynamicSharedMemorySize, LDS_BYTES);
        hipOccupancyMaxActiveBlocksPerMultiprocessor(&per_cu, (const void*)fwd_kernel, NTHR, LDS_BYTES);
        if (per_cu > 1) per_cu = 1;
        if (per_cu < 1) per_cu = 1;
        grid_blocks = cus * per_cu;
        fprintf(stderr, "kernel_launch: %d CUs x %d blocks\n", cus, per_cu);
    }
    if (grid_blocks < 0) return;
    Params p{};
    const float** pp = (const float**)&p;
    for (int i = 0; i < 19; ++i) pp[i] = (const float*)d_in[i];
    p.out = (float*)d_out; p.ws = (unsigned char*)d_ws;
#if N_LAUNCH_MODE == 2
    p.ph_lo = 0; p.ph_hi = NPHASE;
    if (hipMemsetAsync(d_ws, 0, CTL_ZERO_BYTES, stream) != hipSuccess) { fprintf(stderr, "kernel_launch: memset failed\n"); return; }
    hipLaunchKernelGGL(fwd_kernel, dim3(grid_blocks), dim3(NTHR), LDS_BYTES, stream, p);
#elif N_LAUNCH_MODE == 1
    p.ph_lo = 0; p.ph_hi = NPHASE;
    void* args[] = {&p};
    hipError_t e = hipLaunchCooperativeKernel((const void*)fwd_kernel, dim3(grid_blocks), dim3(NTHR), args, LDS_BYTES, stream);
    if (e != hipSuccess) fprintf(stderr, "cooperative launch failed: %s (grid %d)\n", hipGetErrorString(e), grid_blocks);
#else
#ifndef REPEAT_ALL
#define REPEAT_ALL 1
#endif
#ifndef SKIP2_MASK
#define SKIP2_MASK 0
#endif
    for (int rep = 0; rep < REPEAT_ALL; ++rep)
    for (int ph = 0; ph < NPHASE; ++ph) {
        if (rep == 1 && (SKIP2_MASK & (1 << ph))) continue;
        p.ph_lo = ph; p.ph_hi = ph + 1;
        if (REPEAT_MASK & (1 << ph)) { p.flags = 1; hipLaunchKernelGGL(fwd_kernel, dim3(grid_blocks), dim3(NTHR), LDS_BYTES, stream, p); }
        p.flags = 0;
        hipLaunchKernelGGL(fwd_kernel, dim3(grid_blocks), dim3(NTHR), LDS_BYTES, stream, p);
    }
#endif
}
```

```cpp
#include <hip/hip_runtime.h>
#include <hip/hip_cooperative_groups.h>
#include <stdint.h>
#include <stdio.h>
namespace cg = cooperative_groups;

#ifndef NAIVE_ATTN
#define NAIVE_ATTN 0
#endif
#ifndef REPEAT_MASK
#define REPEAT_MASK 0
#endif
#ifndef P2_RS
#define P2_RS 1
#endif
#ifndef P2_RK
#define P2_RK 1
#endif
#ifndef P2_RE
#define P2_RE 1
#endif
#ifndef P3_RNA
#define P3_RNA 1
#endif
#ifndef P3_RSW
#define P3_RSW 1
#endif
#ifndef P5_RG
#define P5_RG 1
#endif
#ifndef P5_RK1
#define P5_RK1 1
#endif
#ifndef P5_RK2
#define P5_RK2 1
#endif
#ifndef P5_RE2
#define P5_RE2 1
#endif
#define SKIPF(bit) (P.flags & (bit))
#define REP(n) _Pragma("unroll 1") for (int rep_ = 0; rep_ < (n); ++rep_)
#ifndef N_LAUNCH_MODE
#define N_LAUNCH_MODE 2
#endif

#define DEVINL __device__ __forceinline__

typedef unsigned short bf16_t;
typedef short bf16x8 __attribute__((ext_vector_type(8)));
typedef float f32x4 __attribute__((ext_vector_type(4)));
typedef unsigned u32x4 __attribute__((ext_vector_type(4)));
typedef unsigned u32x2 __attribute__((ext_vector_type(2)));

constexpr int SEQ = 8192, DM = 1024, NT = 2 * SEQ;
constexpr int QKVW = 2304;
constexpr float EPS = 1e-6f;
constexpr float LOG2E = 1.4426950408889634f;
constexpr float QSCALE = 0.125f * LOG2E;

constexpr size_t MiB = 1u << 20;
constexpr size_t WS_CNT  = 0;
constexpr int CNT_STRIDE = 64;
constexpr size_t WS_MOD  = 1 * MiB;
constexpr size_t WS_ROPE = 2 * MiB;
constexpr size_t WS_WQF  = 4 * MiB;
constexpr size_t WS_WOF  = 9 * MiB;
constexpr size_t WS_WRF  = 1 * MiB + 512 * 1024;
constexpr size_t WS_WGUF = 11 * MiB;
constexpr size_t WS_WDF  = 27 * MiB;
constexpr size_t WS_H    = 59 * MiB;
constexpr size_t WS_NAQ  = 91 * MiB;
constexpr size_t WS_NAK  = 107 * MiB;
constexpr size_t WS_NAV  = 123 * MiB;
constexpr size_t WS_SWQ  = 139 * MiB;
constexpr size_t WS_SWK  = 155 * MiB;
constexpr size_t WS_SWV  = 159 * MiB;
constexpr size_t WS_ATT  = 163 * MiB;
constexpr size_t WS_SSQ  = 195 * MiB;
constexpr size_t WS_LTOK = 196 * MiB;
constexpr size_t WS_LW   = 198 * MiB;
constexpr size_t WS_Y    = 91 * MiB;
constexpr size_t WS_END  = 220 * MiB;

constexpr int NTHR = 512;
constexpr int LDS_HALF = 73728;
constexpr int LDS_MISC = 147456;
constexpr int LDS_BYTES = LDS_MISC + 4096;

struct Params {
    const float *x, *c, *w_ada, *b_ada, *g_pre_mix, *w_in, *na_rpb, *swa_sinks, *beta_na, *beta_swa, *w_out, *g_post_mix, *g_pre_ffn,
                *w_gr, *w_er, *w_gate, *w_up, *w_down, *g_post_ffn;
    float* out; unsigned char* ws; int ph_lo, ph_hi, flags, pad;
};

DEVINL unsigned f2bf(float f) { unsigned u = __float_as_uint(f); return (u + 0x7fffu + ((u >> 16) & 1u)) >> 16; }
typedef __bf16 bf16v2 __attribute__((ext_vector_type(2)));
typedef float f32x2 __attribute__((ext_vector_type(2)));
DEVINL unsigned pk2(float lo, float hi) { const f32x2 v = {lo, hi}; return __builtin_bit_cast(unsigned, __builtin_convertvector(v, bf16v2)); }
DEVINL void store_pair16(bf16_t* rowbase, u32x2 a, u32x2 b, int fa, int fb, int g, bool pred) {
    const auto rx = __builtin_amdgcn_permlane16_swap(a.x, b.x, false, false);
    const auto ry = __builtin_amdgcn_permlane16_swap(a.y, b.y, false, false);
    u32x4 o; o.x = rx[0]; o.y = ry[0]; o.z = rx[1]; o.w = ry[1];
    if (pred) *(u32x4*)(rowbase + 16 * ((g & 1) ? fb : fa) + 8 * (g >> 1)) = o;
}
DEVINL float bf2f(bf16_t v) { return __uint_as_float(((unsigned)v) << 16); }
DEVINL float bflo(unsigned u) { return __uint_as_float(u << 16); }
DEVINL float bfhi(unsigned u) { return __uint_as_float(u & 0xffff0000u); }
DEVINL float wave_sum(float v) {
#pragma unroll
    for (int o = 32; o >= 1; o >>= 1) v += __shfl_xor(v, o);
    return v;
}
DEVINL float silu_f(float v) { return v / (1.f + expf(-v)); }

DEVINL void mod_item(const Params& P, int item, unsigned char* smem, const int t) {
    float* s_silu = (float*)smem;
    float* s_red  = s_silu + 2048;
    for (int i = t; i < 2048; i += 256) s_silu[i] = silu_f(P.c[i]);
    __syncthreads();
    const int c4 = t & 7, rg = t >> 3, col = item * 32 + c4 * 4;
    f32x4 a0 = {0.f, 0.f, 0.f, 0.f}, a1 = {0.f, 0.f, 0.f, 0.f};
#pragma unroll 4
    for (int i = 0; i < 32; ++i) {
        const int k = rg + 32 * i;
        const f32x4 w = *(const f32x4*)(P.w_ada + (size_t)k * 6144 + col);
        a0 += w * s_silu[k]; a1 += w * s_silu[1024 + k];
    }
    *(f32x4*)(s_red + (rg * 2 + 0) * 32 + c4 * 4) = a0;
    *(f32x4*)(s_red + (rg * 2 + 1) * 32 + c4 * 4) = a1;
    __syncthreads();
    if (t < 64) {
        const int b = t >> 5, cc = t & 31; float s = 0.f;
        for (int r = 0; r < 32; ++r) s += s_red[(r * 2 + b) * 32 + cc];
        ((float*)(P.ws + WS_MOD))[b * 6144 + item * 32 + cc] = s + P.b_ada[item * 32 + cc];
    }
    __syncthreads();
}
DEVINL void frag_item(const float* src, int N, int kb, int nb, bf16_t* dst, int NTT, int mode, const float* kscale, unsigned char* smem, const int t) {
    float* scr = (float*)smem;
    const int k0 = kb * 64, n0 = nb * 64;
#pragma unroll
    for (int p = 0; p < 4; ++p) {
        const int r = (t >> 4) + 16 * p;
        f32x4 v = *(const f32x4*)(src + (size_t)(k0 + r) * N + n0 + (t & 15) * 4);
        const float sc = kscale ? kscale[r] : 1.f;
        float* d = scr + r * 65 + (t & 15) * 4;
        d[0] = v.x * sc; d[1] = v.y * sc; d[2] = v.z * sc; d[3] = v.w * sc;
    }
    __syncthreads();
    const int lane = t & 63, lr = lane & 15, g = lane >> 4;
#pragma unroll
    for (int i = 0; i < 2; ++i) {
        const int combo = (t >> 6) + 4 * i, ksl = combo >> 2, ntl = combo & 3;
        const float* sp = scr + (32 * ksl + 8 * g) * 65 + 16 * ntl + lr;
        u32x4 o; o.x = pk2(sp[0], sp[65]); o.y = pk2(sp[2 * 65], sp[3 * 65]); o.z = pk2(sp[4 * 65], sp[5 * 65]); o.w = pk2(sp[6 * 65], sp[7 * 65]);
        const int n16 = nb * 4 + ntl, nt = mode == 0 ? n16 : (mode == 1 ? 2 * n16 : 2 * n16 + 1);
        *(u32x4*)(dst + ((size_t)((kb * 2 + ksl) * NTT + nt) * 64 + lane) * 8) = o;
    }
    __syncthreads();
}
DEVINL unsigned pk4_fp8(float a, float b, float c, float d) {
    int r = __builtin_amdgcn_cvt_pk_fp8_f32(a, b, 0, false);
    r = __builtin_amdgcn_cvt_pk_fp8_f32(c, d, r, true);
    return (unsigned)r;
}
DEVINL void frag8_item(const float* src, int N, int kb, int nb, unsigned char* dst, int NTT, int mode, float scale, unsigned char* smem, const int t) {
    float* scr = (float*)smem;
    const int k0 = kb * 64, n0 = nb * 64;
#pragma unroll
    for (int p = 0; p < 4; ++p) {
        const int r = (t >> 4) + 16 * p;
        f32x4 v = *(const f32x4*)(src + (size_t)(k0 + r) * N + n0 + (t & 15) * 4);
        float* d = scr + r * 65 + (t & 15) * 4;
        d[0] = v.x * scale; d[1] = v.y * scale; d[2] = v.z * scale; d[3] = v.w * scale;
    }
    __syncthreads();
    const int lane = t & 63, lr = lane & 15, g = lane >> 4;
#pragma unroll
    for (int i = 0; i < 2; ++i) {
        const int combo = (t >> 6) + 4 * i, ksl = combo >> 2, ntl = combo & 3;
        const float* sp = scr + (32 * ksl + 8 * g) * 65 + 16 * ntl + lr;
        u32x2 o; o.x = pk4_fp8(sp[0], sp[65], sp[2 * 65], sp[3 * 65]); o.y = pk4_fp8(sp[4 * 65], sp[5 * 65], sp[6 * 65], sp[7 * 65]);
        const int n16 = nb * 4 + ntl, nt = mode == 0 ? n16 : (mode == 1 ? 2 * n16 : 2 * n16 + 1);
        *(u32x2*)(dst + ((size_t)((kb * 2 + ksl) * NTT + nt) * 64 + lane) * 8) = o;
    }
    __syncthreads();
}
DEVINL void router_frags(const Params& P) {
    bf16_t* dst = (bf16_t*)(P.ws + WS_WRF);
    for (int i = blockIdx.x * NTHR + threadIdx.x; i < 4 * 8 * 3 * 64; i += gridDim.x * NTHR) {
        const int lane = i & 63, ot = (i >> 6) % 3, wp = (i >> 6) / 3, p = wp & 7, w = wp >> 3, lr = lane & 15, g = lane >> 4;
        const int o = 16 * ot + lr;
        unsigned hi[8], lo[8];
#pragma unroll
        for (int j = 0; j < 8; ++j) {
            const int n = 256 * w + 32 * p + (j < 4 ? 4 * g + j : 16 + 4 * g + (j - 4));
            float v = 0.f;
            if (o < 4) v = P.w_gr[n * 4 + o]; else if (o < 36) v = P.w_er[((size_t)((o - 4) >> 3) * 1024 + n) * 8 + ((o - 4) & 7)];
            const unsigned h = f2bf(v); hi[j] = h; lo[j] = f2bf(v - __uint_as_float(h << 16));
        }
        u32x4 a, b;
        a.x = hi[0] | (hi[1] << 16); a.y = hi[2] | (hi[3] << 16); a.z = hi[4] | (hi[5] << 16); a.w = hi[6] | (hi[7] << 16);
        b.x = lo[0] | (lo[1] << 16); b.y = lo[2] | (lo[3] << 16); b.z = lo[4] | (lo[5] << 16); b.w = lo[6] | (lo[7] << 16);
        *(u32x4*)(dst + (size_t)i * 8) = a;
        *(u32x4*)(dst + (size_t)(4 * 8 * 3 * 64 + i) * 8) = b;
    }
}
DEVINL void phase0(const Params& P, unsigned char* smem) {
    const int t = threadIdx.x;
    if (blockIdx.x == 0 && t < 32) ((unsigned*)(P.ws + WS_CNT))[t * CNT_STRIDE] = 0u;
    {
        float* rc = (float*)(P.ws + WS_ROPE); float* rs = rc + SEQ * 32;
        for (int i = blockIdx.x * NTHR + t; i < SEQ * 32; i += gridDim.x * NTHR) {
            const int pos = i >> 5, fi = i & 31;
            const float ex = -((float)fi * 2.0f) / 64.0f;
            const float inv = exp2f(ex * 13.287712379549449f);
            const float ang = (float)pos * inv;
            double tt = (double)ang * 0.15915494309189535; tt -= floor(tt);
            const float fr = (float)tt;
            rc[i] = __builtin_amdgcn_cosf(fr); rs[i] = __builtin_amdgcn_sinf(fr);
        }
    }
    router_frags(P);
    bf16_t* WqF = (bf16_t*)(P.ws + WS_WQF); bf16_t* WoF = (bf16_t*)(P.ws + WS_WOF);
    unsigned char* WguF = P.ws + WS_WGUF; unsigned char* WdF = P.ws + WS_WDF;
    constexpr int NMOD = 192, NI_IN = 16 * 36, NI_OUT = 256, NI_E = 2048;
    constexpr int total = NMOD + NI_IN + NI_OUT + 3 * NI_E;
    const int half = t >> 8, th = t & 255; unsigned char* hsm = smem + half * LDS_HALF;
    static_assert((NMOD | NI_IN | NI_OUT | NI_E) % 2 == 0, "item pairs must be of one type (equal barrier counts in both half-blocks)");
    for (int it = 2 * blockIdx.x + half; it < total; it += 2 * gridDim.x) {
        int r = it;
        if (r < NMOD) { mod_item(P, r, hsm, th); continue; } r -= NMOD;
        if (r < NI_IN) { const int kb = r / 36, nb = r % 36; frag_item(P.w_in, QKVW, kb, nb, WqF, 144, 0, nullptr, hsm, th); continue; } r -= NI_IN;
        if (r < NI_OUT) { const int kb = r >> 4, nb = r & 15; const int k0 = kb * 64;
            const float* ks = (k0 < 512) ? (P.beta_na + k0) : (P.beta_swa + (k0 - 512));
            frag_item(P.w_out, 1024, kb, nb, WoF, 64, 0, ks, hsm, th); continue; } r -= NI_OUT;
        if (r < NI_E) { const int e = r >> 6, q = r & 63, kb = q >> 2, nb = q & 3;
            frag8_item(P.w_gate + (size_t)e * 1024 * 256, 256, kb, nb, WguF + (size_t)e * (32 * 32 * 512), 32, 1, 32.f, hsm, th); continue; } r -= NI_E;
        if (r < NI_E) { const int e = r >> 6, q = r & 63, kb = q >> 2, nb = q & 3;
            frag8_item(P.w_up + (size_t)e * 1024 * 256, 256, kb, nb, WguF + (size_t)e * (32 * 32 * 512), 32, 2, 32.f, hsm, th); continue; } r -= NI_E;
        { const int e = r >> 6, q = r & 63, kb = q >> 4, nb = q & 15;
            frag8_item(P.w_down + (size_t)e * 256 * 1024, 1024, kb, nb, WdF + (size_t)e * (8 * 64 * 512), 64, 0, 16.f, hsm, th); }
    }
}

DEVINL void qkv_store_head(const Params& P, const f32x4 (&v0)[4], int slot, int m, int g, const float* rc, const float* rs, int nfr, int fr0) {
    int region, hd;
    if (slot < 8) { region = 0; hd = slot; } else if (slot < 16) { region = 1; hd = slot - 8; } else if (slot < 24) { region = 2; hd = slot - 16; }
    else if (slot < 32) { region = 3; hd = slot - 24; } else if (slot < 34) { region = 4; hd = slot - 32; } else { region = 5; hd = slot - 34; }
    const size_t off = region == 0 ? WS_NAQ : region == 1 ? WS_NAK : region == 2 ? WS_NAV : region == 3 ? WS_SWQ : region == 4 ? WS_SWK : WS_SWV;
    const int nh = (region >= 4) ? 2 : 8, b = m >> 13, sq = m & (SEQ - 1), hp = nfr >> 1, fstep = (nfr == 4) ? 1 : 2;
    f32x4 v[4];
#pragma unroll
    for (int ni = 0; ni < 4; ++ni) v[ni] = v0[ni];
    if (region == 3 || region == 4) {
#pragma unroll
        for (int ni = 0; ni < 2; ++ni) if (ni < hp) {
            const int fr = fr0 + ni * fstep;
            const f32x4 cs = *(const f32x4*)(rc + sq * 32 + 16 * fr + 4 * g), sn = *(const f32x4*)(rs + sq * 32 + 16 * fr + 4 * g);
            const f32x4 x1 = v[ni], x2 = v[ni + hp];
            v[ni] = x1 * cs - x2 * sn; v[ni + hp] = x2 * cs + x1 * sn;
        }
    }
    if (region == 0 || region == 3) {
#pragma unroll
        for (int ni = 0; ni < 4; ++ni) v[ni] = v[ni] * QSCALE;
    }
    bf16_t* base = (bf16_t*)(P.ws + off) + ((size_t)(b * nh + hd) * SEQ + sq) * 64;
#pragma unroll
    for (int ni = 0; ni < 4; ni += 2) if (ni < nfr) {
        u32x2 a, b2; a.x = pk2(v[ni].x, v[ni].y); a.y = pk2(v[ni].z, v[ni].w); b2.x = pk2(v[ni + 1].x, v[ni + 1].y); b2.y = pk2(v[ni + 1].z, v[ni + 1].w);
        store_pair16(base, a, b2, fr0 + ni * fstep, fr0 + (ni + 1) * fstep, g, true);
    }
}
DEVINL void phase2(const Params& P, unsigned char* smem) {
    const int t = threadIdx.x, wv = __builtin_amdgcn_readfirstlane(t >> 6);
    const float* mod = (const float*)(P.ws + WS_MOD);
    const float* rc = (const float*)(P.ws + WS_ROPE); const float* rs = rc + SEQ * 32;
    for (int tile = blockIdx.x; tile < NT / 64; tile += gridDim.x) {
        const int m0 = tile * 64;
        int lane = t & 63;
        asm volatile("" : "+v"(lane));
        const int lr = lane & 15, g = lane >> 4;
        __syncthreads();
        if (!SKIPF(128)) REP(P2_RS) {
            asm volatile("" ::: "memory");
            const float* mb = mod + (m0 >> 13) * 6144;
            f32x4 mul[4], sh[4];
#pragma unroll
            for (int j = 0; j < 4; ++j) { const int col = 4 * lane + 256 * j;
                mul[j] = *(const f32x4*)(P.g_pre_mix + col) * (*(const f32x4*)(mb + 1024 + col) + 1.f); sh[j] = *(const f32x4*)(mb + col); }
#pragma unroll 4
            for (int rr = 0; rr < 8; ++rr) {
                const int row = 8 * wv + rr;
                const f32x4* xr = (const f32x4*)(P.x + (size_t)(m0 + row) * DM) + lane;
                f32x4 v[4]; float ss = 0.f;
#pragma unroll
                for (int j = 0; j < 4; ++j) { v[j] = xr[64 * j]; ss += v[j].x * v[j].x + v[j].y * v[j].y + v[j].z * v[j].z + v[j].w * v[j].w; }
                ss = wave_sum(ss);
                const float rstd = rsqrtf(ss * (1.f / DM) + EPS);
#pragma unroll
                for (int j = 0; j < 4; ++j) {
                    const f32x4 h = v[j] * rstd * mul[j] + sh[j];
                    u32x2 o; o.x = pk2(h.x, h.y); o.y = pk2(h.z, h.w);
                    const int c = (lane >> 1) + 32 * j;
                    *(u32x2*)(smem + row * 2048 + ((c ^ (row & 15)) << 4) + (lane & 1) * 8) = o;
                }
            }
        }
        __syncthreads();
        unsigned voff = (unsigned)(lane * 16);
        asm volatile("" : "+v"(voff));
        const int aoff = lr * 2048;
#define AFRAG(mi_, ks_) (*(const bf16x8*)(smem + aoff + (mi_) * 32768 + (((4 * (ks_) + g) ^ lr) << 4)))
#pragma unroll 1
        for (int pass = 0; pass < 2; ++pass) {
            f32x4 acc[8][4];
            REP(P2_RK) {
#pragma unroll
            for (int i = 0; i < 8; ++i)
#pragma unroll
                for (int mi = 0; mi < 4; ++mi) acc[i][mi] = (f32x4){0.f, 0.f, 0.f, 0.f};
            if (!SKIPF(256)) {
                const unsigned char* wb = (const unsigned char*)(P.ws + WS_WQF) + (size_t)(64 * pass + 8 * wv) * 1024;
                bf16x8 b0[8], b1[8];
#define LOADB(dst, ks_) do { const unsigned char* ub_ = wb + (size_t)((ks_) * 144) * 1024; \
        _Pragma("unroll") for (int j_ = 0; j_ < 8; ++j_) dst[j_] = *(const bf16x8*)(ub_ + j_ * 1024 + voff); } while (0)
#define LOADA(fd, ks_) do { _Pragma("unroll") for (int mi_ = 0; mi_ < 4; ++mi_) fd[mi_] = AFRAG(mi_, ks_); } while (0)
#define MMA(src, fs, ksn_) do { _Pragma("unroll") for (int mi_ = 0; mi_ < 4; ++mi_) { \
        _Pragma("unroll") for (int j_ = 0; j_ < 8; ++j_) acc[j_][mi_] = __builtin_amdgcn_mfma_f32_16x16x32_bf16(src[j_], fs[mi_], acc[j_][mi_], 0, 0, 0); \
        fs[mi_] = AFRAG(mi_, (ksn_) < 32 ? (ksn_) : 31); } } while (0)
                bf16x8 fa[4];
                LOADB(b0, 0); LOADA(fa, 0);
#pragma unroll 1
                for (int ks = 0; ks < 32; ks += 2) {
                    LOADB(b1, ks + 1);
                    MMA(b0, fa, ks + 1);
                    if (ks + 2 < 32) LOADB(b0, ks + 2);
                    MMA(b1, fa, ks + 2);
                }
#undef LOADB
#undef MMA
#undef LOADA
            }
#if P2_RK > 1
#pragma unroll
            for (int i = 0; i < 8; ++i) asm volatile("" : "+v"(acc[i][0]), "+v"(acc[i][1]), "+v"(acc[i][2]), "+v"(acc[i][3]));
#endif
            }
            if (!SKIPF(512)) REP(P2_RE) {
            int l2 = lane;
            asm volatile("" : "+v"(l2));
            const int lr2 = l2 & 15, g2 = l2 >> 4;
#pragma unroll
            for (int hh = 0; hh < 2; ++hh)
#pragma unroll
                for (int mi = 0; mi < 4; ++mi) {
                    f32x4 v[4];
#pragma unroll
                    for (int ni = 0; ni < 4; ++ni) v[ni] = acc[4 * hh + ni][mi];
                    qkv_store_head(P, v, 16 * pass + 2 * wv + hh, m0 + 16 * mi + lr2, g2, rc, rs, 4, 0);
                    asm volatile("" ::: "memory");
                }
            }
        }
        {
            f32x4 acc[2][4];
#pragma unroll
            for (int i = 0; i < 2; ++i)
#pragma unroll
                for (int mi = 0; mi < 4; ++mi) acc[i][mi] = (f32x4){0.f, 0.f, 0.f, 0.f};
            const int slot = 32 + (wv >> 1), fr0 = wv & 1;
            const unsigned char* wb = (const unsigned char*)(P.ws + WS_WQF) + (size_t)(4 * slot + fr0) * 1024;
            bf16x8 pa[4], pb[4];
#define LOADP(i_, ks_) do { pa[i_] = *(const bf16x8*)(wb + (size_t)((ks_) * 144) * 1024 + voff); pb[i_] = *(const bf16x8*)(wb + (size_t)((ks_) * 144 + 2) * 1024 + voff); } while (0)
#define STEP(i_, ks_) do { _Pragma("unroll") for (int mi = 0; mi < 4; ++mi) { const bf16x8 f = AFRAG(mi, ks_); \
        acc[0][mi] = __builtin_amdgcn_mfma_f32_16x16x32_bf16(pa[i_], f, acc[0][mi], 0, 0, 0); acc[1][mi] = __builtin_amdgcn_mfma_f32_16x16x32_bf16(pb[i_], f, acc[1][mi], 0, 0, 0); } } while (0)
            LOADP(0, 0); LOADP(1, 1); LOADP(2, 2);
#pragma unroll 1
            for (int ks = 0; ks < 32; ks += 4) {
                LOADP(3, ks + 3);
                STEP(0, ks);     if (ks + 4 < 32) LOADP(0, ks + 4);
                STEP(1, ks + 1); if (ks + 5 < 32) LOADP(1, ks + 5);
                STEP(2, ks + 2); if (ks + 6 < 32) LOADP(2, ks + 6);
                STEP(3, ks + 3);
            }
#undef LOADP
#undef STEP
            int l2 = lane;
            asm volatile("" : "+v"(l2));
            const int lr2 = l2 & 15, g2 = l2 >> 4;
#pragma unroll
            for (int mi = 0; mi < 4; ++mi) {
                f32x4 v[4]; v[0] = acc[0][mi]; v[1] = acc[1][mi]; v[2] = v[0]; v[3] = v[1];
                qkv_store_head(P, v, slot, m0 + 16 * mi + lr2, g2, rc, rs, 2, fr0);
                asm volatile("" ::: "memory");
            }
        }
#undef AFRAG
    }
}

#if NAIVE_ATTN
DEVINL void phase3(const Params& P, unsigned char* smem) {
    const int lane = threadIdx.x & 63, gw = blockIdx.x * 8 + (threadIdx.x >> 6), ngw = gridDim.x * 8;
    bf16_t* ATT = (bf16_t*)(P.ws + WS_ATT); float* SSQ = (float*)(P.ws + WS_SSQ);
    for (int it = gw; it < NT * 16; it += ngw) {
        const int isw = it >= NT * 8; const int r = isw ? it - NT * 8 : it;
        const int tok = r >> 3, h = r & 7, b = tok >> 13, s = tok & (SEQ - 1);
        float m = -3.0e38f, sum = 0.f, o = 0.f;
        if (!isw) {
            const bf16_t* Q = (const bf16_t*)(P.ws + WS_NAQ) + ((size_t)(b * 8 + h) * SEQ) * 64;
            const bf16_t* K = (const bf16_t*)(P.ws + WS_NAK) + ((size_t)(b * 8 + h) * SEQ) * 64;
            const bf16_t* VT = (const bf16_t*)(P.ws + WS_NAV) + ((size_t)(b * 8 + h) * SEQ) * 64;
            const float q = bf2f(Q[(size_t)s * 64 + lane]);
            const int row = s >> 6, col = s & 63;
            int r0 = row - 4; r0 = r0 < 0 ? 0 : (r0 > 120 ? 120 : r0);
            int cs = col - 8; cs = cs < 0 ? 0 : (cs > 48 ? 48 : cs);
            const float* rpb = P.na_rpb + h * 15 * 31;
            for (int pass = 0; pass < 2; ++pass)
                for (int i = 0; i < 8; ++i)
                    for (int j = 0; j < 16; ++j) {
                        const int key = (r0 + i) * 64 + cs + j;
                        float d = wave_sum(q * bf2f(K[(size_t)key * 64 + lane]));
                        d += rpb[(r0 + i - row + 7) * 31 + (cs + j - col + 15)] * LOG2E;
                        if (pass == 0) m = fmaxf(m, d);
                        else { const float p = exp2f(d - m); sum += p; o += p * bf2f(VT[(size_t)key * 64 + lane]); }
                    }
        } else {
            const int kvh = h >> 2;
            const bf16_t* Q = (const bf16_t*)(P.ws + WS_SWQ) + ((size_t)(b * 8 + h) * SEQ) * 64;
            const bf16_t* K = (const bf16_t*)(P.ws + WS_SWK) + ((size_t)(b * 2 + kvh) * SEQ) * 64;
            const bf16_t* VT = (const bf16_t*)(P.ws + WS_SWV) + ((size_t)(b * 2 + kvh) * SEQ) * 64;
            const float q = bf2f(Q[(size_t)s * 64 + lane]);
            const int klo = s - 128 < 0 ? 0 : s - 128, khi = s + 128 > SEQ - 1 ? SEQ - 1 : s + 128;
            const float sk = P.swa_sinks[h] * LOG2E;
            m = sk;
            for (int pass = 0; pass < 2; ++pass)
                for (int key = klo; key <= khi; ++key) {
                    const float d = wave_sum(q * bf2f(K[(size_t)key * 64 + lane]));
                    if (pass == 0) m = fmaxf(m, d);
                    else { const float p = exp2f(d - m); sum += p; o += p * bf2f(VT[(size_t)key * 64 + lane]); }
                }
            sum += exp2f(sk - m);
        }
        o /= sum;
        ATT[(size_t)tok * DM + (isw ? 512 : 0) + h * 64 + lane] = (bf16_t)f2bf(o);
        const float sq = wave_sum(o * o);
        if (lane == 0) SSQ[tok * 16 + (isw ? 8 : 0) + h] = sq;
    }
}
#else
typedef short s16x4 __attribute__((ext_vector_type(4)));
#define LAS3 __attribute__((address_space(3)))
DEVINL int k_off(int row, int c) { return row * 128 + ((c ^ ((row >> 1) & 7)) << 4); }
DEVINL int v_off(int row, int c) { return row * 128 + ((((c >> 1) ^ ((row >> 1) & 3)) << 5) | ((c & 1) << 4)); }
DEVINL bf16x8 tr_pair(const LAS3 unsigned char* p0, const LAS3 unsigned char* p1) {
    const s16x4 a = __builtin_amdgcn_ds_read_tr16_b64_v4i16((LAS3 s16x4*)p0), b = __builtin_amdgcn_ds_read_tr16_b64_v4i16((LAS3 s16x4*)p1);
    bf16x8 r; r[0] = a[0]; r[1] = a[1]; r[2] = a[2]; r[3] = a[3]; r[4] = b[0]; r[5] = b[1]; r[6] = b[2]; r[7] = b[3]; return r;
}
DEVINL void phase3(const Params& P, unsigned char* smem_all) {
    const int half = threadIdx.x >> 8, t = threadIdx.x & 255, lane = t & 63, w = t >> 6, lr = lane & 15, g = lane >> 4;
    unsigned char* smem = smem_all + half * LDS_HALF;
    bf16_t* ATT = (bf16_t*)(P.ws + WS_ATT); float* SSQ = (float*)(P.ws + WS_SSQ);
    const LAS3 unsigned char* lsm = (const LAS3 unsigned char*)smem;
    constexpr int N_NA = 2 * 8 * 128, N_SW = 2 * 2 * 512;
    static_assert(N_NA % 2 == 0 && N_SW % 2 == 0, "item pairs must be of one type");
    const int G = gridDim.x, vb = (G % 8 == 0) ? (int)(blockIdx.x % 8) * (G / 8) + (int)(blockIdx.x / 8) : (int)blockIdx.x;
    for (int it = 2 * vb + half; it < N_NA + N_SW; it += 2 * G) {
        if (SKIPF(it < N_NA ? 1024 : 2048)) continue;
        if (it < N_NA) REP(P3_RNA) {
            const int r = it & 127, h = (it >> 7) & 7, b = it >> 10;
            const int c0 = 16 * w;
            int r0 = r - 4; r0 = r0 < 0 ? 0 : (r0 > 120 ? 120 : r0);
            int kc0 = c0 - 8; kc0 = kc0 < 0 ? 0 : (kc0 > 32 ? 32 : kc0);
            const bf16_t* Q = (const bf16_t*)(P.ws + WS_NAQ) + ((size_t)(b * 8 + h) * SEQ) * 64;
            const bf16_t* Kg = (const bf16_t*)(P.ws + WS_NAK) + ((size_t)(b * 8 + h) * SEQ + r0 * 64) * 64;
            const bf16_t* Vg = (const bf16_t*)(P.ws + WS_NAV) + ((size_t)(b * 8 + h) * SEQ + r0 * 64) * 64;
            __syncthreads();
            float* s_rpb = (float*)(smem + 65536);
            for (int i = t; i < 465; i += 256) s_rpb[i] = P.na_rpb[h * 465 + i] * LOG2E;
            {
                u32x4 kr[16];
#pragma unroll
                for (int i = 0; i < 16; ++i) kr[i] = *(const u32x4*)(Kg + (size_t)(t + 256 * i) * 8);
#pragma unroll
                for (int i = 0; i < 16; ++i) { const int q = t + 256 * i; *(u32x4*)(smem + k_off(q >> 3, q & 7)) = kr[i]; }
            }
            const bf16_t* qp = Q + (size_t)(r * 64 + c0 + lr) * 64 + 8 * g;
            const bf16x8 q0 = *(const bf16x8*)qp, q1 = *(const bf16x8*)(qp + 32);
            __syncthreads();
            u32x4 vr[8];
#pragma unroll
            for (int i = 0; i < 8; ++i) vr[i] = *(const u32x4*)(Vg + (size_t)(t + 256 * i) * 8);
            f32x4 sc[16];
#pragma unroll
            for (int tt = 0; tt < 16; ++tt) {
                const int row = (tt >> 1) * 64 + kc0 + (tt & 1) * 16 + lr;
                const bf16x8 k0 = *(const bf16x8*)(smem + k_off(row, g)), k1 = *(const bf16x8*)(smem + k_off(row, 4 + g));
                f32x4 a = {0.f, 0.f, 0.f, 0.f};
                a = __builtin_amdgcn_mfma_f32_16x16x32_bf16(k0, q0, a, 0, 0, 0);
                a = __builtin_amdgcn_mfma_f32_16x16x32_bf16(k1, q1, a, 0, 0, 0);
                sc[tt] = a;
            }
            const int c = c0 + lr; int cs = c - 8; cs = cs < 0 ? 0 : (cs > 48 ? 48 : cs);
            const float* rp = s_rpb;
            float mx = -3.0e38f;
#pragma unroll
            for (int tt = 0; tt < 16; ++tt) {
                const int dr = r0 + (tt >> 1) - r + 7;
#pragma unroll
                for (int e = 0; e < 4; ++e) {
                    const int kc = kc0 + (tt & 1) * 16 + 4 * g + e;
                    const bool ok = (kc >= cs) && (kc < cs + 16);
                    int dc = kc - c + 15; dc = dc < 0 ? 0 : (dc > 30 ? 30 : dc);
                    const float v = ok ? sc[tt][e] + rp[dr * 31 + dc] : -3.0e38f;
                    sc[tt][e] = v; mx = fmaxf(mx, v);
                }
            }
            mx = fmaxf(mx, __shfl_xor(mx, 16)); mx = fmaxf(mx, __shfl_xor(mx, 32));
            float sum = 0.f;
            bf16x8 pf[8];
#pragma unroll
            for (int kk = 0; kk < 8; ++kk) {
                float p[8];
#pragma unroll
                for (int e = 0; e < 4; ++e) { p[e] = __builtin_amdgcn_exp2f(sc[2 * kk][e] - mx); p[4 + e] = __builtin_amdgcn_exp2f(sc[2 * kk + 1][e] - mx); }
                sum += ((p[0] + p[1]) + (p[2] + p[3])) + ((p[4] + p[5]) + (p[6] + p[7]));
                union { bf16x8 v; unsigned u[4]; } pk; pk.u[0] = pk2(p[0], p[1]); pk.u[1] = pk2(p[2], p[3]); pk.u[2] = pk2(p[4], p[5]); pk.u[3] = pk2(p[6], p[7]);
                pf[kk] = pk.v;
            }
            sum += __shfl_xor(sum, 16); sum += __shfl_xor(sum, 32);
            __syncthreads();
#pragma unroll
            for (int i = 0; i < 8; ++i) { const int q = t + 256 * i; *(u32x4*)(smem + v_off(q >> 3, q & 7)) = vr[i]; }
#pragma unroll
            for (int i = 0; i < 8; ++i) vr[i] = *(const u32x4*)(Vg + (size_t)(2048 + t + 256 * i) * 8);
            __syncthreads();
            f32x4 o[4];
#pragma unroll
            for (int dt = 0; dt < 4; ++dt) o[dt] = (f32x4){0.f, 0.f, 0.f, 0.f};
            const int vrow = kc0 + 4 * g + (lr >> 2), vsw = (vrow >> 1) & 3, vbase = vrow * 128 + (lr & 3) * 8;
#pragma unroll
            for (int kk = 0; kk < 4; ++kk)
#pragma unroll
                for (int dt = 0; dt < 4; ++dt) {
                    const LAS3 unsigned char* ap = lsm + vbase + ((dt ^ vsw) << 5) + kk * 8192;
                    o[dt] = __builtin_amdgcn_mfma_f32_16x16x32_bf16(tr_pair(ap, ap + 2048), pf[kk], o[dt], 0, 0, 0);
                }
#pragma unroll
            for (int i = 0; i < 8; ++i) { const int q = t + 256 * i; *(u32x4*)(smem + 32768 + v_off(q >> 3, q & 7)) = vr[i]; }
            __syncthreads();
#pragma unroll
            for (int kk = 0; kk < 4; ++kk)
#pragma unroll
                for (int dt = 0; dt < 4; ++dt) {
                    const LAS3 unsigned char* ap = lsm + 32768 + vbase + ((dt ^ vsw) << 5) + kk * 8192;
                    o[dt] = __builtin_amdgcn_mfma_f32_16x16x32_bf16(tr_pair(ap, ap + 2048), pf[4 + kk], o[dt], 0, 0, 0);
                }
            const float inv = 1.f / sum; float sq = 0.f;
            const int tok = b * SEQ + r * 64 + c0 + lr;
#pragma unroll
            for (int dt = 0; dt < 4; dt += 2) {
                const f32x4 v = o[dt] * inv, v2 = o[dt + 1] * inv;
                sq += (v.x * v.x + v.y * v.y + v.z * v.z + v.w * v.w) + (v2.x * v2.x + v2.y * v2.y + v2.z * v2.z + v2.w * v2.w);
                u32x2 oa, ob; oa.x = pk2(v.x, v.y); oa.y = pk2(v.z, v.w); ob.x = pk2(v2.x, v2.y); ob.y = pk2(v2.z, v2.w);
                store_pair16(ATT + (size_t)tok * DM + h * 64, oa, ob, dt, dt + 1, g, true);
            }
            sq += __shfl_xor(sq, 16); sq += __shfl_xor(sq, 32);
            if (g == 0) SSQ[tok * 16 + h] = sq;
        } else REP(P3_RSW) {
            const int r = it - N_NA, qt = r & 511, kvh = (r >> 9) & 1, b = r >> 10;
            const int hq = kvh * 4 + w, q0p = qt * 16, kb = q0p - 128;
            const bf16_t* Q = (const bf16_t*)(P.ws + WS_SWQ) + ((size_t)(b * 8 + hq) * SEQ) * 64;
            const bf16_t* Kg = (const bf16_t*)(P.ws + WS_SWK) + ((size_t)(b * 2 + kvh) * SEQ) * 64;
            const bf16_t* Vg = (const bf16_t*)(P.ws + WS_SWV) + ((size_t)(b * 2 + kvh) * SEQ) * 64;
            __syncthreads();
            {
                u32x4 kr[9], vr[9];
#pragma unroll
                for (int i = 0; i < 9; ++i) { const int q = t + 256 * i; int tokk = kb + (q >> 3); tokk = tokk < 0 ? 0 : (tokk > SEQ - 1 ? SEQ - 1 : tokk);
                    kr[i] = *(const u32x4*)(Kg + (size_t)tokk * 64 + (q & 7) * 8); vr[i] = *(const u32x4*)(Vg + (size_t)tokk * 64 + (q & 7) * 8); }
#pragma unroll
                for (int i = 0; i < 9; ++i) { const int q = t + 256 * i; *(u32x4*)(smem + k_off(q >> 3, q & 7)) = kr[i]; *(u32x4*)(smem + 36864 + v_off(q >> 3, q & 7)) = vr[i]; }
            }
            const bf16_t* qp = Q + (size_t)(q0p + lr) * 64 + 8 * g;
            const bf16x8 q0 = *(const bf16x8*)qp, q1 = *(const bf16x8*)(qp + 32);
            const float sk = P.swa_sinks[hq] * LOG2E;
            __syncthreads();
            f32x4 sc[18];
            float mx = sk;
#pragma unroll
            for (int tt = 0; tt < 18; ++tt) {
                const int kt0 = kb + 16 * tt;
                f32x4 a = {0.f, 0.f, 0.f, 0.f};
                const bool tile_ok = (tt < 17) && (kt0 >= 0) && (kt0 < SEQ);
                if (tt < 17) {
                    const int row = 16 * tt + lr;
                    const bf16x8 k0 = *(const bf16x8*)(smem + k_off(row, g)), k1 = *(const bf16x8*)(smem + k_off(row, 4 + g));
                    a = __builtin_amdgcn_mfma_f32_16x16x32_bf16(k0, q0, a, 0, 0, 0);
                    a = __builtin_amdgcn_mfma_f32_16x16x32_bf16(k1, q1, a, 0, 0, 0);
                }
#pragma unroll
                for (int e = 0; e < 4; ++e) {
                    const int dlt = 16 * tt + 4 * g + e - lr;
                    const bool ok = tile_ok && dlt >= 0 && dlt <= 256;
                    const float v = ok ? a[e] : -3.0e38f;
                    a[e] = v; mx = fmaxf(mx, v);
                }
                sc[tt] = a;
            }
            mx = fmaxf(mx, __shfl_xor(mx, 16)); mx = fmaxf(mx, __shfl_xor(mx, 32));
            float sum = 0.f;
            bf16x8 pf[9];
#pragma unroll
            for (int kk = 0; kk < 9; ++kk) {
                float p[8];
#pragma unroll
                for (int e = 0; e < 4; ++e) { p[e] = __builtin_amdgcn_exp2f(sc[2 * kk][e] - mx); p[4 + e] = __builtin_amdgcn_exp2f(sc[2 * kk + 1][e] - mx); }
                sum += ((p[0] + p[1]) + (p[2] + p[3])) + ((p[4] + p[5]) + (p[6] + p[7]));
                union { bf16x8 v; unsigned u[4]; } pk; pk.u[0] = pk2(p[0], p[1]); pk.u[1] = pk2(p[2], p[3]); pk.u[2] = pk2(p[4], p[5]); pk.u[3] = pk2(p[6], p[7]);
                pf[kk] = pk.v;
            }
            sum += __shfl_xor(sum, 16); sum += __shfl_xor(sum, 32);
            sum += __builtin_amdgcn_exp2f(sk - mx);
            f32x4 o[4];
#pragma unroll
            for (int dt = 0; dt < 4; ++dt) o[dt] = (f32x4){0.f, 0.f, 0.f, 0.f};
            const int vrow = 4 * g + (lr >> 2), vsw = (vrow >> 1) & 3, vbase = 36864 + vrow * 128 + (lr & 3) * 8;
#pragma unroll
            for (int kk = 0; kk < 9; ++kk)
#pragma unroll
                for (int dt = 0; dt < 4; ++dt) {
                    const LAS3 unsigned char* ap = lsm + vbase + ((dt ^ vsw) << 5) + kk * 4096;
                    o[dt] = __builtin_amdgcn_mfma_f32_16x16x32_bf16(tr_pair(ap, ap + 2048), pf[kk], o[dt], 0, 0, 0);
                }
            const float inv = 1.f / sum; float sq = 0.f;
            const int tok = b * SEQ + q0p + lr;
#pragma unroll
            for (int dt = 0; dt < 4; dt += 2) {
                const f32x4 v = o[dt] * inv, v2 = o[dt + 1] * inv;
                sq += (v.x * v.x + v.y * v.y + v.z * v.z + v.w * v.w) + (v2.x * v2.x + v2.y * v2.y + v2.z * v2.z + v2.w * v2.w);
                u32x2 oa, ob; oa.x = pk2(v.x, v.y); oa.y = pk2(v.z, v.w); ob.x = pk2(v2.x, v2.y); ob.y = pk2(v2.z, v2.w);
                store_pair16(ATT + (size_t)tok * DM + 512 + hq * 64, oa, ob, dt, dt + 1, g, true);
            }
            sq += __shfl_xor(sq, 16); sq += __shfl_xor(sq, 32);
            if (g == 0) SSQ[tok * 16 + 8 + hq] = sq;
        }
    }
}
#endif

DEVINL void phase4(const Params& P, unsigned char* smem) {
    const int t = threadIdx.x, wv = __builtin_amdgcn_readfirstlane(t >> 6);
    const bf16_t* ATT = (const bf16_t*)(P.ws + WS_ATT); const float* SSQ = (const float*)(P.ws + WS_SSQ);
    const bf16_t* WrF = (const bf16_t*)(P.ws + WS_WRF);
    const float* mod = (const float*)(P.ws + WS_MOD);
    unsigned char* H2 = P.ws + WS_H;
    unsigned* cnt = (unsigned*)(P.ws + WS_CNT); int* ltok = (int*)(P.ws + WS_LTOK); float* lw = (float*)(P.ws + WS_LW);
    float* s_part = (float*)(smem + 131072);
    float* s_lg = (float*)smem;
    for (int tile = blockIdx.x; tile < NT / 64; tile += gridDim.x) {
        const int m0 = tile * 64;
        int lane = t & 63;
        asm volatile("" : "+v"(lane));
        const int lr = lane & 15, g = lane >> 4;
        __syncthreads();
        {
            const int row = t >> 3;
            const float* sp = SSQ + (size_t)(m0 + row) * 16;
            const f32x4 a = *(const f32x4*)sp, b2 = *(const f32x4*)(sp + 4), c2 = *(const f32x4*)(sp + 8), d2 = *(const f32x4*)(sp + 12);
            const float rna = rsqrtf((a.x + a.y + a.z + a.w + b2.x + b2.y + b2.z + b2.w) * (1.f / 512.f) + EPS);
            const float rsw = rsqrtf((c2.x + c2.y + c2.z + c2.w + d2.x + d2.y + d2.z + d2.w) * (1.f / 512.f) + EPS);
            const bf16_t* src = ATT + (size_t)(m0 + row) * DM;
#pragma unroll 4
            for (int i = 0; i < 16; ++i) {
                const int c = (t & 7) + 8 * i;
                u32x4 v = *(const u32x4*)(src + c * 8);
                const float sc = (c < 64) ? rna : rsw;
                v.x = pk2(bflo(v.x) * sc, bfhi(v.x) * sc); v.y = pk2(bflo(v.y) * sc, bfhi(v.y) * sc);
                v.z = pk2(bflo(v.z) * sc, bfhi(v.z) * sc); v.w = pk2(bflo(v.w) * sc, bfhi(v.w) * sc);
                *(u32x4*)(smem + row * 2048 + ((c ^ (row & 15)) << 4)) = v;
            }
        }
        __syncthreads();
        f32x4 acc[8][4];
#pragma unroll
        for (int i = 0; i < 8; ++i)
#pragma unroll
            for (int mi = 0; mi < 4; ++mi) acc[i][mi] = (f32x4){0.f, 0.f, 0.f, 0.f};
        if (!SKIPF(32)) {
            const unsigned char* wb = (const unsigned char*)(P.ws + WS_WOF) + (size_t)(8 * wv) * 1024;
            unsigned voff = (unsigned)(lane * 16);
            asm volatile("" : "+v"(voff));
            const int aoff = lr * 2048;
#define AFRAG(mi_, ks_) (*(const bf16x8*)(smem + aoff + (mi_) * 32768 + (((4 * (ks_) + g) ^ lr) << 4)))
            bf16x8 b0[8], b1[8];
#define LOADB(dst, ks_) do { const unsigned char* ub_ = wb + (size_t)((ks_) * 64) * 1024; \
        _Pragma("unroll") for (int j_ = 0; j_ < 8; ++j_) dst[j_] = *(const bf16x8*)(ub_ + j_ * 1024 + voff); } while (0)
#define LOADA(fd, ks_) do { _Pragma("unroll") for (int mi_ = 0; mi_ < 4; ++mi_) fd[mi_] = AFRAG(mi_, ks_); } while (0)
#define MMA(src, fs, ksn_) do { _Pragma("unroll") for (int mi_ = 0; mi_ < 4; ++mi_) { \
        _Pragma("unroll") for (int j_ = 0; j_ < 8; ++j_) acc[j_][mi_] = __builtin_amdgcn_mfma_f32_16x16x32_bf16(src[j_], fs[mi_], acc[j_][mi_], 0, 0, 0); \
        fs[mi_] = AFRAG(mi_, (ksn_) < 32 ? (ksn_) : 31); } } while (0)
            bf16x8 fa[4];
            LOADB(b0, 0); LOADA(fa, 0);
#pragma unroll 1
            for (int ks = 0; ks < 32; ks += 2) {
                LOADB(b1, ks + 1);
                MMA(b0, fa, ks + 1);
                if (ks + 2 < 32) LOADB(b0, ks + 2);
                MMA(b1, fa, ks + 2);
            }
#undef LOADB
#undef MMA
#undef LOADA
#undef AFRAG
        }
        float ss[4];
#pragma unroll
        for (int mi = 0; mi < 4; ++mi) {
            float q = 0.f;
#pragma unroll
            for (int nt = 0; nt < 8; ++nt) { const f32x4 a = acc[nt][mi]; q += a.x * a.x + a.y * a.y + a.z * a.z + a.w * a.w; }
            q += __shfl_xor(q, 16); q += __shfl_xor(q, 32); ss[mi] = q;
        }
        if (g == 0) {
#pragma unroll
            for (int mi = 0; mi < 4; ++mi) s_part[wv * 64 + 16 * mi + lr] = ss[mi];
        }
        __syncthreads();
        float rs_[4];
#pragma unroll
        for (int mi = 0; mi < 4; ++mi) { float q = 0.f;
#pragma unroll
            for (int w2 = 0; w2 < 8; ++w2) q += s_part[w2 * 64 + 16 * mi + lr];
            rs_[mi] = rsqrtf(q * (1.f / DM) + EPS); }
        if (SKIPF(64)) continue;
        const float* mb = mod + (m0 >> 13) * 6144;
        float q1[4] = {0.f, 0.f, 0.f, 0.f};
        if (!SKIPF(4096))
#pragma unroll
        for (int nt = 0; nt < 8; ++nt) {
            const int col = 128 * wv + 16 * nt + 4 * g;
            const f32x4 gp = *(const f32x4*)(P.g_post_mix + col), ga = *(const f32x4*)(mb + 2048 + col);
#pragma unroll
            for (int mi = 0; mi < 4; ++mi) {
                const size_t o0 = (size_t)(m0 + 16 * mi + lr) * DM + col;
                const f32x4 r0 = *(const f32x4*)(P.x + o0) + ga * (acc[nt][mi] * rs_[mi] * gp);
                *(f32x4*)(P.out + o0) = r0;
                q1[mi] += r0.x * r0.x + r0.y * r0.y + r0.z * r0.z + r0.w * r0.w;
            }
            if (nt & 1) asm volatile("" ::: "memory");
        }
#pragma unroll
        for (int mi = 0; mi < 4; ++mi) { q1[mi] += __shfl_xor(q1[mi], 16); q1[mi] += __shfl_xor(q1[mi], 32); }
        if (g == 0) {
#pragma unroll
            for (int mi = 0; mi < 4; ++mi) s_part[512 + wv * 64 + 16 * mi + lr] = q1[mi];
        }
        __syncthreads();
        float rt_[4];
#pragma unroll
        for (int mi = 0; mi < 4; ++mi) { float q = 0.f;
#pragma unroll
            for (int w2 = 0; w2 < 8; ++w2) q += s_part[512 + w2 * 64 + 16 * mi + lr];
            rt_[mi] = rsqrtf(q * (1.f / DM) + EPS); }
        if (SKIPF(8192)) continue;
        f32x4 lg[3][4];
#pragma unroll
        for (int i = 0; i < 3; ++i)
#pragma unroll
            for (int mi = 0; mi < 4; ++mi) lg[i][mi] = (f32x4){0.f, 0.f, 0.f, 0.f};
        const bf16_t* wr = WrF + ((size_t)(wv * 4) * 3 * 64 + lane) * 8;
#pragma unroll 1
        for (int p = 0; p < 4; ++p) {
            union { bf16x8 v; unsigned u[4]; } hh[4], hl[4];
            unsigned h8[2][4];
#pragma unroll
            for (int q = 0; q < 2; ++q) {
                const int nt = 2 * p + q, col = 128 * wv + 16 * nt + 4 * g;
                const f32x4 gpf = *(const f32x4*)(P.g_pre_ffn + col), sc = *(const f32x4*)(mb + 4096 + col), sh = *(const f32x4*)(mb + 3072 + col);
                const f32x4 mul = gpf * (sc + 1.f);
#pragma unroll
                for (int mi = 0; mi < 4; ++mi) {
                    const f32x4 x1r = *(const f32x4*)(P.out + (size_t)(m0 + 16 * mi + lr) * DM + col);
                    const f32x4 h = x1r * rt_[mi] * mul + sh;
                    const unsigned u01 = pk2(h.x, h.y), u23 = pk2(h.z, h.w);
                    hh[mi].u[2 * q] = u01; hh[mi].u[2 * q + 1] = u23;
                    hl[mi].u[2 * q] = pk2(h.x - bflo(u01), h.y - bfhi(u01));
                    hl[mi].u[2 * q + 1] = pk2(h.z - bflo(u23), h.w - bfhi(u23));
                    h8[q][mi] = pk4_fp8(h.x, h.y, h.z, h.w);
                }
            }
#pragma unroll
            for (int mi = 0; mi < 4; ++mi) {
                const auto rr = __builtin_amdgcn_permlane16_swap(h8[0][mi], h8[1][mi], false, false);
                u32x2 ov; ov.x = rr[0]; ov.y = rr[1];
                *(u32x2*)(H2 + (size_t)(m0 + 16 * mi + lr) * DM + 128 * wv + 16 * (2 * p + (g & 1)) + 8 * (g >> 1)) = ov;
            }
#pragma unroll
            for (int ot = 0; ot < 3; ++ot) {
                const bf16x8 whi = *(const bf16x8*)(wr + (size_t)(p * 3 + ot) * 512);
                const bf16x8 wlo = *(const bf16x8*)(wr + (size_t)(4 * 8 * 3 * 64) * 8 + (size_t)(p * 3 + ot) * 512);
#pragma unroll
                for (int mi = 0; mi < 4; ++mi) {
                    lg[ot][mi] = __builtin_amdgcn_mfma_f32_16x16x32_bf16(whi, hh[mi].v, lg[ot][mi], 0, 0, 0);
                    lg[ot][mi] = __builtin_amdgcn_mfma_f32_16x16x32_bf16(whi, hl[mi].v, lg[ot][mi], 0, 0, 0);
                    lg[ot][mi] = __builtin_amdgcn_mfma_f32_16x16x32_bf16(wlo, hh[mi].v, lg[ot][mi], 0, 0, 0);
                }
            }
            asm volatile("" ::: "memory");
        }
#pragma unroll
        for (int ot = 0; ot < 3; ++ot)
#pragma unroll
            for (int mi = 0; mi < 4; ++mi)
#pragma unroll
                for (int e = 0; e < 4; ++e) s_lg[(wv * 48 + 16 * ot + 4 * g + e) * 64 + 16 * mi + lr] = lg[ot][mi][e];
        __syncthreads();
        if (t < 64 && !(P.flags & 1)) {
            const int row = m0 + t;
#define LG(o) (((s_lg[(o) * 64 + t] + s_lg[(48 + (o)) * 64 + t]) + (s_lg[(96 + (o)) * 64 + t] + s_lg[(144 + (o)) * 64 + t])) + \
               ((s_lg[(192 + (o)) * 64 + t] + s_lg[(240 + (o)) * 64 + t]) + (s_lg[(288 + (o)) * 64 + t] + s_lg[(336 + (o)) * 64 + t])))
            const float g0 = LG(0), g1 = LG(1), g2 = LG(2), g3 = LG(3);
            int gtop = 0; float gm = g0;
            if (g1 > gm) { gm = g1; gtop = 1; } if (g2 > gm) { gm = g2; gtop = 2; } if (g3 > gm) { gm = g3; gtop = 3; }
            const float gwt = 1.f / (expf(g0 - gm) + expf(g1 - gm) + expf(g2 - gm) + expf(g3 - gm));
            int i1 = 0, i2 = 0; float v1 = -3.0e38f, v2 = -3.0e38f;
            for (int e = 0; e < 8; ++e) {
                const float v = LG(4 + gtop * 8 + e);
                if (v > v1) { v2 = v1; i2 = i1; v1 = v; i1 = e; } else if (v > v2) { v2 = v; i2 = e; }
            }
#undef LG
            const float ex = expf(v2 - v1), w1 = gwt / (1.f + ex), w2 = gwt * ex / (1.f + ex);
            const int ea1 = gtop * 8 + i1, ea2 = gtop * 8 + i2;
            unsigned* s_cnt = (unsigned*)(smem + LDS_MISC);
            if (t < 32) s_cnt[t] = 0u;
            asm volatile("s_waitcnt lgkmcnt(0)" ::: "memory");
            const unsigned l1 = atomicAdd(&s_cnt[ea1], 1u), l2 = atomicAdd(&s_cnt[ea2], 1u);
            asm volatile("s_waitcnt lgkmcnt(0)" ::: "memory");
            if (t < 32) { const unsigned c = s_cnt[t]; s_cnt[32 + t] = c ? atomicAdd(&cnt[t * CNT_STRIDE], c) : 0u; }
            asm volatile("s_waitcnt vmcnt(0) lgkmcnt(0)" ::: "memory");
            const unsigned p1 = s_cnt[32 + ea1] + l1, p2 = s_cnt[32 + ea2] + l2;
            ltok[ea1 * NT + p1] = row * 2;     lw[ea1 * NT + p1] = w1;
            ltok[ea2 * NT + p2] = row * 2 + 1; lw[ea2 * NT + p2] = w2;
        }
    }
}

DEVINL void phase5(const Params& P, unsigned char* smem) {
    const int t = threadIdx.x, wv = __builtin_amdgcn_readfirstlane(t >> 6);
    const unsigned char* H2 = P.ws + WS_H;
    const unsigned* cnt = (const unsigned*)(P.ws + WS_CNT); const int* ltok = (const int*)(P.ws + WS_LTOK); const float* lw = (const float*)(P.ws + WS_LW);
    bf16_t* Y = (bf16_t*)(P.ws + WS_Y);
    unsigned char* hsm = smem + 81920;
    int total = 0;
    for (int e = 0; e < 32; ++e) { const int c = (int)cnt[e * CNT_STRIDE], n = (c + 79) / 80; total += n > 16 ? n : 16; }
    const int G = gridDim.x, vb = (G % 8 == 0) ? (int)(blockIdx.x % 8) * (G / 8) + (int)(blockIdx.x / 8) : (int)blockIdx.x;
    const int per = (total + G - 1) / G;
    for (int it = vb * per; it < (vb + 1) * per && it < total; ++it) {
        int mt = it, e = 0, ntl = 16;
        for (; e < 32; ++e) { const int c = (int)cnt[e * CNT_STRIDE], n = (c + 79) / 80; ntl = n > 16 ? n : 16; if (mt < ntl) break; mt -= ntl; }
        const int ce = (int)cnt[e * CNT_STRIDE], rpt = (ce + ntl - 1) / ntl;
        const int rbeg = mt * rpt, rend = (rbeg + rpt < ce) ? rbeg + rpt : ce;
        int lane = t & 63;
        asm volatile("" : "+v"(lane));
        const int lr = lane & 15, g = lane >> 4;
        unsigned voff = (unsigned)(lane * 8);
        asm volatile("" : "+v"(voff));
        long b0[4], b1[4], b2[4], b3[4];
        const unsigned char* wb1 = P.ws + WS_WGUF + (size_t)e * (32 * 32 * 512) + (size_t)(4 * wv) * 512;
#define LOADB(dst, ks_) do { const unsigned char* ub_ = wb1 + (size_t)((ks_) * 32) * 512; \
        _Pragma("unroll") for (int j_ = 0; j_ < 4; ++j_) dst[j_] = *(const long*)(ub_ + j_ * 512 + voff); } while (0)
        LOADB(b0, 0); LOADB(b1, 1); LOADB(b2, 2);
        __syncthreads();
        REP(P5_RG) {
            asm volatile("" ::: "memory");
#pragma unroll
            for (int rp = 0; rp < 2; ++rp) {
                const int row = (t >> 3) + 64 * rp, r = rbeg + row;
                if (row < 80) {
                    const int tok = (r < rend && !SKIPF(4)) ? (ltok[e * NT + r] >> 1) : 0;
                    const unsigned char* src = H2 + (size_t)tok * DM;
#pragma unroll
                    for (int i = 0; i < 8; ++i) { const int c = (t & 7) + 8 * i; *(u32x4*)(smem + row * 1024 + ((c ^ (row & 15)) << 4)) = *(const u32x4*)(src + c * 16); }
                }
            }
        }
        __syncthreads();
        {
            f32x4 acc[4][5];
            REP(P5_RK1) {
#pragma unroll
            for (int i = 0; i < 4; ++i)
#pragma unroll
                for (int mi = 0; mi < 5; ++mi) acc[i][mi] = (f32x4){0.f, 0.f, 0.f, 0.f};
            const int aoff = lr * 1024;
#define AFRAG(mi_, ks_) (*(const long*)(smem + aoff + (mi_) * 16384 + (((4 * (ks_) + g) ^ (lr << 1)) << 3)))
#define LOADA(fd, ks_) do { _Pragma("unroll") for (int mi_ = 0; mi_ < 5; ++mi_) fd[mi_] = AFRAG(mi_, ks_); } while (0)
#define MMA(src, fs, ksn_) do { _Pragma("unroll") for (int mi_ = 0; mi_ < 5; ++mi_) { \
        _Pragma("unroll") for (int j_ = 0; j_ < 4; ++j_) acc[j_][mi_] = __builtin_amdgcn_mfma_f32_16x16x32_fp8_fp8(src[j_], fs[mi_], acc[j_][mi_], 0, 0, 0); \
        fs[mi_] = AFRAG(mi_, (ksn_) < 32 ? (ksn_) : 31); } } while (0)
            long fa[5];
            if (rep_ > 0) { LOADB(b0, 0); LOADB(b1, 1); LOADB(b2, 2); }
            LOADA(fa, 0);
#pragma unroll 1
            for (int ks = SKIPF(8) ? 32 : 0; ks < 32; ks += 4) {
                LOADB(b3, ks + 3);
                MMA(b0, fa, ks + 1);
                if (ks + 4 < 32) LOADB(b0, ks + 4);
                MMA(b1, fa, ks + 2);
                if (ks + 5 < 32) LOADB(b1, ks + 5);
                MMA(b2, fa, ks + 3);
                if (ks + 6 < 32) LOADB(b2, ks + 6);
                MMA(b3, fa, ks + 4);
            }
#undef LOADB
#undef MMA
#undef LOADA
#undef AFRAG
#if P5_RK1 > 1
#pragma unroll
            for (int i = 0; i < 4; ++i) asm volatile("" : "+v"(acc[i][0]), "+v"(acc[i][1]), "+v"(acc[i][2]), "+v"(acc[i][3]), "+v"(acc[i][4]));
#endif
            }
#pragma unroll
            for (int p = 0; p < 2; ++p)
#pragma unroll
                for (int mi = 0; mi < 5; ++mi) {
                    const f32x4 gt = acc[2 * p][mi] * (1.f / 32.f), up = acc[2 * p + 1][mi] * (8.f / 32.f);
                    const unsigned o = pk4_fp8(gt.x / (1.f + __expf(-gt.x)) * up.x, gt.y / (1.f + __expf(-gt.y)) * up.y, gt.z / (1.f + __expf(-gt.z)) * up.z, gt.w / (1.f + __expf(-gt.w)) * up.w);
                    const int row = 16 * mi + lr, c8 = 4 * wv + 2 * p + (g >> 1);
                    *(unsigned*)(hsm + row * 256 + ((c8 ^ ((row & 15) << 1)) << 3) + (g & 1) * 4) = o;
                }
        }
        __syncthreads();
        {
            f32x4 acc[8][5];
            REP(P5_RK2) {
#pragma unroll
            for (int i = 0; i < 8; ++i)
#pragma unroll
                for (int mi = 0; mi < 5; ++mi) acc[i][mi] = (f32x4){0.f, 0.f, 0.f, 0.f};
            const unsigned char* wb = P.ws + WS_WDF + (size_t)e * (8 * 64 * 512) + (size_t)(8 * wv) * 512;
            const int aoff = lr * 256;
#define AFRAG(mi_, ks_) (*(const long*)(hsm + aoff + (mi_) * 4096 + (((4 * (ks_) + g) ^ (lr << 1)) << 3)))
            long b0[8], b1[8];
#define LOADB(dst, ks_) do { const unsigned char* ub_ = wb + (size_t)((ks_) * 64) * 512; \
        _Pragma("unroll") for (int j_ = 0; j_ < 8; ++j_) dst[j_] = *(const long*)(ub_ + j_ * 512 + voff); } while (0)
#define LOADA(fd, ks_) do { _Pragma("unroll") for (int mi_ = 0; mi_ < 5; ++mi_) fd[mi_] = AFRAG(mi_, ks_); } while (0)
#define MMA(src, fs, ksn_) do { _Pragma("unroll") for (int mi_ = 0; mi_ < 5; ++mi_) { \
        _Pragma("unroll") for (int j_ = 0; j_ < 8; ++j_) acc[j_][mi_] = __builtin_amdgcn_mfma_f32_16x16x32_fp8_fp8(src[j_], fs[mi_], acc[j_][mi_], 0, 0, 0); \
        fs[mi_] = AFRAG(mi_, (ksn_) < 8 ? (ksn_) : 7); } } while (0)
            long fa[5];
            LOADB(b0, 0); LOADA(fa, 0);
#pragma unroll 1
            for (int ks = SKIPF(16) ? 8 : 0; ks < 8; ks += 2) {
                LOADB(b1, ks + 1);
                MMA(b0, fa, ks + 1);
                if (ks + 2 < 8) LOADB(b0, ks + 2);
                MMA(b1, fa, ks + 2);
            }
#undef LOADB
#undef MMA
#undef LOADA
#undef AFRAG
#if P5_RK2 > 1
#pragma unroll
            for (int i = 0; i < 8; ++i) asm volatile("" : "+v"(acc[i][0]), "+v"(acc[i][1]), "+v"(acc[i][2]), "+v"(acc[i][3]), "+v"(acc[i][4]));
#endif
            }
            int l2 = lane;
            asm volatile("" : "+v"(l2));
            const int lr2 = l2 & 15, g2 = l2 >> 4;
            REP(P5_RE2)
#pragma unroll
            for (int mi = 0; mi < 5; ++mi) {
                asm volatile("" ::: "memory");
                const int r = rbeg + 16 * mi + lr2;
                const bool ok = r < rend && !SKIPF(2);
                const int ent = ok ? ltok[e * NT + r] : 0; const float wt = ok ? lw[e * NT + r] * (1.f / 128.f) : 0.f;
                bf16_t* yp = Y + ((size_t)(ent & 1) * NT + (ent >> 1)) * DM + 128 * wv;
#pragma unroll
                for (int nt = 0; nt < 8; nt += 2) {
                    const f32x4 v = acc[nt][mi] * wt, v2 = acc[nt + 1][mi] * wt;
                    u32x2 oa, ob; oa.x = pk2(v.x, v.y); oa.y = pk2(v.z, v.w); ob.x = pk2(v2.x, v2.y); ob.y = pk2(v2.z, v2.w);
                    store_pair16(yp, oa, ob, nt, nt + 1, g2, ok);
                }
            }
        }
    }
}

DEVINL void phase6(const Params& P) {
    const int lane = threadIdx.x & 63, gw = blockIdx.x * 8 + (threadIdx.x >> 6), ngw = gridDim.x * 8;
    const float* mod = (const float*)(P.ws + WS_MOD);
    const bf16_t* Y = (const bf16_t*)(P.ws + WS_Y);
    for (int row = gw; row < NT; row += ngw) {
        const float* mb = mod + (row >> 13) * 6144;
        f32x4 y[4]; float ss = 0.f;
#pragma unroll
        for (int j = 0; j < 4; ++j) {
            const int col = 4 * lane + 256 * j;
            const u32x2 a = *(const u32x2*)(Y + (size_t)row * DM + col), b = *(const u32x2*)(Y + ((size_t)NT + row) * DM + col);
            y[j] = (f32x4){bflo(a.x) + bflo(b.x), bfhi(a.x) + bfhi(b.x), bflo(a.y) + bflo(b.y), bfhi(a.y) + bfhi(b.y)};
            ss += y[j].x * y[j].x + y[j].y * y[j].y + y[j].z * y[j].z + y[j].w * y[j].w;
        }
        ss = wave_sum(ss);
        const float rstd = rsqrtf(ss * (1.f / DM) + EPS);
#pragma unroll
        for (int j = 0; j < 4; ++j) {
            const int col = 4 * lane + 256 * j;
            const f32x4 x1 = *(const f32x4*)(P.out + (size_t)row * DM + col), gp = *(const f32x4*)(P.g_post_ffn + col), gf = *(const f32x4*)(mb + 5120 + col);
            float* dst = (P.flags & 1) ? (float*)(P.ws + 155 * MiB) : P.out;
            *(f32x4*)(dst + (size_t)row * DM + col) = x1 + gf * (y[j] * rstd * gp);
        }
    }
}


#define LAS __attribute__((address_space(3)))
#define XB_TMO      128
#define XB_XCNT(j)  (256  + 64 * (j))
#define XB_XSUB(j)  (1280 + 64 * (j))
#define XB_XGEN(j)  (2304 + 64 * (j))
#define XB_TOP      3328
#define XB_TOPGEN   3392
#define XCD_BAR_WORDS 3456
#define XB_SPIN_CAP (1u << 18)
DEVINL unsigned xb_ld(unsigned* p)              { return __hip_atomic_load(p, __ATOMIC_RELAXED, __HIP_MEMORY_SCOPE_AGENT); }
DEVINL unsigned xb_add(unsigned* p, unsigned v) { return __hip_atomic_fetch_add(p, v, __ATOMIC_RELAXED, __HIP_MEMORY_SCOPE_AGENT); }
DEVINL unsigned xb_xcc_id() { return (unsigned)__builtin_amdgcn_s_getreg((3 << 11) | 20) & 0xFu; }
#define XB_SPIN(cond, bar) do { unsigned _sp = 0; while (cond) { __builtin_amdgcn_s_sleep(1); \
    if ((++_sp & 255u) == 0u) { if (xb_ld(&(bar)[XB_TMO])) break; if (_sp > XB_SPIN_CAP) { atomicAdd(&(bar)[XB_TMO], 1u); break; } } } } while (0)
struct XcdBarrier { unsigned* bar; unsigned x; volatile LAS unsigned* st; };
DEVINL XcdBarrier xcd_barrier_post(unsigned* bar, volatile LAS unsigned* st) {
    XcdBarrier b; b.bar = bar; b.x = xb_xcc_id(); b.st = st;
    if (threadIdx.x == 0) (void)xb_add(&bar[XB_XCNT(b.x)], 1u);
    return b;
}
DEVINL void xcd_barrier_complete(unsigned* bar, unsigned x, unsigned& nloc, unsigned& nx) {
    const unsigned G = gridDim.x * gridDim.y * gridDim.z;
    unsigned sum, cnt, mine, sp = 0u;
    for (;;) {
        sum = 0u; cnt = 0u; mine = 0u;
#pragma unroll
        for (unsigned j = 0; j < 16; ++j) { const unsigned c = xb_ld(&bar[XB_XCNT(j)]); sum += c; cnt += (c > 0u) ? 1u : 0u; mine = (j == x) ? c : mine; }
        if (sum == G) break;
        __builtin_amdgcn_s_sleep(1);
        if ((++sp & 255u) == 0u) { if (xb_ld(&bar[XB_TMO])) break; if (sp > XB_SPIN_CAP) { atomicAdd(&bar[XB_TMO], 1u); break; } }
    }
    nloc = mine > 0u ? mine : 1u; nx = cnt > 0u ? cnt : 1u;
}
DEVINL void xcd_barrier(const XcdBarrier& b) {
    asm volatile("s_waitcnt vmcnt(0)" ::: "memory");
    __syncthreads();
    if (threadIdx.x == 0) {
        unsigned* bar = b.bar;
        __builtin_amdgcn_s_waitcnt(0);
        unsigned nloc = b.st[0], nx = b.st[1];
        if (nloc == 0u) { xcd_barrier_complete(bar, b.x, nloc, nx); b.st[0] = nloc; b.st[1] = nx; }
        const unsigned old = xb_add(&bar[XB_XSUB(b.x)], 1u);
        const unsigned gen = old / nloc;
        if (old + 1u == (gen + 1u) * nloc) {
            __builtin_amdgcn_fence(__ATOMIC_RELEASE, "agent");
            asm volatile("s_waitcnt vmcnt(0)" ::: "memory");
            const unsigned og = xb_add(&bar[XB_TOP], 1u);
            const unsigned tg = og / nx;
            if (og + 1u == (tg + 1u) * nx) xb_add(&bar[XB_TOPGEN], 1u);
            else XB_SPIN(xb_ld(&bar[XB_TOPGEN]) == tg, bar);
            __builtin_amdgcn_fence(__ATOMIC_ACQUIRE, "agent");
            xb_add(&bar[XB_XGEN(b.x)], 1u);
            asm volatile("s_waitcnt vmcnt(0)" ::: "memory");
        } else {
            XB_SPIN(xb_ld(&bar[XB_XGEN(b.x)]) == gen, bar);
            __builtin_amdgcn_fence(__ATOMIC_ACQUIRE, "agent");
            asm volatile("s_waitcnt vmcnt(0)" ::: "memory");
        }
    }
    __syncthreads();
}
constexpr size_t WS_BAR = 16384;
constexpr size_t CTL_ZERO_BYTES = 65536;

constexpr int NPHASE = 6;
__global__ void __launch_bounds__(NTHR, 2) fwd_kernel(Params P) {
    extern __shared__ __attribute__((aligned(16))) unsigned char smem[];
#if N_LAUNCH_MODE == 1
    cg::grid_group grid = cg::this_grid();
#define SEAM(k) do { if (P.ph_lo <= (k) && (k) + 1 < P.ph_hi) grid.sync(); } while (0)
#elif N_LAUNCH_MODE == 2
    volatile LAS unsigned* bst = (volatile LAS unsigned*)(smem + LDS_MISC + 2048);
    if (threadIdx.x < 4) bst[threadIdx.x] = 0u;
    __syncthreads();
    const XcdBarrier xbar = xcd_barrier_post((unsigned*)(P.ws + WS_BAR), bst);
#define SEAM(k) do { if (P.ph_lo <= (k) && (k) + 1 < P.ph_hi) xcd_barrier(xbar); } while (0)
#else
#define SEAM(k) do { } while (0)
#endif
#define IN(k) (P.ph_lo <= (k) && (k) < P.ph_hi)
    if (IN(0)) { phase0(P, smem); }  SEAM(0);
    if (IN(1)) { phase2(P, smem); }  SEAM(1);
    if (IN(2)) { phase3(P, smem); }  SEAM(2);
    if (IN(3)) { phase4(P, smem); }  SEAM(3);
    if (IN(4)) { phase5(P, smem); }  SEAM(4);
    if (IN(5)) { phase6(P); }
#undef IN
#undef SEAM
}

extern "C" void kernel_launch(void* const* d_in, const int* in_sizes, int n_in, void* d_out, int out_size, void* d_ws, size_t ws_size, hipStream_t stream) {
    static int grid_blocks = 0;
    if (!grid_blocks) {
        if (ws_size < WS_END) { fprintf(stderr, "kernel_launch: workspace too small (%zu < %zu)\n", ws_size, (size_t)WS_END); grid_blocks = -1; return; }
        int dev = 0, cus = 0, per_cu = 0;
        hipGetDevice(&dev);
        hipDeviceGetAttribute(&cus, hipDeviceAttributeMultiprocessorCount, dev);
        hipFuncSetAttribute((const void*)fwd_kernel, hipFuncAttributeMaxDynamicSharedMemorySize, LDS_BYTES);
        hipOccupancyMaxActiveBlocksPerMultiprocessor(&per_cu, (const void*)fwd_kernel, NTHR, LDS_BYTES);
        if (per_cu > 1) per_cu = 1;
        if (per_cu < 1) per_cu = 1;
        grid_blocks = cus * per_cu;
        fprintf(stderr, "kernel_launch: %d CUs x %d blocks\n", cus, per_cu);
    }
    if (grid_blocks < 0) return;
    Params p{};
    const float** pp = (const float**)&p;
    for (int i = 0; i < 19; ++i) pp[i] = (const float*)d_in[i];
    p.out = (float*)d_out; p.ws = (unsigned char*)d_ws;
#if N_LAUNCH_MODE == 2
    p.ph_lo = 0; p.ph_hi = NPHASE;
    if (hipMemsetAsync(d_ws, 0, CTL_ZERO_BYTES, stream) != hipSuccess) { fprintf(stderr, "kernel_launch: memset failed\n"); return; }
    hipLaunchKernelGGL(fwd_kernel, dim3(grid_blocks), dim3(NTHR), LDS_BYTES, stream, p);
#elif N_LAUNCH_MODE == 1
    p.ph_lo = 0; p.ph_hi = NPHASE;
    void* args[] = {&p};
    hipError_t e = hipLaunchCooperativeKernel((const void*)fwd_kernel, dim3(grid_blocks), dim3(NTHR), args, LDS_BYTES, stream);
    if (e != hipSuccess) fprintf(stderr, "cooperative launch failed: %s (grid %d)\n", hipGetErrorString(e), grid_blocks);
#else
#ifndef REPEAT_ALL
#define REPEAT_ALL 1
#endif
#ifndef EMPTY_LAUNCHES
#define EMPTY_LAUNCHES 0
#endif
    for (int i = 0; i < EMPTY_LAUNCHES; ++i) { p.ph_lo = 99; p.ph_hi = 99; p.flags = 0; hipLaunchKernelGGL(fwd_kernel, dim3(grid_blocks), dim3(NTHR), LDS_BYTES, stream, p); }
#ifndef SKIP2_MASK
#define SKIP2_MASK 0
#endif
    for (int rep = 0; rep < REPEAT_ALL; ++rep)
    for (int ph = 0; ph < NPHASE; ++ph) {
        if (rep == 1 && (SKIP2_MASK & (1 << ph))) continue;
#ifndef SKIP1_MASK
#define SKIP1_MASK 0
#endif
        if (rep == 0 && REPEAT_ALL == 2 && (SKIP1_MASK & (1 << ph))) continue;
        p.ph_lo = ph; p.ph_hi = ph + 1;
        if (REPEAT_MASK & (1 << ph)) { p.flags = 1; hipLaunchKernelGGL(fwd_kernel, dim3(grid_blocks), dim3(NTHR), LDS_BYTES, stream, p); }
#ifndef PROBE_FLAGS1
#define PROBE_FLAGS1 0
#endif
        p.flags = (REPEAT_ALL == 2 && rep == 0) ? PROBE_FLAGS1 : 0;
        hipLaunchKernelGGL(fwd_kernel, dim3(grid_blocks), dim3(NTHR), LDS_BYTES, stream, p);
    }
#endif
}
```

```cpp
#include <hip/hip_runtime.h>
#include <hip/hip_cooperative_groups.h>
#include <stdint.h>
#include <stdio.h>
namespace cg = cooperative_groups;

#ifndef NAIVE_ATTN
#define NAIVE_ATTN 0
#endif
#ifndef REPEAT_MASK
#define REPEAT_MASK 0
#endif
#ifndef P2_RS
#define P2_RS 1
#endif
#ifndef P2_RK
#define P2_RK 1
#endif
#ifndef P2_RE
#define P2_RE 1
#endif
#ifndef P3_RNA
#define P3_RNA 1
#endif
#ifndef P3_RSW
#define P3_RSW 1
#endif
#ifndef P5_RG
#define P5_RG 1
#endif
#ifndef P5_RK1
#define P5_RK1 1
#endif
#ifndef P5_RK2
#define P5_RK2 1
#endif
#ifndef P5_RE2
#define P5_RE2 1
#endif
#define SKIPF(bit) (P.flags & (bit))
#define REP(n) _Pragma("unroll 1") for (int rep_ = 0; rep_ < (n); ++rep_)
#ifndef N_LAUNCH_MODE
#define N_LAUNCH_MODE 2
#endif

#define DEVINL __device__ __forceinline__

typedef unsigned short bf16_t;
typedef short bf16x8 __attribute__((ext_vector_type(8)));
typedef float f32x4 __attribute__((ext_vector_type(4)));
typedef unsigned u32x4 __attribute__((ext_vector_type(4)));
typedef unsigned u32x2 __attribute__((ext_vector_type(2)));

constexpr int SEQ = 8192, DM = 1024, NT = 2 * SEQ;
constexpr int QKVW = 2304;
constexpr float EPS = 1e-6f;
constexpr float LOG2E = 1.4426950408889634f;
constexpr float QSCALE = 0.125f * LOG2E;

constexpr size_t MiB = 1u << 20;
constexpr size_t WS_CNT  = 0;
constexpr int CNT_STRIDE = 64;
constexpr size_t WS_MOD  = 1 * MiB;
constexpr size_t WS_ROPE = 2 * MiB;
constexpr size_t WS_WQF  = 4 * MiB;
constexpr size_t WS_WOF  = 9 * MiB;
constexpr size_t WS_WRF  = 1 * MiB + 512 * 1024;
constexpr size_t WS_WGUF = 11 * MiB;
constexpr size_t WS_WDF  = 27 * MiB;
constexpr size_t WS_H    = 59 * MiB;
constexpr size_t WS_NAQ  = 91 * MiB;
constexpr size_t WS_NAK  = 107 * MiB;
constexpr size_t WS_NAV  = 123 * MiB;
constexpr size_t WS_SWQ  = 139 * MiB;
constexpr size_t WS_SWK  = 155 * MiB;
constexpr size_t WS_SWV  = 159 * MiB;
constexpr size_t WS_ATT  = 163 * MiB;
constexpr size_t WS_SSQ  = 195 * MiB;
constexpr size_t WS_LTOK = 196 * MiB;
constexpr size_t WS_LW   = 198 * MiB;
constexpr size_t WS_Y    = 91 * MiB;
constexpr size_t WS_X1B  = 200 * MiB;
constexpr size_t WS_END  = 232 * MiB;

constexpr int NTHR = 512;
constexpr int LDS_HALF = 73728;
constexpr int LDS_MISC = 147456;
constexpr int LDS_BYTES = LDS_MISC + 4096;

struct Params {
    const float *x, *c, *w_ada, *b_ada, *g_pre_mix, *w_in, *na_rpb, *swa_sinks, *beta_na, *beta_swa, *w_out, *g_post_mix, *g_pre_ffn,
                *w_gr, *w_er, *w_gate, *w_up, *w_down, *g_post_ffn;
    float* out; unsigned char* ws; int ph_lo, ph_hi, flags, pad;
};

DEVINL unsigned f2bf(float f) { unsigned u = __float_as_uint(f); return (u + 0x7fffu + ((u >> 16) & 1u)) >> 16; }
typedef __bf16 bf16v2 __attribute__((ext_vector_type(2)));
typedef float f32x2 __attribute__((ext_vector_type(2)));
DEVINL unsigned pk2(float lo, float hi) { const f32x2 v = {lo, hi}; return __builtin_bit_cast(unsigned, __builtin_convertvector(v, bf16v2)); }
DEVINL void store_pair16(bf16_t* rowbase, u32x2 a, u32x2 b, int fa, int fb, int g, bool pred) {
    const auto rx = __builtin_amdgcn_permlane16_swap(a.x, b.x, false, false);
    const auto ry = __builtin_amdgcn_permlane16_swap(a.y, b.y, false, false);
    u32x4 o; o.x = rx[0]; o.y = ry[0]; o.z = rx[1]; o.w = ry[1];
    if (pred) *(u32x4*)(rowbase + 16 * ((g & 1) ? fb : fa) + 8 * (g >> 1)) = o;
}
DEVINL float bf2f(bf16_t v) { return __uint_as_float(((unsigned)v) << 16); }
DEVINL float bflo(unsigned u) { return __uint_as_float(u << 16); }
DEVINL float bfhi(unsigned u) { return __uint_as_float(u & 0xffff0000u); }
DEVINL float wave_sum(float v) {
#pragma unroll
    for (int o = 32; o >= 1; o >>= 1) v += __shfl_xor(v, o);
    return v;
}
DEVINL float silu_f(float v) { return v / (1.f + expf(-v)); }

DEVINL void mod_item(const Params& P, int item, unsigned char* smem, const int t) {
    float* s_silu = (float*)smem;
    float* s_red  = s_silu + 2048;
    for (int i = t; i < 2048; i += 256) s_silu[i] = silu_f(P.c[i]);
    __syncthreads();
    const int c4 = t & 7, rg = t >> 3, col = item * 32 + c4 * 4;
    f32x4 a0 = {0.f, 0.f, 0.f, 0.f}, a1 = {0.f, 0.f, 0.f, 0.f};
#pragma unroll 4
    for (int i = 0; i < 32; ++i) {
        const int k = rg + 32 * i;
        const f32x4 w = *(const f32x4*)(P.w_ada + (size_t)k * 6144 + col);
        a0 += w * s_silu[k]; a1 += w * s_silu[1024 + k];
    }
    *(f32x4*)(s_red + (rg * 2 + 0) * 32 + c4 * 4) = a0;
    *(f32x4*)(s_red + (rg * 2 + 1) * 32 + c4 * 4) = a1;
    __syncthreads();
    if (t < 64) {
        const int b = t >> 5, cc = t & 31; float s = 0.f;
        for (int r = 0; r < 32; ++r) s += s_red[(r * 2 + b) * 32 + cc];
        ((float*)(P.ws + WS_MOD))[b * 6144 + item * 32 + cc] = s + P.b_ada[item * 32 + cc];
    }
    __syncthreads();
}
DEVINL void frag_item(const float* src, int N, int kb, int nb, bf16_t* dst, int NTT, int mode, const float* kscale, unsigned char* smem, const int t) {
    float* scr = (float*)smem;
    const int k0 = kb * 64, n0 = nb * 64;
#pragma unroll
    for (int p = 0; p < 4; ++p) {
        const int r = (t >> 4) + 16 * p;
        f32x4 v = *(const f32x4*)(src + (size_t)(k0 + r) * N + n0 + (t & 15) * 4);
        const float sc = kscale ? kscale[r] : 1.f;
        float* d = scr + r * 65 + (t & 15) * 4;
        d[0] = v.x * sc; d[1] = v.y * sc; d[2] = v.z * sc; d[3] = v.w * sc;
    }
    __syncthreads();
    const int lane = t & 63, lr = lane & 15, g = lane >> 4;
#pragma unroll
    for (int i = 0; i < 2; ++i) {
        const int combo = (t >> 6) + 4 * i, ksl = combo >> 2, ntl = combo & 3;
        const float* sp = scr + (32 * ksl + 8 * g) * 65 + 16 * ntl + lr;
        u32x4 o; o.x = pk2(sp[0], sp[65]); o.y = pk2(sp[2 * 65], sp[3 * 65]); o.z = pk2(sp[4 * 65], sp[5 * 65]); o.w = pk2(sp[6 * 65], sp[7 * 65]);
        const int n16 = nb * 4 + ntl, nt = mode == 0 ? n16 : (mode == 1 ? 2 * n16 : 2 * n16 + 1);
        *(u32x4*)(dst + ((size_t)((kb * 2 + ksl) * NTT + nt) * 64 + lane) * 8) = o;
    }
    __syncthreads();
}
DEVINL unsigned pk4_fp8(float a, float b, float c, float d) {
    int r = __builtin_amdgcn_cvt_pk_fp8_f32(a, b, 0, false);
    r = __builtin_amdgcn_cvt_pk_fp8_f32(c, d, r, true);
    return (unsigned)r;
}
DEVINL void frag8_item(const float* src, int N, int kb, int nb, unsigned char* dst, int NTT, int mode, float scale, unsigned char* smem, const int t) {
    float* scr = (float*)smem;
    const int k0 = kb * 64, n0 = nb * 64;
#pragma unroll
    for (int p = 0; p < 4; ++p) {
        const int r = (t >> 4) + 16 * p;
        f32x4 v = *(const f32x4*)(src + (size_t)(k0 + r) * N + n0 + (t & 15) * 4);
        float* d = scr + r * 65 + (t & 15) * 4;
        d[0] = v.x * scale; d[1] = v.y * scale; d[2] = v.z * scale; d[3] = v.w * scale;
    }
    __syncthreads();
    const int lane = t & 63, lr = lane & 15, g = lane >> 4;
#pragma unroll
    for (int i = 0; i < 2; ++i) {
        const int combo = (t >> 6) + 4 * i, ksl = combo >> 2, ntl = combo & 3;
        const float* sp = scr + (32 * ksl + 8 * g) * 65 + 16 * ntl + lr;
        u32x2 o; o.x = pk4_fp8(sp[0], sp[65], sp[2 * 65], sp[3 * 65]); o.y = pk4_fp8(sp[4 * 65], sp[5 * 65], sp[6 * 65], sp[7 * 65]);
        const int n16 = nb * 4 + ntl, nt = mode == 0 ? n16 : (mode == 1 ? 2 * n16 : 2 * n16 + 1);
        *(u32x2*)(dst + ((size_t)((kb * 2 + ksl) * NTT + nt) * 64 + lane) * 8) = o;
    }
    __syncthreads();
}
DEVINL void router_frags(const Params& P) {
    bf16_t* dst = (bf16_t*)(P.ws + WS_WRF);
    for (int i = blockIdx.x * NTHR + threadIdx.x; i < 4 * 8 * 3 * 64; i += gridDim.x * NTHR) {
        const int lane = i & 63, ot = (i >> 6) % 3, wp = (i >> 6) / 3, p = wp & 7, w = wp >> 3, lr = lane & 15, g = lane >> 4;
        const int o = 16 * ot + lr;
        unsigned hi[8], lo[8];
#pragma unroll
        for (int j = 0; j < 8; ++j) {
            const int n = 256 * w + 32 * p + (j < 4 ? 4 * g + j : 16 + 4 * g + (j - 4));
            float v = 0.f;
            if (o < 4) v = P.w_gr[n * 4 + o]; else if (o < 36) v = P.w_er[((size_t)((o - 4) >> 3) * 1024 + n) * 8 + ((o - 4) & 7)];
            const unsigned h = f2bf(v); hi[j] = h; lo[j] = f2bf(v - __uint_as_float(h << 16));
        }
        u32x4 a, b;
        a.x = hi[0] | (hi[1] << 16); a.y = hi[2] | (hi[3] << 16); a.z = hi[4] | (hi[5] << 16); a.w = hi[6] | (hi[7] << 16);
        b.x = lo[0] | (lo[1] << 16); b.y = lo[2] | (lo[3] << 16); b.z = lo[4] | (lo[5] << 16); b.w = lo[6] | (lo[7] << 16);
        *(u32x4*)(dst + (size_t)i * 8) = a;
        *(u32x4*)(dst + (size_t)(4 * 8 * 3 * 64 + i) * 8) = b;
    }
}
DEVINL void phase0(const Params& P, unsigned char* smem) {
    const int t = threadIdx.x;
    if (blockIdx.x == 0 && t < 32) ((unsigned*)(P.ws + WS_CNT))[t * CNT_STRIDE] = 0u;
    {
        float* rc = (float*)(P.ws + WS_ROPE); float* rs = rc + SEQ * 32;
        for (int i = blockIdx.x * NTHR + t; i < SEQ * 32; i += gridDim.x * NTHR) {
            const int pos = i >> 5, fi = i & 31;
            const float ex = -((float)fi * 2.0f) / 64.0f;
            const float inv = exp2f(ex * 13.287712379549449f);
            const float ang = (float)pos * inv;
            double tt = (double)ang * 0.15915494309189535; tt -= floor(tt);
            const float fr = (float)tt;
            rc[i] = __builtin_amdgcn_cosf(fr); rs[i] = __builtin_amdgcn_sinf(fr);
        }
    }
    router_frags(P);
    bf16_t* WqF = (bf16_t*)(P.ws + WS_WQF); bf16_t* WoF = (bf16_t*)(P.ws + WS_WOF);
    unsigned char* WguF = P.ws + WS_WGUF; unsigned char* WdF = P.ws + WS_WDF;
    constexpr int NMOD = 192, NI_IN = 16 * 36, NI_OUT = 256, NI_E = 2048;
    constexpr int total = NMOD + NI_IN + NI_OUT + 3 * NI_E;
    const int half = t >> 8, th = t & 255; unsigned char* hsm = smem + half * LDS_HALF;
    static_assert((NMOD | NI_IN | NI_OUT | NI_E) % 2 == 0, "item pairs must be of one type (equal barrier counts in both half-blocks)");
    for (int it = 2 * blockIdx.x + half; it < total; it += 2 * gridDim.x) {
        int r = it;
        if (r < NMOD) { mod_item(P, r, hsm, th); continue; } r -= NMOD;
        if (r < NI_IN) { const int kb = r / 36, nb = r % 36; frag_item(P.w_in, QKVW, kb, nb, WqF, 144, 0, nullptr, hsm, th); continue; } r -= NI_IN;
        if (r < NI_OUT) { const int kb = r >> 4, nb = r & 15; const int k0 = kb * 64;
            const float* ks = (k0 < 512) ? (P.beta_na + k0) : (P.beta_swa + (k0 - 512));
            frag_item(P.w_out, 1024, kb, nb, WoF, 64, 0, ks, hsm, th); continue; }
        break;
    }
    {
        constexpr int E0 = NMOD + NI_IN + NI_OUT;
        int it = 2 * blockIdx.x + half; while (it < E0) it += 2 * gridDim.x;
        f32x4 v[4];
#define E_DECODE(it_) const int r_ = (it_) - E0, kind_ = r_ / NI_E, rr_ = r_ % NI_E, e_ = rr_ >> 6, q_ = rr_ & 63; \
        const int kb_ = kind_ == 2 ? (q_ >> 4) : (q_ >> 2), nb_ = kind_ == 2 ? (q_ & 15) : (q_ & 3), N_ = kind_ == 2 ? 1024 : 256; \
        const float* src_ = (kind_ == 0 ? P.w_gate : kind_ == 1 ? P.w_up : P.w_down) + (size_t)e_ * 1024 * 256;
#define E_LOAD(it_) do { E_DECODE(it_) _Pragma("unroll") for (int p = 0; p < 4; ++p) v[p] = *(const f32x4*)(src_ + (size_t)(kb_ * 64 + (th >> 4) + 16 * p) * N_ + nb_ * 64 + (th & 15) * 4); } while (0)
        if (it < total) E_LOAD(it);
        int buf = 0;
        for (; it < total; it += 2 * gridDim.x) {
            E_DECODE(it)
            float* scr = (float*)(hsm + buf * 17408);
            const float scale = kind_ == 2 ? 16.f : 32.f;
#pragma unroll
            for (int p = 0; p < 4; ++p) { float* d = scr + ((th >> 4) + 16 * p) * 65 + (th & 15) * 4; d[0] = v[p].x * scale; d[1] = v[p].y * scale; d[2] = v[p].z * scale; d[3] = v[p].w * scale; }
            __syncthreads();
            if (it + 2 * (int)gridDim.x < total) E_LOAD(it + 2 * gridDim.x);
            unsigned char* dst = kind_ == 2 ? (WdF + (size_t)e_ * (8 * 64 * 512)) : (WguF + (size_t)e_ * (32 * 32 * 512));
            const int NTT = kind_ == 2 ? 64 : 32, lane = th & 63, lr = lane & 15, g = lane >> 4;
#pragma unroll
            for (int i = 0; i < 2; ++i) {
                const int combo = (th >> 6) + 4 * i, ksl = combo >> 2, ntl = combo & 3;
                const float* sp = scr + (32 * ksl + 8 * g) * 65 + 16 * ntl + lr;
                u32x2 o; o.x = pk4_fp8(sp[0], sp[65], sp[2 * 65], sp[3 * 65]); o.y = pk4_fp8(sp[4 * 65], sp[5 * 65], sp[6 * 65], sp[7 * 65]);
                const int n16 = nb_ * 4 + ntl, nt = kind_ == 2 ? n16 : (kind_ == 0 ? 2 * n16 : 2 * n16 + 1);
                *(u32x2*)(dst + ((size_t)((kb_ * 2 + ksl) * NTT + nt) * 64 + lane) * 8) = o;
            }
            buf ^= 1;
        }
#undef E_DECODE
#undef E_LOAD
        __syncthreads();
    }
}

DEVINL void qkv_store_head(const Params& P, const f32x4 (&v0)[4], int slot, int m, int g, const float* rc, const float* rs, int nfr, int fr0) {
    int region, hd;
    if (slot < 8) { region = 0; hd = slot; } else if (slot < 16) { region = 1; hd = slot - 8; } else if (slot < 24) { region = 2; hd = slot - 16; }
    else if (slot < 32) { region = 3; hd = slot - 24; } else if (slot < 34) { region = 4; hd = slot - 32; } else { region = 5; hd = slot - 34; }
    const size_t off = region == 0 ? WS_NAQ : region == 1 ? WS_NAK : region == 2 ? WS_NAV : region == 3 ? WS_SWQ : region == 4 ? WS_SWK : WS_SWV;
    const int nh = (region >= 4) ? 2 : 8, b = m >> 13, sq = m & (SEQ - 1), hp = nfr >> 1, fstep = (nfr == 4) ? 1 : 2;
    f32x4 v[4];
#pragma unroll
    for (int ni = 0; ni < 4; ++ni) v[ni] = v0[ni];
    if (region == 3 || region == 4) {
#pragma unroll
        for (int ni = 0; ni < 2; ++ni) if (ni < hp) {
            const int fr = fr0 + ni * fstep;
            const f32x4 cs = *(const f32x4*)(rc + sq * 32 + 16 * fr + 4 * g), sn = *(const f32x4*)(rs + sq * 32 + 16 * fr + 4 * g);
            const f32x4 x1 = v[ni], x2 = v[ni + hp];
            v[ni] = x1 * cs - x2 * sn; v[ni + hp] = x2 * cs + x1 * sn;
        }
    }
    if (region == 0 || region == 3) {
#pragma unroll
        for (int ni = 0; ni < 4; ++ni) v[ni] = v[ni] * QSCALE;
    }
    bf16_t* base = (bf16_t*)(P.ws + off) + ((size_t)(b * nh + hd) * SEQ + sq) * 64;
#pragma unroll
    for (int ni = 0; ni < 4; ni += 2) if (ni < nfr) {
        u32x2 a, b2; a.x = pk2(v[ni].x, v[ni].y); a.y = pk2(v[ni].z, v[ni].w); b2.x = pk2(v[ni + 1].x, v[ni + 1].y); b2.y = pk2(v[ni + 1].z, v[ni + 1].w);
        store_pair16(base, a, b2, fr0 + ni * fstep, fr0 + (ni + 1) * fstep, g, true);
    }
}
DEVINL void phase2(const Params& P, unsigned char* smem) {
    const int t = threadIdx.x, wv = __builtin_amdgcn_readfirstlane(t >> 6);
    const float* mod = (const float*)(P.ws + WS_MOD);
    const float* rc = (const float*)(P.ws + WS_ROPE); const float* rs = rc + SEQ * 32;
    for (int tile = blockIdx.x; tile < NT / 64; tile += gridDim.x) {
        const int m0 = tile * 64;
        int lane = t & 63;
        asm volatile("" : "+v"(lane));
        const int lr = lane & 15, g = lane >> 4;
        __syncthreads();
        if (!SKIPF(128)) REP(P2_RS) {
            asm volatile("" ::: "memory");
            const float* mb = mod + (m0 >> 13) * 6144;
            f32x4 mul[4], sh[4];
#pragma unroll
            for (int j = 0; j < 4; ++j) { const int col = 4 * lane + 256 * j;
                mul[j] = *(const f32x4*)(P.g_pre_mix + col) * (*(const f32x4*)(mb + 1024 + col) + 1.f); sh[j] = *(const f32x4*)(mb + col); }
#pragma unroll 4
            for (int rr = 0; rr < 8; ++rr) {
                const int row = 8 * wv + rr;
                const f32x4* xr = (const f32x4*)(P.x + (size_t)(m0 + row) * DM) + lane;
                f32x4 v[4]; float ss = 0.f;
#pragma unroll
                for (int j = 0; j < 4; ++j) { v[j] = xr[64 * j]; ss += v[j].x * v[j].x + v[j].y * v[j].y + v[j].z * v[j].z + v[j].w * v[j].w; }
                ss = wave_sum(ss);
                const float rstd = rsqrtf(ss * (1.f / DM) + EPS);
#pragma unroll
                for (int j = 0; j < 4; ++j) {
                    const f32x4 h = v[j] * rstd * mul[j] + sh[j];
                    u32x2 o; o.x = pk2(h.x, h.y); o.y = pk2(h.z, h.w);
                    const int c = (lane >> 1) + 32 * j;
                    *(u32x2*)(smem + row * 2048 + ((c ^ (row & 15)) << 4) + (lane & 1) * 8) = o;
                }
            }
        }
        __syncthreads();
        unsigned voff = (unsigned)(lane * 16);
        asm volatile("" : "+v"(voff));
        const int aoff = lr * 2048;
#define AFRAG(mi_, ks_) (*(const bf16x8*)(smem + aoff + (mi_) * 32768 + (((4 * (ks_) + g) ^ lr) << 4)))
#pragma unroll 1
        for (int pass = 0; pass < 2; ++pass) {
            f32x4 acc[8][4];
            REP(P2_RK) {
#pragma unroll
            for (int i = 0; i < 8; ++i)
#pragma unroll
                for (int mi = 0; mi < 4; ++mi) acc[i][mi] = (f32x4){0.f, 0.f, 0.f, 0.f};
            if (!SKIPF(256)) {
                const unsigned char* wb = (const unsigned char*)(P.ws + WS_WQF) + (size_t)(64 * pass + 8 * wv) * 1024;
                bf16x8 b0[8], b1[8];
#define LOADB(dst, ks_) do { const unsigned char* ub_ = wb + (size_t)((ks_) * 144) * 1024; \
        _Pragma("unroll") for (int j_ = 0; j_ < 8; ++j_) dst[j_] = *(const bf16x8*)(ub_ + j_ * 1024 + voff); } while (0)
#define LOADA(fd, ks_) do { _Pragma("unroll") for (int mi_ = 0; mi_ < 4; ++mi_) fd[mi_] = AFRAG(mi_, ks_); } while (0)
#define MMA(src, fs, ksn_) do { _Pragma("unroll") for (int mi_ = 0; mi_ < 4; ++mi_) { \
        _Pragma("unroll") for (int j_ = 0; j_ < 8; ++j_) acc[j_][mi_] = __builtin_amdgcn_mfma_f32_16x16x32_bf16(src[j_], fs[mi_], acc[j_][mi_], 0, 0, 0); \
        fs[mi_] = AFRAG(mi_, (ksn_) < 32 ? (ksn_) : 31); } } while (0)
                bf16x8 fa[4];
                LOADB(b0, 0); LOADA(fa, 0);
#pragma unroll 1
                for (int ks = 0; ks < 32; ks += 2) {
                    LOADB(b1, ks + 1);
                    MMA(b0, fa, ks + 1);
                    if (ks + 2 < 32) LOADB(b0, ks + 2);
                    MMA(b1, fa, ks + 2);
                }
#undef LOADB
#undef MMA
#undef LOADA
            }
#if P2_RK > 1
#pragma unroll
            for (int i = 0; i < 8; ++i) asm volatile("" : "+v"(acc[i][0]), "+v"(acc[i][1]), "+v"(acc[i][2]), "+v"(acc[i][3]));
#endif
            }
            if (!SKIPF(512)) REP(P2_RE) {
            int l2 = lane;
            asm volatile("" : "+v"(l2));
            const int lr2 = l2 & 15, g2 = l2 >> 4;
#pragma unroll
            for (int hh = 0; hh < 2; ++hh)
#pragma unroll
                for (int mi = 0; mi < 4; ++mi) {
                    f32x4 v[4];
#pragma unroll
                    for (int ni = 0; ni < 4; ++ni) v[ni] = acc[4 * hh + ni][mi];
                    qkv_store_head(P, v, 16 * pass + 2 * wv + hh, m0 + 16 * mi + lr2, g2, rc, rs, 4, 0);
                    asm volatile("" ::: "memory");
                }
            }
        }
        {
            f32x4 acc[2][4];
#pragma unroll
            for (int i = 0; i < 2; ++i)
#pragma unroll
                for (int mi = 0; mi < 4; ++mi) acc[i][mi] = (f32x4){0.f, 0.f, 0.f, 0.f};
            const int slot = 32 + (wv >> 1), fr0 = wv & 1;
            const unsigned char* wb = (const unsigned char*)(P.ws + WS_WQF) + (size_t)(4 * slot + fr0) * 1024;
            bf16x8 pa[4], pb[4];
#define LOADP(i_, ks_) do { pa[i_] = *(const bf16x8*)(wb + (size_t)((ks_) * 144) * 1024 + voff); pb[i_] = *(const bf16x8*)(wb + (size_t)((ks_) * 144 + 2) * 1024 + voff); } while (0)
#define STEP(i_, ks_) do { _Pragma("unroll") for (int mi = 0; mi < 4; ++mi) { const bf16x8 f = AFRAG(mi, ks_); \
        acc[0][mi] = __builtin_amdgcn_mfma_f32_16x16x32_bf16(pa[i_], f, acc[0][mi], 0, 0, 0); acc[1][mi] = __builtin_amdgcn_mfma_f32_16x16x32_bf16(pb[i_], f, acc[1][mi], 0, 0, 0); } } while (0)
            LOADP(0, 0); LOADP(1, 1); LOADP(2, 2);
#pragma unroll 1
            for (int ks = 0; ks < 32; ks += 4) {
                LOADP(3, ks + 3);
                STEP(0, ks);     if (ks + 4 < 32) LOADP(0, ks + 4);
                STEP(1, ks + 1); if (ks + 5 < 32) LOADP(1, ks + 5);
                STEP(2, ks + 2); if (ks + 6 < 32) LOADP(2, ks + 6);
                STEP(3, ks + 3);
            }
#undef LOADP
#undef STEP
            int l2 = lane;
            asm volatile("" : "+v"(l2));
            const int lr2 = l2 & 15, g2 = l2 >> 4;
#pragma unroll
            for (int mi = 0; mi < 4; ++mi) {
                f32x4 v[4]; v[0] = acc[0][mi]; v[1] = acc[1][mi]; v[2] = v[0]; v[3] = v[1];
                qkv_store_head(P, v, slot, m0 + 16 * mi + lr2, g2, rc, rs, 2, fr0);
                asm volatile("" ::: "memory");
            }
        }
#undef AFRAG
    }
}

#if NAIVE_ATTN
DEVINL void phase3(const Params& P, unsigned char* smem) {
    const int lane = threadIdx.x & 63, gw = blockIdx.x * 8 + (threadIdx.x >> 6), ngw = gridDim.x * 8;
    bf16_t* ATT = (bf16_t*)(P.ws + WS_ATT); float* SSQ = (float*)(P.ws + WS_SSQ);
    for (int it = gw; it < NT * 16; it += ngw) {
        const int isw = it >= NT * 8; const int r = isw ? it - NT * 8 : it;
        const int tok = r >> 3, h = r & 7, b = tok >> 13, s = tok & (SEQ - 1);
        float m = -3.0e38f, sum = 0.f, o = 0.f;
        if (!isw) {
            const bf16_t* Q = (const bf16_t*)(P.ws + WS_NAQ) + ((size_t)(b * 8 + h) * SEQ) * 64;
            const bf16_t* K = (const bf16_t*)(P.ws + WS_NAK) + ((size_t)(b * 8 + h) * SEQ) * 64;
            const bf16_t* VT = (const bf16_t*)(P.ws + WS_NAV) + ((size_t)(b * 8 + h) * SEQ) * 64;
            const float q = bf2f(Q[(size_t)s * 64 + lane]);
            const int row = s >> 6, col = s & 63;
            int r0 = row - 4; r0 = r0 < 0 ? 0 : (r0 > 120 ? 120 : r0);
            int cs = col - 8; cs = cs < 0 ? 0 : (cs > 48 ? 48 : cs);
            const float* rpb = P.na_rpb + h * 15 * 31;
            for (int pass = 0; pass < 2; ++pass)
                for (int i = 0; i < 8; ++i)
                    for (int j = 0; j < 16; ++j) {
                        const int key = (r0 + i) * 64 + cs + j;
                        float d = wave_sum(q * bf2f(K[(size_t)key * 64 + lane]));
                        d += rpb[(r0 + i - row + 7) * 31 + (cs + j - col + 15)] * LOG2E;
                        if (pass == 0) m = fmaxf(m, d);
                        else { const float p = exp2f(d - m); sum += p; o += p * bf2f(VT[(size_t)key * 64 + lane]); }
                    }
        } else {
            const int kvh = h >> 2;
            const bf16_t* Q = (const bf16_t*)(P.ws + WS_SWQ) + ((size_t)(b * 8 + h) * SEQ) * 64;
            const bf16_t* K = (const bf16_t*)(P.ws + WS_SWK) + ((size_t)(b * 2 + kvh) * SEQ) * 64;
            const bf16_t* VT = (const bf16_t*)(P.ws + WS_SWV) + ((size_t)(b * 2 + kvh) * SEQ) * 64;
            const float q = bf2f(Q[(size_t)s * 64 + lane]);
            const int klo = s - 128 < 0 ? 0 : s - 128, khi = s + 128 > SEQ - 1 ? SEQ - 1 : s + 128;
            const float sk = P.swa_sinks[h] * LOG2E;
            m = sk;
            for (int pass = 0; pass < 2; ++pass)
                for (int key = klo; key <= khi; ++key) {
                    const float d = wave_sum(q * bf2f(K[(size_t)key * 64 + lane]));
                    if (pass == 0) m = fmaxf(m, d);
                    else { const float p = exp2f(d - m); sum += p; o += p * bf2f(VT[(size_t)key * 64 + lane]); }
                }
            sum += exp2f(sk - m);
        }
        o /= sum;
        ATT[(size_t)tok * DM + (isw ? 512 : 0) + h * 64 + lane] = (bf16_t)f2bf(o);
        const float sq = wave_sum(o * o);
        if (lane == 0) SSQ[tok * 16 + (isw ? 8 : 0) + h] = sq;
    }
}
#else
typedef short s16x4 __attribute__((ext_vector_type(4)));
#define LAS3 __attribute__((address_space(3)))
DEVINL int k_off(int row, int c) { return row * 128 + ((c ^ ((row >> 1) & 7)) << 4); }
DEVINL int v_off(int row, int c) { return row * 128 + ((((c >> 1) ^ ((row >> 1) & 3)) << 5) | ((c & 1) << 4)); }
DEVINL bf16x8 tr_pair(const LAS3 unsigned char* p0, const LAS3 unsigned char* p1) {
    const s16x4 a = __builtin_amdgcn_ds_read_tr16_b64_v4i16((LAS3 s16x4*)p0), b = __builtin_amdgcn_ds_read_tr16_b64_v4i16((LAS3 s16x4*)p1);
    bf16x8 r; r[0] = a[0]; r[1] = a[1]; r[2] = a[2]; r[3] = a[3]; r[4] = b[0]; r[5] = b[1]; r[6] = b[2]; r[7] = b[3]; return r;
}
DEVINL void phase3(const Params& P, unsigned char* smem_all) {
    const int half = threadIdx.x >> 8, t = threadIdx.x & 255, lane = t & 63, w = t >> 6, lr = lane & 15, g = lane >> 4;
    unsigned char* smem = smem_all + half * LDS_HALF;
    bf16_t* ATT = (bf16_t*)(P.ws + WS_ATT); float* SSQ = (float*)(P.ws + WS_SSQ);
    const LAS3 unsigned char* lsm = (const LAS3 unsigned char*)smem;
    constexpr int N_NA = 2 * 8 * 128, N_SW = 2 * 2 * 512;
    static_assert(N_NA % 2 == 0 && N_SW % 2 == 0, "item pairs must be of one type");
    const int G = gridDim.x, vb = (G % 8 == 0) ? (int)(blockIdx.x % 8) * (G / 8) + (int)(blockIdx.x / 8) : (int)blockIdx.x;
    const int it0 = 2 * vb + half, step = 2 * G;
    if (!SKIPF(1024)) {
        u32x4 kr[16];
#define NA_GEO(it_) const int r = (it_) & 127, h = ((it_) >> 7) & 7, b = (it_) >> 10; int r0 = r - 4; r0 = r0 < 0 ? 0 : (r0 > 120 ? 120 : r0);
#define NA_KLOAD(it_) do { NA_GEO(it_) (void)r; const bf16_t* Kg_ = (const bf16_t*)(P.ws + WS_NAK) + ((size_t)(b * 8 + h) * SEQ + r0 * 64) * 64; \
        const bf16_t* kp_ = Kg_ + (size_t)((t >> 3) * 16) * 64 + (t & 7) * 8; \
        _Pragma("unroll") for (int i = 0; i < 16; ++i) kr[i] = *(const u32x4*)(kp_ + i * 64); } while (0)
        if (it0 < N_NA) NA_KLOAD(it0);
        for (int it = it0; it < N_NA; it += step) {
            NA_GEO(it)
            int lo_ = lane; asm volatile("" : "+v"(lo_));
            const int lr = lo_ & 15, g = lo_ >> 4;
            const int c0 = 16 * w;
            int kc0 = c0 - 8; kc0 = kc0 < 0 ? 0 : (kc0 > 32 ? 32 : kc0);
            const bf16_t* Q = (const bf16_t*)(P.ws + WS_NAQ) + ((size_t)(b * 8 + h) * SEQ) * 64;
            const bf16_t* Vg = (const bf16_t*)(P.ws + WS_NAV) + ((size_t)(b * 8 + h) * SEQ + r0 * 64) * 64;
            __syncthreads();
            float* s_rpb = (float*)(smem + 65536);
            for (int i = t; i < 465; i += 256) s_rpb[i] = P.na_rpb[h * 465 + i] * LOG2E;
            { int to = t; asm volatile("" : "+v"(to));
#pragma unroll
            for (int i = 0; i < 16; ++i) *(u32x4*)(smem + k_off((to >> 3) * 16 + i, to & 7)) = kr[i]; }
            const bf16_t* qp = Q + (size_t)(r * 64 + c0 + lr) * 64 + 8 * g;
            const bf16x8 q0 = *(const bf16x8*)qp, q1 = *(const bf16x8*)(qp + 32);
            __syncthreads();
            const int c = c0 + lr; int cs = c - 8; cs = cs < 0 ? 0 : (cs > 48 ? 48 : cs);
            int dco[8]; bool okm[8];
#pragma unroll
            for (int j = 0; j < 8; ++j) {
                const int kc = kc0 + (j >> 2) * 16 + 4 * g + (j & 3);
                okm[j] = (kc >= cs) && (kc < cs + 16);
                int dc = kc - c + 15; dc = dc < 0 ? 0 : (dc > 30 ? 30 : dc);
                dco[j] = dc;
            }
            const float* rp = s_rpb + (r0 - r + 7) * 31;
            f32x4 sc[16];
            float mx = -3.0e38f;
#pragma unroll
            for (int tt = 0; tt < 16; ++tt) {
                const int row = (tt >> 1) * 64 + kc0 + (tt & 1) * 16 + lr;
                const bf16x8 k0 = *(const bf16x8*)(smem + k_off(row, g)), k1 = *(const bf16x8*)(smem + k_off(row, 4 + g));
                f32x4 a;
#pragma unroll
                for (int e = 0; e < 4; ++e) { const int j = (tt & 1) * 4 + e; a[e] = okm[j] ? rp[(tt >> 1) * 31 + dco[j]] : -3.0e38f; }
                a = __builtin_amdgcn_mfma_f32_16x16x32_bf16(k0, q0, a, 0, 0, 0);
                a = __builtin_amdgcn_mfma_f32_16x16x32_bf16(k1, q1, a, 0, 0, 0);
                sc[tt] = a;
                if ((tt & 3) == 3) asm volatile("" ::: "memory");
            }
            u32x4 vr[16];
            { const bf16_t* vp_ = Vg + (size_t)((t >> 3) * 16) * 64 + (t & 7) * 8;
#pragma unroll
            for (int i = 0; i < 16; ++i) vr[i] = *(const u32x4*)(vp_ + i * 64); }
#pragma unroll
            for (int tt = 0; tt < 16; ++tt) mx = fmaxf(fmaxf(mx, fmaxf(sc[tt][0], sc[tt][1])), fmaxf(sc[tt][2], sc[tt][3]));
            mx = fmaxf(mx, __shfl_xor(mx, 16)); mx = fmaxf(mx, __shfl_xor(mx, 32));
            float sum = 0.f;
            bf16x8 pf[8];
#pragma unroll
            for (int kk = 0; kk < 8; ++kk) {
                float p[8];
#pragma unroll
                for (int e = 0; e < 4; ++e) { p[e] = __builtin_amdgcn_exp2f(sc[2 * kk][e] - mx); p[4 + e] = __builtin_amdgcn_exp2f(sc[2 * kk + 1][e] - mx); }
                sum += ((p[0] + p[1]) + (p[2] + p[3])) + ((p[4] + p[5]) + (p[6] + p[7]));
                union { bf16x8 v; unsigned u[4]; } pk; pk.u[0] = pk2(p[0], p[1]); pk.u[1] = pk2(p[2], p[3]); pk.u[2] = pk2(p[4], p[5]); pk.u[3] = pk2(p[6], p[7]);
                pf[kk] = pk.v;
            }
            sum += __shfl_xor(sum, 16); sum += __shfl_xor(sum, 32);
            __syncthreads();
            { int to = t; asm volatile("" : "+v"(to));
#pragma unroll
            for (int i = 0; i < 16; ++i) *(u32x4*)(smem + v_off((to >> 3) * 16 + i, to & 7)) = vr[i]; }
            asm volatile("" ::: "memory");
            if (it + step < N_NA) NA_KLOAD(it + step);
            __syncthreads();
            f32x4 o[4];
#pragma unroll
            for (int dt = 0; dt < 4; ++dt) o[dt] = (f32x4){0.f, 0.f, 0.f, 0.f};
            const int vrow = kc0 + 4 * g + (lr >> 2), vsw = (vrow >> 1) & 3, vbase = vrow * 128 + (lr & 3) * 8;
#pragma unroll
            for (int kk = 0; kk < 8; ++kk)
#pragma unroll
                for (int dt = 0; dt < 4; ++dt) {
                    const LAS3 unsigned char* ap = lsm + vbase + ((dt ^ vsw) << 5) + kk * 8192;
                    o[dt] = __builtin_amdgcn_mfma_f32_16x16x32_bf16(tr_pair(ap, ap + 2048), pf[kk], o[dt], 0, 0, 0);
                }
            const float inv = 1.f / sum; float sq = 0.f;
            const int tok = b * SEQ + r * 64 + c0 + lr;
#pragma unroll
            for (int dt = 0; dt < 4; dt += 2) {
                const f32x4 v = o[dt] * inv, v2 = o[dt + 1] * inv;
                sq += (v.x * v.x + v.y * v.y + v.z * v.z + v.w * v.w) + (v2.x * v2.x + v2.y * v2.y + v2.z * v2.z + v2.w * v2.w);
                u32x2 oa, ob; oa.x = pk2(v.x, v.y); oa.y = pk2(v.z, v.w); ob.x = pk2(v2.x, v2.y); ob.y = pk2(v2.z, v2.w);
                store_pair16(ATT + (size_t)tok * DM + h * 64, oa, ob, dt, dt + 1, g, true);
            }
            sq += __shfl_xor(sq, 16); sq += __shfl_xor(sq, 32);
            if (g == 0) SSQ[tok * 16 + h] = sq;
        }
#undef NA_GEO
#undef NA_KLOAD
    }
    if (!SKIPF(2048)) {
        u32x4 kr[9], vr[9];
#define SW_LOAD(r_) do { const int qt_ = (r_) & 511, kvh_ = ((r_) >> 9) & 1, b_ = (r_) >> 10, kb_ = qt_ * 16 - 128; \
        const bf16_t* Kg_ = (const bf16_t*)(P.ws + WS_SWK) + ((size_t)(b_ * 2 + kvh_) * SEQ) * 64; const bf16_t* Vg_ = (const bf16_t*)(P.ws + WS_SWV) + ((size_t)(b_ * 2 + kvh_) * SEQ) * 64; \
        _Pragma("unroll") for (int i = 0; i < 9; ++i) { const int q = t + 256 * i; int tokk = kb_ + (q >> 3); tokk = tokk < 0 ? 0 : (tokk > SEQ - 1 ? SEQ - 1 : tokk); \
            kr[i] = *(const u32x4*)(Kg_ + (size_t)tokk * 64 + (q & 7) * 8); vr[i] = *(const u32x4*)(Vg_ + (size_t)tokk * 64 + (q & 7) * 8); } } while (0)
        int rfirst = it0; while (rfirst < N_NA) rfirst += step;  rfirst -= N_NA;
        if (rfirst < N_SW) SW_LOAD(rfirst);
        for (int r = rfirst; r < N_SW; r += step) {
            int lo_ = lane; asm volatile("" : "+v"(lo_));
            const int lr = lo_ & 15, g = lo_ >> 4;
            const int qt = r & 511, kvh = (r >> 9) & 1, b = r >> 10;
            const int hq = kvh * 4 + w, q0p = qt * 16, kb = q0p - 128;
            const bf16_t* Q = (const bf16_t*)(P.ws + WS_SWQ) + ((size_t)(b * 8 + hq) * SEQ) * 64;
            __syncthreads();
            { int to = t; asm volatile("" : "+v"(to));
#pragma unroll
            for (int i = 0; i < 9; ++i) { const int q = to + 256 * i; *(u32x4*)(smem + k_off(q >> 3, q & 7)) = kr[i]; *(u32x4*)(smem + 36864 + v_off(q >> 3, q & 7)) = vr[i]; } }
            const bf16_t* qp = Q + (size_t)(q0p + lr) * 64 + 8 * g;
            const bf16x8 q0 = *(const bf16x8*)qp, q1 = *(const bf16x8*)(qp + 32);
            const float sk = P.swa_sinks[hq] * LOG2E;
            __syncthreads();
            f32x4 sc[18];
            float mx = sk;
#pragma unroll
            for (int tt = 0; tt < 18; ++tt) {
                const int kt0 = kb + 16 * tt;
                const bool tile_ok = (tt < 17) && (kt0 >= 0) && (kt0 < SEQ);
                f32x4 a;
#pragma unroll
                for (int e = 0; e < 4; ++e) { const int dlt = 16 * tt + 4 * g + e - lr;
                    a[e] = (tile_ok && dlt >= 0 && dlt <= 256) ? 0.f : -3.0e38f; }
                if (tt < 17) {
                    const int row = 16 * tt + lr;
                    const bf16x8 k0 = *(const bf16x8*)(smem + k_off(row, g)), k1 = *(const bf16x8*)(smem + k_off(row, 4 + g));
                    a = __builtin_amdgcn_mfma_f32_16x16x32_bf16(k0, q0, a, 0, 0, 0);
                    a = __builtin_amdgcn_mfma_f32_16x16x32_bf16(k1, q1, a, 0, 0, 0);
                }
                sc[tt] = a;
                mx = fmaxf(fmaxf(mx, fmaxf(a[0], a[1])), fmaxf(a[2], a[3]));
            }
            mx = fmaxf(mx, __shfl_xor(mx, 16)); mx = fmaxf(mx, __shfl_xor(mx, 32));
            float sum = 0.f;
            bf16x8 pf[9];
#pragma unroll
            for (int kk = 0; kk < 9; ++kk) {
                float p[8];
#pragma unroll
                for (int e = 0; e < 4; ++e) { p[e] = __builtin_amdgcn_exp2f(sc[2 * kk][e] - mx); p[4 + e] = __builtin_amdgcn_exp2f(sc[2 * kk + 1][e] - mx); }
                sum += ((p[0] + p[1]) + (p[2] + p[3])) + ((p[4] + p[5]) + (p[6] + p[7]));
                union { bf16x8 v; unsigned u[4]; } pk; pk.u[0] = pk2(p[0], p[1]); pk.u[1] = pk2(p[2], p[3]); pk.u[2] = pk2(p[4], p[5]); pk.u[3] = pk2(p[6], p[7]);
                pf[kk] = pk.v;
            }
            sum += __shfl_xor(sum, 16); sum += __shfl_xor(sum, 32);
            sum += __builtin_amdgcn_exp2f(sk - mx);
            asm volatile("" ::: "memory");
            if (r + step < N_SW) SW_LOAD(r + step);
            f32x4 o[4];
#pragma unroll
            for (int dt = 0; dt < 4; ++dt) o[dt] = (f32x4){0.f, 0.f, 0.f, 0.f};
            const int vrow = 4 * g + (lr >> 2), vsw = (vrow >> 1) & 3, vbase = 36864 + vrow * 128 + (lr & 3) * 8;
#pragma unroll
            for (int kk = 0; kk < 9; ++kk)
#pragma unroll
                for (int dt = 0; dt < 4; ++dt) {
                    const LAS3 unsigned char* ap = lsm + vbase + ((dt ^ vsw) << 5) + kk * 4096;
                    o[dt] = __builtin_amdgcn_mfma_f32_16x16x32_bf16(tr_pair(ap, ap + 2048), pf[kk], o[dt], 0, 0, 0);
                }
            const float inv = 1.f / sum; float sq = 0.f;
            const int tok = b * SEQ + q0p + lr;
#pragma unroll
            for (int dt = 0; dt < 4; dt += 2) {
                const f32x4 v = o[dt] * inv, v2 = o[dt + 1] * inv;
                sq += (v.x * v.x + v.y * v.y + v.z * v.z + v.w * v.w) + (v2.x * v2.x + v2.y * v2.y + v2.z * v2.z + v2.w * v2.w);
                u32x2 oa, ob; oa.x = pk2(v.x, v.y); oa.y = pk2(v.z, v.w); ob.x = pk2(v2.x, v2.y); ob.y = pk2(v2.z, v2.w);
                store_pair16(ATT + (size_t)tok * DM + 512 + hq * 64, oa, ob, dt, dt + 1, g, true);
            }
            sq += __shfl_xor(sq, 16); sq += __shfl_xor(sq, 32);
            if (g == 0) SSQ[tok * 16 + 8 + hq] = sq;
        }
#undef SW_LOAD
    }
}
#endif

DEVINL void phase4(const Params& P, unsigned char* smem) {
    const int t = threadIdx.x, wv = __builtin_amdgcn_readfirstlane(t >> 6);
    const bf16_t* ATT = (const bf16_t*)(P.ws + WS_ATT); const float* SSQ = (const float*)(P.ws + WS_SSQ);
    const bf16_t* WrF = (const bf16_t*)(P.ws + WS_WRF);
    const float* mod = (const float*)(P.ws + WS_MOD);
    unsigned char* H2 = P.ws + WS_H;
    bf16_t* X1B = (bf16_t*)(P.ws + WS_X1B);
    unsigned* cnt = (unsigned*)(P.ws + WS_CNT); int* ltok = (int*)(P.ws + WS_LTOK); float* lw = (float*)(P.ws + WS_LW);
    float* s_part = (float*)(smem + 131072);
    float* s_lg = (float*)smem;
    for (int tile = blockIdx.x; tile < NT / 64; tile += gridDim.x) {
        const int m0 = tile * 64;
        int lane = t & 63;
        asm volatile("" : "+v"(lane));
        const int lr = lane & 15, g = lane >> 4;
        __syncthreads();
        {
            const int row = t >> 3;
            const float* sp = SSQ + (size_t)(m0 + row) * 16;
            const f32x4 a = *(const f32x4*)sp, b2 = *(const f32x4*)(sp + 4), c2 = *(const f32x4*)(sp + 8), d2 = *(const f32x4*)(sp + 12);
            const float rna = rsqrtf((a.x + a.y + a.z + a.w + b2.x + b2.y + b2.z + b2.w) * (1.f / 512.f) + EPS);
            const float rsw = rsqrtf((c2.x + c2.y + c2.z + c2.w + d2.x + d2.y + d2.z + d2.w) * (1.f / 512.f) + EPS);
            const bf16_t* src = ATT + (size_t)(m0 + row) * DM;
#pragma unroll 4
            for (int i = 0; i < 16; ++i) {
                const int c = (t & 7) + 8 * i;
                u32x4 v = *(const u32x4*)(src + c * 8);
                const float sc = (c < 64) ? rna : rsw;
                v.x = pk2(bflo(v.x) * sc, bfhi(v.x) * sc); v.y = pk2(bflo(v.y) * sc, bfhi(v.y) * sc);
                v.z = pk2(bflo(v.z) * sc, bfhi(v.z) * sc); v.w = pk2(bflo(v.w) * sc, bfhi(v.w) * sc);
                *(u32x4*)(smem + row * 2048 + ((c ^ (row & 15)) << 4)) = v;
            }
        }
        __syncthreads();
        f32x4 acc[8][4];
#pragma unroll
        for (int i = 0; i < 8; ++i)
#pragma unroll
            for (int mi = 0; mi < 4; ++mi) acc[i][mi] = (f32x4){0.f, 0.f, 0.f, 0.f};
        if (!SKIPF(32)) {
            const unsigned char* wb = (const unsigned char*)(P.ws + WS_WOF) + (size_t)(8 * wv) * 1024;
            unsigned voff = (unsigned)(lane * 16);
            asm volatile("" : "+v"(voff));
            const int aoff = lr * 2048;
#define AFRAG(mi_, ks_) (*(const bf16x8*)(smem + aoff + (mi_) * 32768 + (((4 * (ks_) + g) ^ lr) << 4)))
            bf16x8 b0[8], b1[8];
#define LOADB(dst, ks_) do { const unsigned char* ub_ = wb + (size_t)((ks_) * 64) * 1024; \
        _Pragma("unroll") for (int j_ = 0; j_ < 8; ++j_) dst[j_] = *(const bf16x8*)(ub_ + j_ * 1024 + voff); } while (0)
#define LOADA(fd, ks_) do { _Pragma("unroll") for (int mi_ = 0; mi_ < 4; ++mi_) fd[mi_] = AFRAG(mi_, ks_); } while (0)
#define MMA(src, fs, ksn_) do { _Pragma("unroll") for (int mi_ = 0; mi_ < 4; ++mi_) { \
        _Pragma("unroll") for (int j_ = 0; j_ < 8; ++j_) acc[j_][mi_] = __builtin_amdgcn_mfma_f32_16x16x32_bf16(src[j_], fs[mi_], acc[j_][mi_], 0, 0, 0); \
        fs[mi_] = AFRAG(mi_, (ksn_) < 32 ? (ksn_) : 31); } } while (0)
            bf16x8 fa[4];
            LOADB(b0, 0); LOADA(fa, 0);
#pragma unroll 1
            for (int ks = 0; ks < 32; ks += 2) {
                LOADB(b1, ks + 1);
                MMA(b0, fa, ks + 1);
                if (ks + 2 < 32) LOADB(b0, ks + 2);
                MMA(b1, fa, ks + 2);
            }
#undef LOADB
#undef MMA
#undef LOADA
#undef AFRAG
        }
        float ss[4];
#pragma unroll
        for (int mi = 0; mi < 4; ++mi) {
            float q = 0.f;
#pragma unroll
            for (int nt = 0; nt < 8; ++nt) { const f32x4 a = acc[nt][mi]; q += a.x * a.x + a.y * a.y + a.z * a.z + a.w * a.w; }
            q += __shfl_xor(q, 16); q += __shfl_xor(q, 32); ss[mi] = q;
        }
        if (g == 0) {
#pragma unroll
            for (int mi = 0; mi < 4; ++mi) s_part[wv * 64 + 16 * mi + lr] = ss[mi];
        }
        __syncthreads();
        float rs_[4];
#pragma unroll
        for (int mi = 0; mi < 4; ++mi) { float q = 0.f;
#pragma unroll
            for (int w2 = 0; w2 < 8; ++w2) q += s_part[w2 * 64 + 16 * mi + lr];
            rs_[mi] = rsqrtf(q * (1.f / DM) + EPS); }
        if (SKIPF(64)) continue;
        const float* mb = mod + (m0 >> 13) * 6144;
        f32x4 lg[3][4];
#pragma unroll
        for (int i = 0; i < 3; ++i)
#pragma unroll
            for (int mi = 0; mi < 4; ++mi) lg[i][mi] = (f32x4){0.f, 0.f, 0.f, 0.f};
        f32x4* xl = (f32x4*)smem + t;
        const bf16_t* wr = WrF + ((size_t)(wv * 4) * 3 * 64 + lane) * 8;
#pragma unroll
        for (int hf = 0; hf < 2; ++hf) {
            float q1[2] = {0.f, 0.f};
            if (!SKIPF(4096))
#pragma unroll
            for (int np = 0; np < 4; ++np) {
                u32x2 pk_[2][2];
#pragma unroll
                for (int q = 0; q < 2; ++q) {
                    const int nt = 2 * np + q, col = 128 * wv + 16 * nt + 4 * g;
                    const f32x4 gp = *(const f32x4*)(P.g_post_mix + col), ga = *(const f32x4*)(mb + 2048 + col);
#pragma unroll
                    for (int mi2 = 0; mi2 < 2; ++mi2) {
                        const int mi = 2 * hf + mi2;
                        const f32x4 r0 = *(const f32x4*)(P.x + (size_t)(m0 + 16 * mi + lr) * DM + col) + ga * (acc[nt][mi] * rs_[mi] * gp);
                        xl[(nt * 2 + mi2) * 512] = r0;
                        pk_[q][mi2].x = pk2(r0.x, r0.y); pk_[q][mi2].y = pk2(r0.z, r0.w);
                        q1[mi2] += r0.x * r0.x + r0.y * r0.y + r0.z * r0.z + r0.w * r0.w;
                    }
                }
#pragma unroll
                for (int mi2 = 0; mi2 < 2; ++mi2)
                    store_pair16(X1B + (size_t)(m0 + 16 * (2 * hf + mi2) + lr) * DM + 128 * wv, pk_[0][mi2], pk_[1][mi2], 2 * np, 2 * np + 1, g, true);
                asm volatile("" ::: "memory");
            }
#pragma unroll
            for (int mi2 = 0; mi2 < 2; ++mi2) { q1[mi2] += __shfl_xor(q1[mi2], 16); q1[mi2] += __shfl_xor(q1[mi2], 32); }
            if (g == 0) {
#pragma unroll
                for (int mi2 = 0; mi2 < 2; ++mi2) s_part[512 + wv * 64 + 16 * (2 * hf + mi2) + lr] = q1[mi2];
            }
            __syncthreads();
            if (SKIPF(8192)) continue;
            float rt2[2];
#pragma unroll
            for (int mi2 = 0; mi2 < 2; ++mi2) { float q = 0.f;
#pragma unroll
                for (int w2 = 0; w2 < 8; ++w2) q += s_part[512 + w2 * 64 + 16 * (2 * hf + mi2) + lr];
                rt2[mi2] = rsqrtf(q * (1.f / DM) + EPS); }
#pragma unroll 1
            for (int p = 0; p < 4; ++p) {
                union { bf16x8 v; unsigned u[4]; } hh[2], hl[2];
                unsigned h8[2][2];
#pragma unroll
                for (int q = 0; q < 2; ++q) {
                    const int nt = 2 * p + q, col = 128 * wv + 16 * nt + 4 * g;
                    const f32x4 gpf = *(const f32x4*)(P.g_pre_ffn + col), sc = *(const f32x4*)(mb + 4096 + col), sh = *(const f32x4*)(mb + 3072 + col);
                    const f32x4 mul = gpf * (sc + 1.f);
#pragma unroll
                    for (int mi2 = 0; mi2 < 2; ++mi2) {
                        const f32x4 h = xl[(nt * 2 + mi2) * 512] * rt2[mi2] * mul + sh;
                        const unsigned u01 = pk2(h.x, h.y), u23 = pk2(h.z, h.w);
                        hh[mi2].u[2 * q] = u01; hh[mi2].u[2 * q + 1] = u23;
                        hl[mi2].u[2 * q] = pk2(h.x - bflo(u01), h.y - bfhi(u01));
                        hl[mi2].u[2 * q + 1] = pk2(h.z - bflo(u23), h.w - bfhi(u23));
                        h8[q][mi2] = pk4_fp8(h.x, h.y, h.z, h.w);
                    }
                }
#pragma unroll
                for (int mi2 = 0; mi2 < 2; ++mi2) {
                    const auto rr = __builtin_amdgcn_permlane16_swap(h8[0][mi2], h8[1][mi2], false, false);
                    u32x2 ov; ov.x = rr[0]; ov.y = rr[1];
                    *(u32x2*)(H2 + (size_t)(m0 + 16 * (2 * hf + mi2) + lr) * DM + 128 * wv + 16 * (2 * p + (g & 1)) + 8 * (g >> 1)) = ov;
                }
#pragma unroll
                for (int ot = 0; ot < 3; ++ot) {
                    const bf16x8 whi = *(const bf16x8*)(wr + (size_t)(p * 3 + ot) * 512);
                    const bf16x8 wlo = *(const bf16x8*)(wr + (size_t)(4 * 8 * 3 * 64) * 8 + (size_t)(p * 3 + ot) * 512);
#pragma unroll
                    for (int mi2 = 0; mi2 < 2; ++mi2) {
                        f32x4 a = lg[ot][2 * hf + mi2];
                        a = __builtin_amdgcn_mfma_f32_16x16x32_bf16(whi, hh[mi2].v, a, 0, 0, 0);
                        a = __builtin_amdgcn_mfma_f32_16x16x32_bf16(whi, hl[mi2].v, a, 0, 0, 0);
                        a = __builtin_amdgcn_mfma_f32_16x16x32_bf16(wlo, hh[mi2].v, a, 0, 0, 0);
                        lg[ot][2 * hf + mi2] = a;
                    }
                }
                asm volatile("" ::: "memory");
            }
        }
        __syncthreads();
#pragma unroll
        for (int ot = 0; ot < 3; ++ot)
#pragma unroll
            for (int mi = 0; mi < 4; ++mi)
#pragma unroll
                for (int e = 0; e < 4; ++e) s_lg[(wv * 48 + 16 * ot + 4 * g + e) * 64 + 16 * mi + lr] = lg[ot][mi][e];
        __syncthreads();
        if (t < 64 && !(P.flags & 1)) {
            const int row = m0 + t;
#define LG(o) (((s_lg[(o) * 64 + t] + s_lg[(48 + (o)) * 64 + t]) + (s_lg[(96 + (o)) * 64 + t] + s_lg[(144 + (o)) * 64 + t])) + \
               ((s_lg[(192 + (o)) * 64 + t] + s_lg[(240 + (o)) * 64 + t]) + (s_lg[(288 + (o)) * 64 + t] + s_lg[(336 + (o)) * 64 + t])))
            const float g0 = LG(0), g1 = LG(1), g2 = LG(2), g3 = LG(3);
            int gtop = 0; float gm = g0;
            if (g1 > gm) { gm = g1; gtop = 1; } if (g2 > gm) { gm = g2; gtop = 2; } if (g3 > gm) { gm = g3; gtop = 3; }
            const float gwt = 1.f / (expf(g0 - gm) + expf(g1 - gm) + expf(g2 - gm) + expf(g3 - gm));
            int i1 = 0, i2 = 0; float v1 = -3.0e38f, v2 = -3.0e38f;
            for (int e = 0; e < 8; ++e) {
                const float v = LG(4 + gtop * 8 + e);
                if (v > v1) { v2 = v1; i2 = i1; v1 = v; i1 = e; } else if (v > v2) { v2 = v; i2 = e; }
            }
#undef LG
            const float ex = expf(v2 - v1), w1 = gwt / (1.f + ex), w2 = gwt * ex / (1.f + ex);
            const int ea1 = gtop * 8 + i1, ea2 = gtop * 8 + i2;
            unsigned* s_cnt = (unsigned*)(smem + LDS_MISC);
            if (t < 32) s_cnt[t] = 0u;
            asm volatile("s_waitcnt lgkmcnt(0)" ::: "memory");
            const unsigned l1 = atomicAdd(&s_cnt[ea1], 1u), l2 = atomicAdd(&s_cnt[ea2], 1u);
            asm volatile("s_waitcnt lgkmcnt(0)" ::: "memory");
            if (t < 32) { const unsigned c = s_cnt[t]; s_cnt[32 + t] = c ? atomicAdd(&cnt[t * CNT_STRIDE], c) : 0u; }
            asm volatile("s_waitcnt vmcnt(0) lgkmcnt(0)" ::: "memory");
            const unsigned p1 = s_cnt[32 + ea1] + l1, p2 = s_cnt[32 + ea2] + l2;
            ltok[ea1 * NT + p1] = row * 2;     lw[ea1 * NT + p1] = w1;
            ltok[ea2 * NT + p2] = row * 2 + 1; lw[ea2 * NT + p2] = w2;
        }
    }
}

DEVINL void phase5(const Params& P, unsigned char* smem) {
    const int t = threadIdx.x, wv = __builtin_amdgcn_readfirstlane(t >> 6);
    const unsigned char* H2 = P.ws + WS_H;
    const unsigned* cnt = (const unsigned*)(P.ws + WS_CNT); const int* ltok = (const int*)(P.ws + WS_LTOK); const float* lw = (const float*)(P.ws + WS_LW);
    unsigned char* Y = P.ws + WS_Y;
    unsigned char* hsm = smem + 81920;
    int* s_cv = (int*)(smem + LDS_MISC + 512);
    if (t < 32) s_cv[t] = (int)cnt[t * CNT_STRIDE];
    __syncthreads();
    if (t == 0) { int acc_ = 0; for (int e = 0; e < 32; ++e) { const int n = (s_cv[e] + 79) / 80; s_cv[32 + e] = acc_; acc_ += n > 16 ? n : 16; } s_cv[64] = acc_; }
    __syncthreads();
    const int total = s_cv[64];
    const int G = gridDim.x, vb = (G % 8 == 0) ? (int)(blockIdx.x % 8) * (G / 8) + (int)(blockIdx.x / 8) : (int)blockIdx.x;
    const int per = (total + G - 1) / G;
    for (int it = vb * per; it < (vb + 1) * per && it < total; ++it) {
        int e = 0;
#pragma unroll
        for (int st = 16; st >= 1; st >>= 1) if (s_cv[32 + e + st] <= it) e += st;
        const int mt = it - s_cv[32 + e], ce = s_cv[e], ntl = s_cv[32 + e + 1] - s_cv[32 + e], rpt = (ce + ntl - 1) / ntl;
        const int rbeg = mt * rpt, rend = (rbeg + rpt < ce) ? rbeg + rpt : ce;
        int lane = t & 63;
        asm volatile("" : "+v"(lane));
        const int lr = lane & 15, g = lane >> 4;
        unsigned voff = (unsigned)(lane * 8);
        asm volatile("" : "+v"(voff));
        long b0[4], b1[4], b2[4], b3[4];
        const unsigned char* wb1 = P.ws + WS_WGUF + (size_t)e * (32 * 32 * 512) + (size_t)(4 * wv) * 512;
#define LOADB(dst, ks_) do { const unsigned char* ub_ = wb1 + (size_t)((ks_) * 32) * 512; \
        _Pragma("unroll") for (int j_ = 0; j_ < 4; ++j_) dst[j_] = *(const long*)(ub_ + j_ * 512 + voff); } while (0)
        LOADB(b0, 0); LOADB(b1, 1); LOADB(b2, 2);
        __syncthreads();
        REP(P5_RG) {
            asm volatile("" ::: "memory");
#pragma unroll
            for (int rp = 0; rp < 2; ++rp) {
                const int row = (t >> 3) + 64 * rp, r = rbeg + row;
                if (row < 80) {
                    const int tok = (r < rend && !SKIPF(4)) ? (ltok[e * NT + r] >> 1) : 0;
                    const unsigned char* src = H2 + (size_t)tok * DM;
#pragma unroll
                    for (int i = 0; i < 8; ++i) { const int c = (t & 7) + 8 * i; *(u32x4*)(smem + row * 1024 + ((c ^ (row & 15)) << 4)) = *(const u32x4*)(src + c * 16); }
                }
            }
        }
        __syncthreads();
        {
            f32x4 acc[4][5];
            REP(P5_RK1) {
#pragma unroll
            for (int i = 0; i < 4; ++i)
#pragma unroll
                for (int mi = 0; mi < 5; ++mi) acc[i][mi] = (f32x4){0.f, 0.f, 0.f, 0.f};
            const int aoff = lr * 1024;
#define AFRAG(mi_, ks_) (*(const long*)(smem + aoff + (mi_) * 16384 + (((4 * (ks_) + g) ^ (lr << 1)) << 3)))
#define LOADA(fd, ks_) do { _Pragma("unroll") for (int mi_ = 0; mi_ < 5; ++mi_) fd[mi_] = AFRAG(mi_, ks_); } while (0)
#define MMA(src, fs, ksn_) do { _Pragma("unroll") for (int mi_ = 0; mi_ < 5; ++mi_) { \
        _Pragma("unroll") for (int j_ = 0; j_ < 4; ++j_) acc[j_][mi_] = __builtin_amdgcn_mfma_f32_16x16x32_fp8_fp8(src[j_], fs[mi_], acc[j_][mi_], 0, 0, 0); \
        fs[mi_] = AFRAG(mi_, (ksn_) < 32 ? (ksn_) : 31); } } while (0)
            long fa[5];
            if (rep_ > 0) { LOADB(b0, 0); LOADB(b1, 1); LOADB(b2, 2); }
            LOADA(fa, 0);
#pragma unroll 1
            for (int ks = SKIPF(8) ? 32 : 0; ks < 32; ks += 4) {
                LOADB(b3, ks + 3);
                MMA(b0, fa, ks + 1);
                if (ks + 4 < 32) LOADB(b0, ks + 4);
                MMA(b1, fa, ks + 2);
                if (ks + 5 < 32) LOADB(b1, ks + 5);
                MMA(b2, fa, ks + 3);
                if (ks + 6 < 32) LOADB(b2, ks + 6);
                MMA(b3, fa, ks + 4);
            }
#undef LOADB
#undef MMA
#undef LOADA
#undef AFRAG
#if P5_RK1 > 1
#pragma unroll
            for (int i = 0; i < 4; ++i) asm volatile("" : "+v"(acc[i][0]), "+v"(acc[i][1]), "+v"(acc[i][2]), "+v"(acc[i][3]), "+v"(acc[i][4]));
#endif
            }
#pragma unroll
            for (int p = 0; p < 2; ++p)
#pragma unroll
                for (int mi = 0; mi < 5; ++mi) {
                    const f32x4 gt = acc[2 * p][mi] * (1.f / 32.f), up = acc[2 * p + 1][mi] * (8.f / 32.f);
                    const unsigned o = pk4_fp8(gt.x / (1.f + __expf(-gt.x)) * up.x, gt.y / (1.f + __expf(-gt.y)) * up.y, gt.z / (1.f + __expf(-gt.z)) * up.z, gt.w / (1.f + __expf(-gt.w)) * up.w);
                    const int row = 16 * mi + lr, c8 = 4 * wv + 2 * p + (g >> 1);
                    *(unsigned*)(hsm + row * 256 + ((c8 ^ ((row & 15) << 1)) << 3) + (g & 1) * 4) = o;
                }
        }
        __syncthreads();
        {
            f32x4 acc[8][5];
            REP(P5_RK2) {
#pragma unroll
            for (int i = 0; i < 8; ++i)
#pragma unroll
                for (int mi = 0; mi < 5; ++mi) acc[i][mi] = (f32x4){0.f, 0.f, 0.f, 0.f};
            const unsigned char* wb = P.ws + WS_WDF + (size_t)e * (8 * 64 * 512) + (size_t)(8 * wv) * 512;
            const int aoff = lr * 256;
#define AFRAG(mi_, ks_) (*(const long*)(hsm + aoff + (mi_) * 4096 + (((4 * (ks_) + g) ^ (lr << 1)) << 3)))
            long b0[8], b1[8];
#define LOADB(dst, ks_) do { const unsigned char* ub_ = wb + (size_t)((ks_) * 64) * 512; \
        _Pragma("unroll") for (int j_ = 0; j_ < 8; ++j_) dst[j_] = *(const long*)(ub_ + j_ * 512 + voff); } while (0)
#define LOADA(fd, ks_) do { _Pragma("unroll") for (int mi_ = 0; mi_ < 5; ++mi_) fd[mi_] = AFRAG(mi_, ks_); } while (0)
#define MMA(src, fs, ksn_) do { _Pragma("unroll") for (int mi_ = 0; mi_ < 5; ++mi_) { \
        _Pragma("unroll") for (int j_ = 0; j_ < 8; ++j_) acc[j_][mi_] = __builtin_amdgcn_mfma_f32_16x16x32_fp8_fp8(src[j_], fs[mi_], acc[j_][mi_], 0, 0, 0); \
        fs[mi_] = AFRAG(mi_, (ksn_) < 8 ? (ksn_) : 7); } } while (0)
            long fa[5];
            LOADB(b0, 0); LOADA(fa, 0);
#pragma unroll 1
            for (int ks = SKIPF(16) ? 8 : 0; ks < 8; ks += 2) {
                LOADB(b1, ks + 1);
                MMA(b0, fa, ks + 1);
                if (ks + 2 < 8) LOADB(b0, ks + 2);
                MMA(b1, fa, ks + 2);
            }
#undef LOADB
#undef MMA
#undef LOADA
#undef AFRAG
#if P5_RK2 > 1
#pragma unroll
            for (int i = 0; i < 8; ++i) asm volatile("" : "+v"(acc[i][0]), "+v"(acc[i][1]), "+v"(acc[i][2]), "+v"(acc[i][3]), "+v"(acc[i][4]));
#endif
            }
            int l2 = lane;
            asm volatile("" : "+v"(l2));
            const int lr2 = l2 & 15, g2 = l2 >> 4;
            REP(P5_RE2)
#pragma unroll
            for (int mi = 0; mi < 5; ++mi) {
                asm volatile("" ::: "memory");
                const int r = rbeg + 16 * mi + lr2;
                const bool ok = r < rend && !SKIPF(2);
                const int ent = ok ? ltok[e * NT + r] : 0; const float wt = ok ? lw[e * NT + r] * (1.f / 128.f) : 0.f;
                unsigned char* yp = Y + ((size_t)(ent & 1) * NT + (ent >> 1)) * DM + 128 * wv;
#pragma unroll
                for (int nt = 0; nt < 8; nt += 2) {
                    const f32x4 v = acc[nt][mi] * wt, v2 = acc[nt + 1][mi] * wt;
                    const auto rr = __builtin_amdgcn_permlane16_swap(pk4_fp8(v.x, v.y, v.z, v.w), pk4_fp8(v2.x, v2.y, v2.z, v2.w), false, false);
                    u32x2 ov; ov.x = rr[0]; ov.y = rr[1];
                    if (ok) *(u32x2*)(yp + 16 * (nt + (g2 & 1)) + 8 * (g2 >> 1)) = ov;
                }
            }
        }
    }
}

DEVINL void phase6(const Params& P) {
    const int lane = threadIdx.x & 63, gw = blockIdx.x * 8 + (threadIdx.x >> 6), ngw = gridDim.x * 8;
    const float* mod = (const float*)(P.ws + WS_MOD);
    const unsigned char* Y = P.ws + WS_Y; const bf16_t* X1B = (const bf16_t*)(P.ws + WS_X1B);
    float* dst = (P.flags & 1) ? (float*)(P.ws + 155 * MiB) : P.out;
    f32x4 gp[4];
#pragma unroll
    for (int j = 0; j < 4; ++j) gp[j] = *(const f32x4*)(P.g_post_ffn + 4 * lane + 256 * j);
    for (int row0 = gw * 2; row0 < NT; row0 += ngw * 2) {
        const float* mb = mod + (row0 >> 13) * 6144;
        unsigned ya[2][4], yb[2][4]; u32x2 x1[2][4];
#pragma unroll
        for (int r = 0; r < 2; ++r)
#pragma unroll
            for (int j = 0; j < 4; ++j) {
                const size_t o = (size_t)(row0 + r) * DM + 4 * lane + 256 * j;
                ya[r][j] = *(const unsigned*)(Y + o); yb[r][j] = *(const unsigned*)(Y + (size_t)NT * DM + o); x1[r][j] = *(const u32x2*)(X1B + o);
            }
#pragma unroll
        for (int r = 0; r < 2; ++r) {
            f32x4 y[4]; float ss = 0.f;
#pragma unroll
            for (int j = 0; j < 4; ++j) {
                const f32x2 a0 = __builtin_amdgcn_cvt_pk_f32_fp8((int)ya[r][j], false), a1 = __builtin_amdgcn_cvt_pk_f32_fp8((int)ya[r][j], true);
                const f32x2 b0 = __builtin_amdgcn_cvt_pk_f32_fp8((int)yb[r][j], false), b1 = __builtin_amdgcn_cvt_pk_f32_fp8((int)yb[r][j], true);
                y[j] = (f32x4){a0.x + b0.x, a0.y + b0.y, a1.x + b1.x, a1.y + b1.y};
                ss += y[j].x * y[j].x + y[j].y * y[j].y + y[j].z * y[j].z + y[j].w * y[j].w;
            }
            ss = wave_sum(ss);
            const float rstd = rsqrtf(ss * (1.f / DM) + EPS);
#pragma unroll
            for (int j = 0; j < 4; ++j) {
                const int col = 4 * lane + 256 * j;
                const f32x4 gf = *(const f32x4*)(mb + 5120 + col);
                const f32x4 xv = {bflo(x1[r][j].x), bfhi(x1[r][j].x), bflo(x1[r][j].y), bfhi(x1[r][j].y)};
                *(f32x4*)(dst + (size_t)(row0 + r) * DM + col) = xv + gf * (y[j] * rstd * gp[j]);
            }
        }
    }
}


#define LAS __attribute__((address_space(3)))
#define XB_TMO      128
#define XB_XCNT(j)  (256  + 64 * (j))
#define XB_XSUB(j)  (1280 + 64 * (j))
#define XB_XGEN(j)  (2304 + 64 * (j))
#define XB_TOP      3328
#define XB_TOPGEN   3392
#define XCD_BAR_WORDS 3456
#define XB_SPIN_CAP (1u << 18)
DEVINL unsigned xb_ld(unsigned* p)              { return __hip_atomic_load(p, __ATOMIC_RELAXED, __HIP_MEMORY_SCOPE_AGENT); }
DEVINL unsigned xb_add(unsigned* p, unsigned v) { return __hip_atomic_fetch_add(p, v, __ATOMIC_RELAXED, __HIP_MEMORY_SCOPE_AGENT); }
DEVINL unsigned xb_xcc_id() { return (unsigned)__builtin_amdgcn_s_getreg((3 << 11) | 20) & 0xFu; }
#define XB_SPIN(cond, bar) do { unsigned _sp = 0; while (cond) { __builtin_amdgcn_s_sleep(1); \
    if ((++_sp & 255u) == 0u) { if (xb_ld(&(bar)[XB_TMO])) break; if (_sp > XB_SPIN_CAP) { atomicAdd(&(bar)[XB_TMO], 1u); break; } } } } while (0)
struct XcdBarrier { unsigned* bar; unsigned x; volatile LAS unsigned* st; };
DEVINL XcdBarrier xcd_barrier_post(unsigned* bar, volatile LAS unsigned* st) {
    XcdBarrier b; b.bar = bar; b.x = xb_xcc_id(); b.st = st;
    if (threadIdx.x == 0) (void)xb_add(&bar[XB_XCNT(b.x)], 1u);
    return b;
}
DEVINL void xcd_barrier_complete(unsigned* bar, unsigned x, unsigned& nloc, unsigned& nx) {
    const unsigned G = gridDim.x * gridDim.y * gridDim.z;
    unsigned sum, cnt, mine, sp = 0u;
    for (;;) {
        sum = 0u; cnt = 0u; mine = 0u;
#pragma unroll
        for (unsigned j = 0; j < 16; ++j) { const unsigned c = xb_ld(&bar[XB_XCNT(j)]); sum += c; cnt += (c > 0u) ? 1u : 0u; mine = (j == x) ? c : mine; }
        if (sum == G) break;
        __builtin_amdgcn_s_sleep(1);
        if ((++sp & 255u) == 0u) { if (xb_ld(&bar[XB_TMO])) break; if (sp > XB_SPIN_CAP) { atomicAdd(&bar[XB_TMO], 1u); break; } }
    }
    nloc = mine > 0u ? mine : 1u; nx = cnt > 0u ? cnt : 1u;
}
DEVINL void xcd_barrier(const XcdBarrier& b) {
    asm volatile("s_waitcnt vmcnt(0)" ::: "memory");
    __syncthreads();
    if (threadIdx.x == 0) {
        unsigned* bar = b.bar;
        __builtin_amdgcn_s_waitcnt(0);
        unsigned nloc = b.st[0], nx = b.st[1];
        if (nloc == 0u) { xcd_barrier_complete(bar, b.x, nloc, nx); b.st[0] = nloc; b.st[1] = nx; }
        const unsigned old = xb_add(&bar[XB_XSUB(b.x)], 1u);
        const unsigned gen = old / nloc;
        if (old + 1u == (gen + 1u) * nloc) {
            __builtin_amdgcn_fence(__ATOMIC_RELEASE, "agent");
            asm volatile("s_waitcnt vmcnt(0)" ::: "memory");
            const unsigned og = xb_add(&bar[XB_TOP], 1u);
            const unsigned tg = og / nx;
            if (og + 1u == (tg + 1u) * nx) xb_add(&bar[XB_TOPGEN], 1u);
            else XB_SPIN(xb_ld(&bar[XB_TOPGEN]) == tg, bar);
            __builtin_amdgcn_fence(__ATOMIC_ACQUIRE, "agent");
            xb_add(&bar[XB_XGEN(b.x)], 1u);
            asm volatile("s_waitcnt vmcnt(0)" ::: "memory");
        } else {
            XB_SPIN(xb_ld(&bar[XB_XGEN(b.x)]) == gen, bar);
            __builtin_amdgcn_fence(__ATOMIC_ACQUIRE, "agent");
            asm volatile("s_waitcnt vmcnt(0)" ::: "memory");
        }
    }
    __syncthreads();
}
constexpr size_t WS_BAR = 16384;
constexpr size_t CTL_ZERO_BYTES = 65536;

constexpr int NPHASE = 6;
__global__ void __launch_bounds__(NTHR, 2) fwd_kernel(Params P) {
    extern __shared__ __attribute__((aligned(16))) unsigned char smem[];
#if N_LAUNCH_MODE == 1
    cg::grid_group grid = cg::this_grid();
#define SEAM(k) do { if (P.ph_lo <= (k) && (k) + 1 < P.ph_hi) grid.sync(); } while (0)
#elif N_LAUNCH_MODE == 2
    volatile LAS unsigned* bst = (volatile LAS unsigned*)(smem + LDS_MISC + 2048);
    if (threadIdx.x < 4) bst[threadIdx.x] = 0u;
    __syncthreads();
    const XcdBarrier xbar = xcd_barrier_post((unsigned*)(P.ws + WS_BAR), bst);
#define SEAM(k) do { if (P.ph_lo <= (k) && (k) + 1 < P.ph_hi) xcd_barrier(xbar); } while (0)
#else
#define SEAM(k) do { } while (0)
#endif
#define IN(k) (P.ph_lo <= (k) && (k) < P.ph_hi)
    if (IN(0)) { phase0(P, smem); }  SEAM(0);
    if (IN(1)) { phase2(P, smem); }  SEAM(1);
    if (IN(2)) { phase3(P, smem); }  SEAM(2);
    if (IN(3)) { phase4(P, smem); }  SEAM(3);
    if (IN(4)) { phase5(P, smem); }  SEAM(4);
    if (IN(5)) { phase6(P); }
#undef IN
#undef SEAM
}

extern "C" void kernel_launch(void* const* d_in, const int* in_sizes, int n_in, void* d_out, int out_size, void* d_ws, size_t ws_size, hipStream_t stream) {
    static int grid_blocks = 0;
    if (!grid_blocks) {
        if (ws_size < WS_END) { fprintf(stderr, "kernel_launch: workspace too small (%zu < %zu)\n", ws_size, (size_t)WS_END); grid_blocks = -1; return; }
        int dev = 0, cus = 0, per_cu = 0;
        hipGetDevice(&dev);
        hipDeviceGetAttribute(&cus, hipDeviceAttributeMultiprocessorCount, dev);
        hipFuncSetAttribute((const void*)fwd_kernel, hipFuncAttributeMaxDynamicSharedMemorySize, LDS_BYTES);
        hipOccupancyMaxActiveBlocksPerMultiprocessor(&per_cu, (const void*)fwd_kernel, NTHR, LDS_BYTES);
        if (per_cu > 1) per_cu = 1;
        if (per_cu < 1) per_cu = 1;
        grid_blocks = cus * per_cu;
        fprintf(stderr, "kernel_launch: %d CUs x %d blocks\n", cus, per_cu);
    }
    if (grid_blocks < 0) return;
    Params p{};
    const float** pp = (const float**)&p;
    for (int i = 0; i < 19; ++i) pp[i] = (const float*)d_in[i];
    p.out = (float*)d_out; p.ws = (unsigned char*)d_ws;
#if N_LAUNCH_MODE == 2
    p.ph_lo = 0; p.ph_hi = NPHASE;
    if (hipMemsetAsync(d_ws, 0, CTL_ZERO_BYTES, stream) != hipSuccess) { fprintf(stderr, "kernel_launch: memset failed\n"); return; }
    hipLaunchKernelGGL(fwd_kernel, dim3(grid_blocks), dim3(NTHR), LDS_BYTES, stream, p);
#elif N_LAUNCH_MODE == 1
    p.ph_lo = 0; p.ph_hi = NPHASE;
    void* args[] = {&p};
    hipError_t e = hipLaunchCooperativeKernel((const void*)fwd_kernel, dim3(grid_blocks), dim3(NTHR), args, LDS_BYTES, stream);
    if (e != hipSuccess) fprintf(stderr, "cooperative launch failed: %s (grid %d)\n", hipGetErrorString(e), grid_blocks);
#else
#ifndef REPEAT_ALL
#define REPEAT_ALL 1
#endif
#ifndef EMPTY_LAUNCHES
#define EMPTY_LAUNCHES 0
#endif
    for (int i = 0; i < EMPTY_LAUNCHES; ++i) { p.ph_lo = 99; p.ph_hi = 99; p.flags = 0; hipLaunchKernelGGL(fwd_kernel, dim3(grid_blocks), dim3(NTHR), LDS_BYTES, stream, p); }
#ifndef SKIP2_MASK
#define SKIP2_MASK 0
#endif
    for (int rep = 0; rep < REPEAT_ALL; ++rep)
    for (int ph = 0; ph < NPHASE; ++ph) {
        if (rep == 1 && (SKIP2_MASK & (1 << ph))) continue;
#ifndef SKIP1_MASK
#define SKIP1_MASK 0
#endif
        if (rep == 0 && REPEAT_ALL == 2 && (SKIP1_MASK & (1 << ph))) continue;
        p.ph_lo = ph; p.ph_hi = ph + 1;
        if (REPEAT_MASK & (1 << ph)) { p.flags = 1; hipLaunchKernelGGL(fwd_kernel, dim3(grid_blocks), dim3(NTHR), LDS_BYTES, stream, p); }
#ifndef PROBE_FLAGS1
#define PROBE_FLAGS1 0
#endif
        p.flags = (REPEAT_ALL == 2 && rep == 0) ? PROBE_FLAGS1 : 0;
        hipLaunchKernelGGL(fwd_kernel, dim3(grid_blocks), dim3(NTHR), LDS_BYTES, stream, p);
    }
#endif
}
```

```cpp
#include <hip/hip_runtime.h>
#include <hip/hip_cooperative_groups.h>
#include <stdint.h>
#include <stdio.h>
namespace cg = cooperative_groups;

#ifndef NAIVE_ATTN
#define NAIVE_ATTN 0
#define EXPERTS_IN_P2 1
#endif
#ifndef REPEAT_MASK
#define REPEAT_MASK 0
#endif
#ifndef P2_RS
#define P2_RS 1
#endif
#ifndef P2_RK
#define P2_RK 1
#endif
#ifndef P2_RE
#define P2_RE 1
#endif
#ifndef P3_RNA
#define P3_RNA 1
#endif
#ifndef P3_RSW
#define P3_RSW 1
#endif
#ifndef P5_RG
#define P5_RG 1
#endif
#ifndef P5_RK1
#define P5_RK1 1
#endif
#ifndef P5_RK2
#define P5_RK2 1
#endif
#ifndef P5_RE2
#define P5_RE2 1
#endif
#define SKIPF(bit) (P.flags & (bit))
#define REP(n) _Pragma("unroll 1") for (int rep_ = 0; rep_ < (n); ++rep_)
#ifndef N_LAUNCH_MODE
#define N_LAUNCH_MODE 2
#endif

#define DEVINL __device__ __forceinline__

typedef unsigned short bf16_t;
typedef short bf16x8 __attribute__((ext_vector_type(8)));
typedef float f32x4 __attribute__((ext_vector_type(4)));
typedef unsigned u32x4 __attribute__((ext_vector_type(4)));
typedef unsigned u32x2 __attribute__((ext_vector_type(2)));

constexpr int SEQ = 8192, DM = 1024, NT = 2 * SEQ;
constexpr int QKVW = 2304;
constexpr float EPS = 1e-6f;
constexpr float LOG2E = 1.4426950408889634f;
constexpr float QSCALE = 0.125f * LOG2E;

constexpr size_t MiB = 1u << 20;
constexpr size_t WS_CNT  = 0;
constexpr int CNT_STRIDE = 64;
constexpr size_t WS_MOD  = 1 * MiB;
constexpr size_t WS_ROPE = 2 * MiB;
constexpr size_t WS_WQF  = 4 * MiB;
constexpr size_t WS_WOF  = 9 * MiB;
constexpr size_t WS_WRF  = 1 * MiB + 512 * 1024;
constexpr size_t WS_WGUF = 11 * MiB;
constexpr size_t WS_WDF  = 27 * MiB;
constexpr size_t WS_H    = 59 * MiB;
constexpr size_t WS_NAQ  = 91 * MiB;
constexpr size_t WS_NAK  = 107 * MiB;
constexpr size_t WS_NAV  = 123 * MiB;
constexpr size_t WS_SWQ  = 139 * MiB;
constexpr size_t WS_SWK  = 155 * MiB;
constexpr size_t WS_SWV  = 159 * MiB;
constexpr size_t WS_ATT  = 163 * MiB;
constexpr size_t WS_SSQ  = 195 * MiB;
constexpr size_t WS_LTOK = 196 * MiB;
constexpr size_t WS_LW   = 198 * MiB;
constexpr size_t WS_Y    = 91 * MiB;
constexpr size_t WS_X1B  = 91 * MiB;
constexpr size_t WS_XB   = 200 * MiB;
constexpr size_t WS_CCNT = 32768;
constexpr size_t WS_CTOK = 232 * MiB;
constexpr size_t WS_CW   = 240 * MiB;
constexpr size_t WS_END  = 254 * MiB;

constexpr int NTHR = 512;
constexpr int LDS_HALF = 73728;
constexpr int LDS_MISC = 147456;
constexpr int LDS_BYTES = LDS_MISC + 4096;

struct Params {
    const float *x, *c, *w_ada, *b_ada, *g_pre_mix, *w_in, *na_rpb, *swa_sinks, *beta_na, *beta_swa, *w_out, *g_post_mix, *g_pre_ffn,
                *w_gr, *w_er, *w_gate, *w_up, *w_down, *g_post_ffn;
    float* out; unsigned char* ws; int ph_lo, ph_hi, flags, pad;
};

DEVINL unsigned f2bf(float f) { unsigned u = __float_as_uint(f); return (u + 0x7fffu + ((u >> 16) & 1u)) >> 16; }
typedef __bf16 bf16v2 __attribute__((ext_vector_type(2)));
typedef float f32x2 __attribute__((ext_vector_type(2)));
DEVINL unsigned pk2(float lo, float hi) { const f32x2 v = {lo, hi}; return __builtin_bit_cast(unsigned, __builtin_convertvector(v, bf16v2)); }
DEVINL void store_pair16(bf16_t* rowbase, u32x2 a, u32x2 b, int fa, int fb, int g, bool pred) {
    const auto rx = __builtin_amdgcn_permlane16_swap(a.x, b.x, false, false);
    const auto ry = __builtin_amdgcn_permlane16_swap(a.y, b.y, false, false);
    u32x4 o; o.x = rx[0]; o.y = ry[0]; o.z = rx[1]; o.w = ry[1];
    if (pred) *(u32x4*)(rowbase + 16 * ((g & 1) ? fb : fa) + 8 * (g >> 1)) = o;
}
DEVINL float bf2f(bf16_t v) { return __uint_as_float(((unsigned)v) << 16); }
DEVINL float bflo(unsigned u) { return __uint_as_float(u << 16); }
DEVINL float bfhi(unsigned u) { return __uint_as_float(u & 0xffff0000u); }
DEVINL float gsum4(float v) {
    const auto a = __builtin_amdgcn_permlane16_swap(__float_as_uint(v), __float_as_uint(v), false, false);
    const float s = __uint_as_float(a[0]) + __uint_as_float(a[1]);
    const auto b = __builtin_amdgcn_permlane32_swap(__float_as_uint(s), __float_as_uint(s), false, false);
    return __uint_as_float(b[0]) + __uint_as_float(b[1]);
}
DEVINL float gmaxf4(float v) {
    const auto a = __builtin_amdgcn_permlane16_swap(__float_as_uint(v), __float_as_uint(v), false, false);
    const float s = fmaxf(__uint_as_float(a[0]), __uint_as_float(a[1]));
    const auto b = __builtin_amdgcn_permlane32_swap(__float_as_uint(s), __float_as_uint(s), false, false);
    return fmaxf(__uint_as_float(b[0]), __uint_as_float(b[1]));
}
DEVINL int gmaxi4(int v) {
    const auto a = __builtin_amdgcn_permlane16_swap((unsigned)v, (unsigned)v, false, false);
    const int s = (int)a[0] > (int)a[1] ? (int)a[0] : (int)a[1];
    const auto b = __builtin_amdgcn_permlane32_swap((unsigned)s, (unsigned)s, false, false);
    return (int)b[0] > (int)b[1] ? (int)b[0] : (int)b[1];
}
DEVINL float dpp_add(float v, const int ctrl_is) {
    switch (ctrl_is) {
        case 0:  return v + __int_as_float(__builtin_amdgcn_update_dpp(0, __float_as_int(v), 0xB1, 0xF, 0xF, true));
        case 1:  return v + __int_as_float(__builtin_amdgcn_update_dpp(0, __float_as_int(v), 0x4E, 0xF, 0xF, true));
        case 2:  return v + __int_as_float(__builtin_amdgcn_update_dpp(0, __float_as_int(v), 0x141, 0xF, 0xF, true));
        default: return v + __int_as_float(__builtin_amdgcn_update_dpp(0, __float_as_int(v), 0x140, 0xF, 0xF, true));
    }
}
DEVINL float wave_sum(float v) {
    v = gsum4(v);
    v = dpp_add(v, 0); v = dpp_add(v, 1); v = dpp_add(v, 2); v = dpp_add(v, 3);
    return v;
}
DEVINL float silu_f(float v) { return v / (1.f + expf(-v)); }

DEVINL void mod_item(const Params& P, int item, unsigned char* smem, const int t) {
    float* s_silu = (float*)smem;
    float* s_red  = s_silu + 2048;
    for (int i = t; i < 2048; i += 256) s_silu[i] = silu_f(P.c[i]);
    __syncthreads();
    const int c4 = t & 7, rg = t >> 3, col = item * 32 + c4 * 4;
    f32x4 a0 = {0.f, 0.f, 0.f, 0.f}, a1 = {0.f, 0.f, 0.f, 0.f};
#pragma unroll 4
    for (int i = 0; i < 32; ++i) {
        const int k = rg + 32 * i;
        const f32x4 w = __builtin_nontemporal_load((const f32x4*)(P.w_ada + (size_t)k * 6144 + col));
        a0 += w * s_silu[k]; a1 += w * s_silu[1024 + k];
    }
    *(f32x4*)(s_red + (rg * 2 + 0) * 32 + c4 * 4) = a0;
    *(f32x4*)(s_red + (rg * 2 + 1) * 32 + c4 * 4) = a1;
    __syncthreads();
    if (t < 64) {
        const int b = t >> 5, cc = t & 31; float s = 0.f;
        for (int r = 0; r < 32; ++r) s += s_red[(r * 2 + b) * 32 + cc];
        ((float*)(P.ws + WS_MOD))[b * 6144 + item * 32 + cc] = s + P.b_ada[item * 32 + cc];
    }
    __syncthreads();
}
DEVINL void mod_item512(const Params& P, int item, unsigned char* smem, const int t) {
    float* s_silu = (float*)smem;
    float* s_red  = s_silu + 2048;
    for (int i = t; i < 2048; i += NTHR) s_silu[i] = silu_f(P.c[i]);
    __syncthreads();
    const int c4 = t & 7, rg = t >> 3, col = item * 32 + c4 * 4;
    f32x4 w[16];
#pragma unroll
    for (int i = 0; i < 16; ++i) w[i] = __builtin_nontemporal_load((const f32x4*)(P.w_ada + (size_t)(rg + 64 * i) * 6144 + col));
    f32x4 a0 = {0.f, 0.f, 0.f, 0.f}, a1 = {0.f, 0.f, 0.f, 0.f};
#pragma unroll
    for (int i = 0; i < 16; ++i) { const int k = rg + 64 * i; a0 += w[i] * s_silu[k]; a1 += w[i] * s_silu[1024 + k]; }
    *(f32x4*)(s_red + (rg * 2 + 0) * 32 + c4 * 4) = a0;
    *(f32x4*)(s_red + (rg * 2 + 1) * 32 + c4 * 4) = a1;
    __syncthreads();
    if (t < 64) {
        const int b = t >> 5, cc = t & 31; float sacc = 0.f;
        for (int r = 0; r < 64; ++r) sacc += s_red[(r * 2 + b) * 32 + cc];
        ((float*)(P.ws + WS_MOD))[b * 6144 + item * 32 + cc] = sacc + P.b_ada[item * 32 + cc];
    }
    __syncthreads();
}
DEVINL void mod_item512_issue(const Params& P, int item, const int t, f32x4 (&w)[16], f32x4& cv) {
    const int c4 = t & 7, rg = t >> 3, col = item * 32 + c4 * 4;
    cv = *(const f32x4*)(P.c + 4 * t);
#pragma unroll
    for (int i = 0; i < 16; ++i) w[i] = __builtin_nontemporal_load((const f32x4*)(P.w_ada + (size_t)(rg + 64 * i) * 6144 + col));
}
DEVINL void mod_item512_finish(const Params& P, int item, unsigned char* smem, const int t, const f32x4 (&w)[16], const f32x4 cv) {
    float* s_silu = (float*)smem;
    float* s_red  = s_silu + 2048;
    *(f32x4*)(s_silu + 4 * t) = (f32x4){silu_f(cv.x), silu_f(cv.y), silu_f(cv.z), silu_f(cv.w)};
    __syncthreads();
    const int c4 = t & 7, rg = t >> 3;
    f32x4 a0 = {0.f, 0.f, 0.f, 0.f}, a1 = {0.f, 0.f, 0.f, 0.f};
#pragma unroll
    for (int i = 0; i < 16; ++i) { const int k = rg + 64 * i; a0 += w[i] * s_silu[k]; a1 += w[i] * s_silu[1024 + k]; }
    *(f32x4*)(s_red + (rg * 2 + 0) * 32 + c4 * 4) = a0;
    *(f32x4*)(s_red + (rg * 2 + 1) * 32 + c4 * 4) = a1;
    __syncthreads();
    if (t < 64) {
        const int b = t >> 5, cc = t & 31; float sacc = 0.f;
        for (int r = 0; r < 64; ++r) sacc += s_red[(r * 2 + b) * 32 + cc];
        ((float*)(P.ws + WS_MOD))[b * 6144 + item * 32 + cc] = sacc + P.b_ada[item * 32 + cc];
    }
    __syncthreads();
}
DEVINL void frag_item(const float* src, int N, int kb, int nb, bf16_t* dst, int NTT, int mode, const float* kscale, unsigned char* smem, const int t) {
    float* scr = (float*)smem;
    const int k0 = kb * 64, n0 = nb * 64;
#pragma unroll
    for (int p = 0; p < 4; ++p) {
        const int r = (t >> 4) + 16 * p;
        f32x4 v = __builtin_nontemporal_load((const f32x4*)(src + (size_t)(k0 + r) * N + n0 + (t & 15) * 4));
        const float sc = kscale ? kscale[r] : 1.f;
        float* d = scr + r * 65 + (t & 15) * 4;
        d[0] = v.x * sc; d[1] = v.y * sc; d[2] = v.z * sc; d[3] = v.w * sc;
    }
    __syncthreads();
    const int lane = t & 63, lr = lane & 15, g = lane >> 4;
#pragma unroll
    for (int i = 0; i < 2; ++i) {
        const int combo = (t >> 6) + 4 * i, ksl = combo >> 2, ntl = combo & 3;
        const float* sp = scr + (32 * ksl + 8 * g) * 65 + 16 * ntl + lr;
        u32x4 o; o.x = pk2(sp[0], sp[65]); o.y = pk2(sp[2 * 65], sp[3 * 65]); o.z = pk2(sp[4 * 65], sp[5 * 65]); o.w = pk2(sp[6 * 65], sp[7 * 65]);
        const int n16 = nb * 4 + ntl, nt = mode == 0 ? n16 : (mode == 1 ? 2 * n16 : 2 * n16 + 1);
        *(u32x4*)(dst + ((size_t)((kb * 2 + ksl) * NTT + nt) * 64 + lane) * 8) = o;
    }
    __syncthreads();
}
DEVINL unsigned pk4_fp8(float a, float b, float c, float d) {
    int r = __builtin_amdgcn_cvt_pk_fp8_f32(a, b, 0, false);
    r = __builtin_amdgcn_cvt_pk_fp8_f32(c, d, r, true);
    return (unsigned)r;
}
DEVINL float sat8(float v) { return __builtin_amdgcn_fmed3f(v, -448.f, 448.f); }
DEVINL void frag8_item(const float* src, int N, int kb, int nb, unsigned char* dst, int NTT, int mode, float scale, unsigned char* smem, const int t) {
    float* scr = (float*)smem;
    const int k0 = kb * 64, n0 = nb * 64;
#pragma unroll
    for (int p = 0; p < 4; ++p) {
        const int r = (t >> 4) + 16 * p;
        f32x4 v = __builtin_nontemporal_load((const f32x4*)(src + (size_t)(k0 + r) * N + n0 + (t & 15) * 4));
        float* d = scr + r * 65 + (t & 15) * 4;
        d[0] = v.x * scale; d[1] = v.y * scale; d[2] = v.z * scale; d[3] = v.w * scale;
    }
    __syncthreads();
    const int lane = t & 63, lr = lane & 15, g = lane >> 4;
#pragma unroll
    for (int i = 0; i < 2; ++i) {
        const int combo = (t >> 6) + 4 * i, ksl = combo >> 2, ntl = combo & 3;
        const float* sp = scr + (32 * ksl + 8 * g) * 65 + 16 * ntl + lr;
        u32x2 o; o.x = pk4_fp8(sp[0], sp[65], sp[2 * 65], sp[3 * 65]); o.y = pk4_fp8(sp[4 * 65], sp[5 * 65], sp[6 * 65], sp[7 * 65]);
        const int n16 = nb * 4 + ntl, nt = mode == 0 ? n16 : (mode == 1 ? 2 * n16 : 2 * n16 + 1);
        *(u32x2*)(dst + ((size_t)((kb * 2 + ksl) * NTT + nt) * 64 + lane) * 8) = o;
    }
    __syncthreads();
}
DEVINL void router_frags(const Params& P, int i0, int istep) {
    bf16_t* dst = (bf16_t*)(P.ws + WS_WRF);
    for (int i = i0; i < 4 * 8 * 3 * 64; i += istep) {
        const int lane = i & 63, ot = (i >> 6) % 3, wp = (i >> 6) / 3, p = wp & 7, w = wp >> 3, lr = lane & 15, g = lane >> 4;
        const int o = 16 * ot + lr;
        unsigned hi[8], lo[8];
#pragma unroll
        for (int j = 0; j < 8; ++j) {
            const int n = 256 * w + 32 * p + (j < 4 ? 4 * g + j : 16 + 4 * g + (j - 4));
            float v = 0.f;
            if (o < 4) v = P.w_gr[n * 4 + o]; else if (o < 36) v = P.w_er[((size_t)((o - 4) >> 3) * 1024 + n) * 8 + ((o - 4) & 7)];
            const unsigned h = f2bf(v); hi[j] = h; lo[j] = f2bf(v - __uint_as_float(h << 16));
        }
        u32x4 a, b;
        a.x = hi[0] | (hi[1] << 16); a.y = hi[2] | (hi[3] << 16); a.z = hi[4] | (hi[5] << 16); a.w = hi[6] | (hi[7] << 16);
        b.x = lo[0] | (lo[1] << 16); b.y = lo[2] | (lo[3] << 16); b.z = lo[4] | (lo[5] << 16); b.w = lo[6] | (lo[7] << 16);
        *(u32x4*)(dst + (size_t)i * 8) = a;
        *(u32x4*)(dst + (size_t)(4 * 8 * 3 * 64 + i) * 8) = b;
    }
}
#define WIN_LDSFREE 1
#if WIN_LDSFREE
DEVINL void win_fragment_pair(const Params& P, int pr, int lane) {
    const int f0 = 2 * pr, ks = f0 / 144, nt = f0 - ks * 144, lr = lane & 15, g = lane >> 4;
    const float* sp = P.w_in + (size_t)(32 * ks + 8 * g) * QKVW + 16 * nt + lr;
    float v[2][8];
#pragma unroll
    for (int j = 0; j < 8; ++j) { v[0][j] = __builtin_nontemporal_load(sp + (size_t)j * QKVW); v[1][j] = __builtin_nontemporal_load(sp + (size_t)j * QKVW + 16); }
    bf16_t* dst = (bf16_t*)(P.ws + WS_WQF) + ((size_t)(ks * 144 + nt) * 64 + lane) * 8;
#pragma unroll
    for (int f = 0; f < 2; ++f) { u32x4 o; o.x = pk2(v[f][0], v[f][1]); o.y = pk2(v[f][2], v[f][3]); o.z = pk2(v[f][4], v[f][5]); o.w = pk2(v[f][6], v[f][7]); *(u32x4*)(dst + (size_t)f * 512) = o; }
}
#endif
DEVINL void phase0(const Params& P, unsigned char* smem, const bool do_router) {
    const int t = threadIdx.x;
#if WIN_LDSFREE && EXPERTS_IN_P2
    f32x4 mw[16], mcv;
    const bool has_mod = (int)blockIdx.x < 192;
    if (has_mod) mod_item512_issue(P, (int)blockIdx.x, t, mw, mcv);
#endif
    if (blockIdx.x == 0 && t < 112) ((unsigned*)(P.ws + WS_CCNT))[t * 64] = 0u;
#if WIN_LDSFREE
    {
        const int gw = (int)blockIdx.x * 8 + (t >> 6), ngw = (int)gridDim.x * 8;
        if (ngw == 2048) {
            { int l3 = t & 63; asm volatile("" : "+v"(l3)); win_fragment_pair(P, gw, l3); }
            if (gw >= 1792) { int l3 = t & 63; asm volatile("" : "+v"(l3)); win_fragment_pair(P, 2048 + (gw - 1792), l3); }
        } else
        for (int pr = gw; pr < 2304; pr += ngw) { int l3 = t & 63; asm volatile("" : "+v"(l3)); win_fragment_pair(P, pr, l3); }
    }
#endif
    if (do_router) router_frags(P, (int)blockIdx.x * NTHR + t, (int)gridDim.x * NTHR);
    bf16_t* WqF = (bf16_t*)(P.ws + WS_WQF); bf16_t* WoF = (bf16_t*)(P.ws + WS_WOF);
    unsigned char* WguF = P.ws + WS_WGUF; unsigned char* WdF = P.ws + WS_WDF;
    constexpr int NMOD = 192, NI_IN = WIN_LDSFREE ? 0 : 16 * 36, NI_OUT = EXPERTS_IN_P2 ? 0 : 256;
    constexpr int total = NMOD + NI_IN + NI_OUT;
    const int half = t >> 8, th = t & 255; unsigned char* hsm = smem + half * LDS_HALF;
    static_assert((NMOD | NI_IN | NI_OUT) % 2 == 0, "item pairs must be of one type (equal barrier counts in both half-blocks)");
#if WIN_LDSFREE && EXPERTS_IN_P2
    if (has_mod) mod_item512_finish(P, (int)blockIdx.x, smem, t, mw, mcv);
    for (int it = (int)blockIdx.x + (int)gridDim.x; it < NMOD; it += gridDim.x) mod_item512(P, it, smem, t);
    if (false)
#endif
    for (int it = 2 * blockIdx.x + half; it < total; it += 2 * gridDim.x) {
        int r = it;
        if (r < NMOD) { mod_item(P, r, hsm, th); continue; } r -= NMOD;
        if (r < NI_IN) { const int kb = r / 36, nb = r % 36; frag_item(P.w_in, QKVW, kb, nb, WqF, 144, 0, nullptr, hsm, th); continue; } r -= NI_IN;
        if (!EXPERTS_IN_P2 && r < NI_OUT) { const int kb = r >> 4, nb = r & 15; const int k0 = kb * 64;
            const float* ks = (k0 < 512) ? (P.beta_na + k0) : (P.beta_swa + (k0 - 512));
            frag_item(P.w_out, 1024, kb, nb, WoF, 64, 0, ks, hsm, th); continue; }
        break;
    }
#if !EXPERTS_IN_P2
    {
        constexpr int NE_IT = 3 * 512;
        for (int it = 2 * blockIdx.x + half; it < NE_IT; it += 2 * gridDim.x) {
            const int kind = it >> 9, rr = it & 511, e = rr >> 4;
            const int kb = kind == 2 ? ((rr >> 3) & 1) : ((rr >> 1) & 7), nb = kind == 2 ? (rr & 7) : (rr & 1);
            const int N = kind == 2 ? 1024 : 256;
            const float* src = (kind == 0 ? P.w_gate : kind == 1 ? P.w_up : P.w_down) + (size_t)e * 1024 * 256 + (size_t)(kb * 128) * N + nb * 128;
            const float scale = kind == 2 ? 16.f : 32.f;
            float* scr = (float*)hsm;
            f32x4 v[16];
#pragma unroll
            for (int p = 0; p < 16; ++p) v[p] = *(const f32x4*)(src + (size_t)((th >> 5) + 8 * p) * N + (th & 31) * 4);
#pragma unroll
            for (int p = 0; p < 16; ++p) { float* d = scr + ((th >> 5) + 8 * p) * 129 + (th & 31) * 4; d[0] = v[p].x * scale; d[1] = v[p].y * scale; d[2] = v[p].z * scale; d[3] = v[p].w * scale; }
            __syncthreads();
            unsigned char* dst = kind == 2 ? (WdF + (size_t)e * (2 * 64 * 2048)) : (WguF + (size_t)e * (8 * 32 * 2048));
            const int NTT = kind == 2 ? 64 : 32, lane = th & 63, lr = lane & 15, g = lane >> 4;
#pragma unroll
            for (int i = 0; i < 2; ++i) {
                const int ntl = (th >> 6) + 4 * i;
                const float* sp = scr + (32 * g) * 129 + 16 * ntl + lr;
                u32x4 o0, o1;
                o0.x = pk4_fp8(sp[0 * 129], sp[1 * 129], sp[2 * 129], sp[3 * 129]);     o0.y = pk4_fp8(sp[4 * 129], sp[5 * 129], sp[6 * 129], sp[7 * 129]);
                o0.z = pk4_fp8(sp[8 * 129], sp[9 * 129], sp[10 * 129], sp[11 * 129]);   o0.w = pk4_fp8(sp[12 * 129], sp[13 * 129], sp[14 * 129], sp[15 * 129]);
                o1.x = pk4_fp8(sp[16 * 129], sp[17 * 129], sp[18 * 129], sp[19 * 129]); o1.y = pk4_fp8(sp[20 * 129], sp[21 * 129], sp[22 * 129], sp[23 * 129]);
                o1.z = pk4_fp8(sp[24 * 129], sp[25 * 129], sp[26 * 129], sp[27 * 129]); o1.w = pk4_fp8(sp[28 * 129], sp[29 * 129], sp[30 * 129], sp[31 * 129]);
                const int n16 = nb * 8 + ntl, nt = kind == 2 ? n16 : (kind == 0 ? 2 * n16 : 2 * n16 + 1);
                unsigned char* o = dst + ((size_t)(kb * NTT + nt) * 64 + lane) * 32;
                *(u32x4*)o = o0; *(u32x4*)(o + 16) = o1;
            }
            __syncthreads();
        }
    }
#endif
}

#if EXPERTS_IN_P2
DEVINL void expert_unit_quarter(const Params& P, int u, int q4, int lane) {
    const int lr = lane & 15, g = lane >> 4;
    const float* src; unsigned char* dst; float scale; int N, ntbase, ntstep, ntoff;
    if (u < 512) { const int e = u >> 4, up = (u >> 3) & 1, ks = u & 7; N = 256; scale = 32.f;
        src = (up ? P.w_up : P.w_gate) + (size_t)e * 1024 * 256 + (size_t)(128 * ks) * 256;
        dst = P.ws + WS_WGUF + (size_t)e * (8 * 32 * 2048) + (size_t)(ks * 32) * 2048; ntbase = 0; ntstep = 2; ntoff = up; }
    else { const int v = u - 512, e = v >> 3, ks = (v >> 2) & 1, qq = v & 3; N = 1024; scale = 16.f;
        src = P.w_down + (size_t)e * 256 * 1024 + (size_t)(128 * ks) * 1024 + 256 * qq;
        dst = P.ws + WS_WDF + (size_t)e * (2 * 64 * 2048) + (size_t)(ks * 64) * 2048; ntbase = 16 * qq; ntstep = 1; ntoff = 0; }
    const float* sp = src + (size_t)(32 * g) * N + 64 * q4 + lr;
    float v[4][32];
#pragma unroll
    for (int j = 0; j < 32; ++j)
#pragma unroll
        for (int f = 0; f < 4; ++f) v[f][j] = __builtin_nontemporal_load(sp + (size_t)j * N + 16 * f);
#pragma unroll
    for (int f = 0; f < 4; ++f) {
        u32x4 o0, o1;
#define P4(i_) pk4_fp8(v[f][4 * (i_)] * scale, v[f][4 * (i_) + 1] * scale, v[f][4 * (i_) + 2] * scale, v[f][4 * (i_) + 3] * scale)
        o0.x = P4(0); o0.y = P4(1); o0.z = P4(2); o0.w = P4(3); o1.x = P4(4); o1.y = P4(5); o1.z = P4(6); o1.w = P4(7);
#undef P4
        const int nt = ntbase * 1 + (4 * q4 + f) * ntstep + ntoff;
        unsigned char* o = dst + ((size_t)nt * 64 + lane) * 32;
        *(u32x4*)o = o0; *(u32x4*)(o + 16) = o1;
    }
}
#endif

#if EXPERTS_IN_P2
DEVINL void wout_fragment(const Params& P, int f, int lane) {
    const int ks = f >> 6, nt = f & 63, lr = lane & 15, g = lane >> 4, k0 = 32 * ks + 8 * g;
    const float* sp = P.w_out + (size_t)k0 * 1024 + 16 * nt + lr;
    const float* bp = k0 < 512 ? P.beta_na + k0 : P.beta_swa + (k0 - 512);
    float v[8];
#pragma unroll
    for (int j = 0; j < 8; ++j) v[j] = __builtin_nontemporal_load(sp + (size_t)j * 1024) * bp[j];
    u32x4 o; o.x = pk2(v[0], v[1]); o.y = pk2(v[2], v[3]); o.z = pk2(v[4], v[5]); o.w = pk2(v[6], v[7]);
    *(u32x4*)((bf16_t*)(P.ws + WS_WOF) + ((size_t)(ks * 64 + nt) * 64 + lane) * 8) = o;
}
#endif

DEVINL void qkv_store_head(const Params& P, const f32x4 (&v0)[4], int slot, int m, int g, const float* rc, const float* rs, int nfr, int fr0) {
    int region, hd;
    if (slot < 8) { region = 0; hd = slot; } else if (slot < 16) { region = 1; hd = slot - 8; } else if (slot < 24) { region = 2; hd = slot - 16; }
    else if (slot < 32) { region = 3; hd = slot - 24; } else if (slot < 34) { region = 4; hd = slot - 32; } else { region = 5; hd = slot - 34; }
    const size_t off = region == 0 ? WS_NAQ : region == 1 ? WS_NAK : region == 2 ? WS_NAV : region == 3 ? WS_SWQ : region == 4 ? WS_SWK : WS_SWV;
    const int nh = (region >= 4) ? 2 : 8, b = m >> 13, sq = m & (SEQ - 1), hp = nfr >> 1, fstep = (nfr == 4) ? 1 : 2;
    f32x4 v[4];
#pragma unroll
    for (int ni = 0; ni < 4; ++ni) v[ni] = v0[ni];
    if (region == 3 || region == 4) {
#pragma unroll
        for (int ni = 0; ni < 2; ++ni) if (ni < hp) {
            const int fr = fr0 + ni * fstep;
            const f32x4 cs = *(const f32x4*)(rc + sq * 32 + 16 * fr + 4 * g), sn = *(const f32x4*)(rs + sq * 32 + 16 * fr + 4 * g);
            const f32x4 x1 = v[ni], x2 = v[ni + hp];
            v[ni] = x1 * cs - x2 * sn; v[ni + hp] = x2 * cs + x1 * sn;
        }
    }
    if (region == 0 || region == 3) {
#pragma unroll
        for (int ni = 0; ni < 4; ++ni) v[ni] = v[ni] * QSCALE;
    }
    bf16_t* base = (bf16_t*)(P.ws + off) + ((size_t)(b * nh + hd) * SEQ + sq) * 64;
#pragma unroll
    for (int ni = 0; ni < 4; ni += 2) if (ni < nfr) {
        u32x2 a, b2; a.x = pk2(v[ni].x, v[ni].y); a.y = pk2(v[ni].z, v[ni].w); b2.x = pk2(v[ni + 1].x, v[ni + 1].y); b2.y = pk2(v[ni + 1].z, v[ni + 1].w);
        store_pair16(base, a, b2, fr0 + ni * fstep, fr0 + (ni + 1) * fstep, g, true);
    }
}
struct XPre { f32x4 v[8][4]; };
DEVINL void stage_x_load(const Params& P, int m0, XPre& X) {
    const int wv = __builtin_amdgcn_readfirstlane(threadIdx.x >> 6); int lane = threadIdx.x & 63; asm volatile("" : "+v"(lane));
#pragma unroll
    for (int rr = 0; rr < 8; ++rr) {
        const f32x4* xr = (const f32x4*)(P.x + (size_t)(m0 + 8 * wv + rr) * DM) + lane;
#pragma unroll
        for (int j = 0; j < 4; ++j) X.v[rr][j] = __builtin_nontemporal_load(xr + 64 * j);
    }
}
DEVINL void phase2(const Params& P, unsigned char* smem, XPre& X, const bool have_pre) {
    if ((!have_pre || threadIdx.x < 64) && (int)blockIdx.x < NT / 64) stage_x_load(P, (int)blockIdx.x * 64, X);
    const int t = threadIdx.x, wv = __builtin_amdgcn_readfirstlane(t >> 6);
    const float* mod = (const float*)(P.ws + WS_MOD);
    const float* rc = (const float*)(P.ws + WS_ROPE); const float* rs = rc + SEQ * 32;
    bf16_t* XB = (bf16_t*)(P.ws + WS_XB);
    float* s_rc = (float*)(smem + 131072); float* s_rs = s_rc + 2048;
    for (int tile = blockIdx.x; tile < NT / 64; tile += gridDim.x) {
        const int m0 = tile * 64;
        int lane = t & 63;
        asm volatile("" : "+v"(lane));
        const int lr = lane & 15, g = lane >> 4;
        __syncthreads();
        if (!SKIPF(128)) REP(P2_RS) {
            asm volatile("" ::: "memory");
            const float* mb = mod + (m0 >> 13) * 6144;
            f32x4 mul[4], sh[4];
#pragma unroll
            for (int j = 0; j < 4; ++j) { const int col = 4 * lane + 256 * j;
                mul[j] = *(const f32x4*)(P.g_pre_mix + col) * (*(const f32x4*)(mb + 1024 + col) + 1.f); sh[j] = *(const f32x4*)(mb + col); }
#pragma unroll
            for (int rr = 0; rr < 8; ++rr) {
                const int row = 8 * wv + rr;
                f32x4 v[4]; float ss = 0.f;
#pragma unroll
                for (int j = 0; j < 4; ++j) { v[j] = X.v[rr][j]; ss += v[j].x * v[j].x + v[j].y * v[j].y + v[j].z * v[j].z + v[j].w * v[j].w; }
#pragma unroll
                for (int j = 0; j < 4; ++j) { u32x2 o; o.x = pk2(v[j].x, v[j].y); o.y = pk2(v[j].z, v[j].w); *(u32x2*)(XB + (size_t)(m0 + row) * DM + 4 * lane + 256 * j) = o; }
                ss = wave_sum(ss);
                const float rstd = rsqrtf(ss * (1.f / DM) + EPS);
#pragma unroll
                for (int j = 0; j < 4; ++j) {
                    const f32x4 h = v[j] * rstd * mul[j] + sh[j];
                    u32x2 o; o.x = pk2(h.x, h.y); o.y = pk2(h.z, h.w);
                    const int c = (lane >> 1) + 32 * j;
                    *(u32x2*)(smem + row * 2048 + ((c ^ (row & 15)) << 4) + (lane & 1) * 8) = o;
                }
            }
        }
        {
            const int sq0 = m0 & (SEQ - 1);
#pragma unroll
            for (int q_ = 0; q_ < 4; ++q_) {
                const int i = 4 * t + q_, pos = sq0 + (i >> 5), fi = i & 31;
                const float ex = -((float)fi * 2.0f) / 64.0f;
                const float inv = exp2f(ex * 13.287712379549449f);
                const float ang = (float)pos * inv;
                double tt = (double)ang * 0.15915494309189535; tt -= floor(tt);
                const float fr = (float)tt;
                s_rc[i] = __builtin_amdgcn_cosf(fr); s_rs[i] = __builtin_amdgcn_sinf(fr);
            }
        }
        const float* rcl = s_rc - (m0 & (SEQ - 1)) * 32; const float* rsl = s_rs - (m0 & (SEQ - 1)) * 32;
        __syncthreads();
        unsigned voff = (unsigned)(lane * 16);
        asm volatile("" : "+v"(voff));
        const int aoff = lr * 2048;
#define AFRAG(mi_, ks_) (*(const bf16x8*)(smem + aoff + (mi_) * 32768 + (((4 * (ks_) + g) ^ lr) << 4)))
#if EXPERTS_IN_P2
        if (wv >= 4 && !(have_pre && tile == (int)blockIdx.x)) {
#pragma unroll 1
            for (int i = 0; i < 2; ++i) { int l3 = lane; asm volatile("" : "+v"(l3)); expert_unit_quarter(P, 3 * tile + i, wv - 4, l3); }
            { int l3 = lane; asm volatile("" : "+v"(l3)); wout_fragment(P, 8 * tile + 2 * (wv - 4), l3); wout_fragment(P, 8 * tile + 2 * (wv - 4) + 1, l3); }
        }
#endif
#pragma unroll 1
        for (int sq = 0; sq < 3; ++sq) {
        const int pass = wv < 4 ? sq : (sq == 0 ? 2 : sq - 1);
        if (pass < 2) {
            f32x4 acc[8][4];
            REP(P2_RK) {
#pragma unroll
            for (int i = 0; i < 8; ++i)
#pragma unroll
                for (int mi = 0; mi < 4; ++mi) acc[i][mi] = (f32x4){0.f, 0.f, 0.f, 0.f};
            if (!SKIPF(256)) {
                const unsigned char* wb = (const unsigned char*)(P.ws + WS_WQF) + (size_t)(64 * pass + 8 * wv) * 1024;
                bf16x8 b0[8], b1[8];
#define LOADB(dst, ks_) do { const unsigned char* ub_ = wb + (size_t)((ks_) * 144) * 1024; \
        _Pragma("unroll") for (int j_ = 0; j_ < 8; ++j_) dst[j_] = *(const bf16x8*)(ub_ + j_ * 1024 + voff); } while (0)
#define LOADA(fd, ks_) do { _Pragma("unroll") for (int mi_ = 0; mi_ < 4; ++mi_) fd[mi_] = AFRAG(mi_, ks_); } while (0)
#define MMA(src, fs, ksn_) do { _Pragma("unroll") for (int mi_ = 0; mi_ < 4; ++mi_) { \
        _Pragma("unroll") for (int j_ = 0; j_ < 8; ++j_) acc[j_][mi_] = __builtin_amdgcn_mfma_f32_16x16x32_bf16(src[j_], fs[mi_], acc[j_][mi_], 0, 0, 0); \
        fs[mi_] = AFRAG(mi_, (ksn_) < 32 ? (ksn_) : 31); } } while (0)
                bf16x8 fa[4];
                LOADB(b0, 0); LOADA(fa, 0);
#pragma unroll 1
                for (int ks = 0; ks < 32; ks += 2) {
                    LOADB(b1, ks + 1);
                    __builtin_amdgcn_sched_barrier(0);
                    MMA(b0, fa, ks + 1);
                    __builtin_amdgcn_sched_barrier(0);
                    LOADB(b0, ks + 2 < 32 ? ks + 2 : 31);
                    __builtin_amdgcn_sched_barrier(0);
                    MMA(b1, fa, ks + 2);
                    __builtin_amdgcn_sched_barrier(0);
                }
#undef LOADB
#undef MMA
#undef LOADA
            }
#if P2_RK > 1
#pragma unroll
            for (int i = 0; i < 8; ++i) asm volatile("" : "+v"(acc[i][0]), "+v"(acc[i][1]), "+v"(acc[i][2]), "+v"(acc[i][3]));
#endif
            }
            if (!SKIPF(512)) REP(P2_RE) {
            int l2 = lane;
            asm volatile("" : "+v"(l2));
            const int lr2 = l2 & 15, g2 = l2 >> 4;
#pragma unroll
            for (int hh = 0; hh < 2; ++hh)
#pragma unroll
                for (int mi = 0; mi < 4; ++mi) {
                    f32x4 v[4];
#pragma unroll
                    for (int ni = 0; ni < 4; ++ni) v[ni] = acc[4 * hh + ni][mi];
                    qkv_store_head(P, v, 16 * pass + 2 * wv + hh, m0 + 16 * mi + lr2, g2, rcl, rsl, 4, 0);
                    asm volatile("" ::: "memory");
                }
            }
        } else {
            f32x4 acc[2][4];
#pragma unroll
            for (int i = 0; i < 2; ++i)
#pragma unroll
                for (int mi = 0; mi < 4; ++mi) acc[i][mi] = (f32x4){0.f, 0.f, 0.f, 0.f};
            const int slot = 32 + (wv >> 1), fr0 = wv & 1;
            const unsigned char* wb = (const unsigned char*)(P.ws + WS_WQF) + (size_t)(4 * slot + fr0) * 1024;
            bf16x8 pa[4], pb[4];
#define LOADP(i_, ks_) do { pa[i_] = *(const bf16x8*)(wb + (size_t)((ks_) * 144) * 1024 + voff); pb[i_] = *(const bf16x8*)(wb + (size_t)((ks_) * 144 + 2) * 1024 + voff); } while (0)
#define STEP(i_, ks_) do { _Pragma("unroll") for (int mi = 0; mi < 4; ++mi) { const bf16x8 f = AFRAG(mi, ks_); \
        acc[0][mi] = __builtin_amdgcn_mfma_f32_16x16x32_bf16(pa[i_], f, acc[0][mi], 0, 0, 0); acc[1][mi] = __builtin_amdgcn_mfma_f32_16x16x32_bf16(pb[i_], f, acc[1][mi], 0, 0, 0); } } while (0)
            LOADP(0, 0); LOADP(1, 1); LOADP(2, 2);
#pragma unroll 1
            for (int ks = 0; ks < 32; ks += 4) {
                LOADP(3, ks + 3);                            __builtin_amdgcn_sched_barrier(0);
                STEP(0, ks);     __builtin_amdgcn_sched_barrier(0); LOADP(0, ks + 4 < 32 ? ks + 4 : 31); __builtin_amdgcn_sched_barrier(0);
                STEP(1, ks + 1); __builtin_amdgcn_sched_barrier(0); LOADP(1, ks + 5 < 32 ? ks + 5 : 31); __builtin_amdgcn_sched_barrier(0);
                STEP(2, ks + 2); __builtin_amdgcn_sched_barrier(0); LOADP(2, ks + 6 < 32 ? ks + 6 : 31); __builtin_amdgcn_sched_barrier(0);
                STEP(3, ks + 3); __builtin_amdgcn_sched_barrier(0);
            }
#undef LOADP
#undef STEP
            int l2 = lane;
            asm volatile("" : "+v"(l2));
            const int lr2 = l2 & 15, g2 = l2 >> 4;
#pragma unroll
            for (int mi = 0; mi < 4; ++mi) {
                f32x4 v[4]; v[0] = acc[0][mi]; v[1] = acc[1][mi]; v[2] = v[0]; v[3] = v[1];
                qkv_store_head(P, v, slot, m0 + 16 * mi + lr2, g2, rcl, rsl, 2, fr0);
                asm volatile("" ::: "memory");
            }
        }
        }
#if EXPERTS_IN_P2
        if (wv < 4 && !(have_pre && tile == (int)blockIdx.x)) { int l3 = lane; asm volatile("" : "+v"(l3)); expert_unit_quarter(P, 3 * tile + 2, wv, l3); }
#endif
#undef AFRAG
        if (tile + (int)gridDim.x < NT / 64) stage_x_load(P, (tile + (int)gridDim.x) * 64, X);
    }
}

#if NAIVE_ATTN
DEVINL void phase3(const Params& P, unsigned char* smem) {
    const int lane = threadIdx.x & 63, gw = blockIdx.x * 8 + (threadIdx.x >> 6), ngw = gridDim.x * 8;
    bf16_t* ATT = (bf16_t*)(P.ws + WS_ATT); float* SSQ = (float*)(P.ws + WS_SSQ);
    for (int it = gw; it < NT * 16; it += ngw) {
        const int isw = it >= NT * 8; const int r = isw ? it - NT * 8 : it;
        const int tok = r >> 3, h = r & 7, b = tok >> 13, s = tok & (SEQ - 1);
        float m = -3.0e38f, sum = 0.f, o = 0.f;
        if (!isw) {
            const bf16_t* Q = (const bf16_t*)(P.ws + WS_NAQ) + ((size_t)(b * 8 + h) * SEQ) * 64;
            const bf16_t* K = (const bf16_t*)(P.ws + WS_NAK) + ((size_t)(b * 8 + h) * SEQ) * 64;
            const bf16_t* VT = (const bf16_t*)(P.ws + WS_NAV) + ((size_t)(b * 8 + h) * SEQ) * 64;
            const float q = bf2f(Q[(size_t)s * 64 + lane]);
            const int row = s >> 6, col = s & 63;
            int r0 = row - 4; r0 = r0 < 0 ? 0 : (r0 > 120 ? 120 : r0);
            int cs = col - 8; cs = cs < 0 ? 0 : (cs > 48 ? 48 : cs);
            const float* rpb = P.na_rpb + h * 15 * 31;
            for (int pass = 0; pass < 2; ++pass)
                for (int i = 0; i < 8; ++i)
                    for (int j = 0; j < 16; ++j) {
                        const int key = (r0 + i) * 64 + cs + j;
                        float d = wave_sum(q * bf2f(K[(size_t)key * 64 + lane]));
                        d += rpb[(r0 + i - row + 7) * 31 + (cs + j - col + 15)] * LOG2E;
                        if (pass == 0) m = fmaxf(m, d);
                        else { const float p = exp2f(d - m); sum += p; o += p * bf2f(VT[(size_t)key * 64 + lane]); }
                    }
        } else {
            const int kvh = h >> 2;
            const bf16_t* Q = (const bf16_t*)(P.ws + WS_SWQ) + ((size_t)(b * 8 + h) * SEQ) * 64;
            const bf16_t* K = (const bf16_t*)(P.ws + WS_SWK) + ((size_t)(b * 2 + kvh) * SEQ) * 64;
            const bf16_t* VT = (const bf16_t*)(P.ws + WS_SWV) + ((size_t)(b * 2 + kvh) * SEQ) * 64;
            const float q = bf2f(Q[(size_t)s * 64 + lane]);
            const int klo = s - 128 < 0 ? 0 : s - 128, khi = s + 128 > SEQ - 1 ? SEQ - 1 : s + 128;
            const float sk = P.swa_sinks[h] * LOG2E;
            m = sk;
            for (int pass = 0; pass < 2; ++pass)
                for (int key = klo; key <= khi; ++key) {
                    const float d = wave_sum(q * bf2f(K[(size_t)key * 64 + lane]));
                    if (pass == 0) m = fmaxf(m, d);
                    else { const float p = exp2f(d - m); sum += p; o += p * bf2f(VT[(size_t)key * 64 + lane]); }
                }
            sum += exp2f(sk - m);
        }
        o /= sum;
        ATT[(size_t)tok * DM + (isw ? 512 : 0) + h * 64 + lane] = (bf16_t)f2bf(o);
        const float sq = wave_sum(o * o);
        if (lane == 0) SSQ[tok * 16 + (isw ? 8 : 0) + h] = sq;
    }
}
#else
typedef short s16x4 __attribute__((ext_vector_type(4)));
#define LAS3 __attribute__((address_space(3)))
DEVINL int imax3(int a, int b, int c) { const int m = a > b ? a : b; return m > c ? m : c; }
DEVINL int k_off(int row, int c) { return row * 128 + ((c ^ ((row >> 1) & 7)) << 4); }
DEVINL int v_off(int row, int c) { return row * 128 + ((((c >> 1) ^ ((row >> 1) & 3)) << 5) | ((c & 1) << 4)); }
DEVINL bf16x8 tr_pair(const LAS3 unsigned char* p0, const LAS3 unsigned char* p1) {
    const s16x4 a = __builtin_amdgcn_ds_read_tr16_b64_v4i16((LAS3 s16x4*)p0), b = __builtin_amdgcn_ds_read_tr16_b64_v4i16((LAS3 s16x4*)p1);
    bf16x8 r; r[0] = a[0]; r[1] = a[1]; r[2] = a[2]; r[3] = a[3]; r[4] = b[0]; r[5] = b[1]; r[6] = b[2]; r[7] = b[3]; return r;
}
DEVINL void phase3(const Params& P, unsigned char* smem) {
    const int t = threadIdx.x, wv = __builtin_amdgcn_readfirstlane(t >> 6);
    bf16_t* ATT = (bf16_t*)(P.ws + WS_ATT); float* SSQ = (float*)(P.ws + WS_SSQ);
    const LAS3 unsigned char* lsm = (const LAS3 unsigned char*)smem;
    const int G = gridDim.x, vb = (G % 8 == 0) ? (int)(blockIdx.x % 8) * (G / 8) + (int)(blockIdx.x / 8) : (int)blockIdx.x;
    constexpr int KR = 0, VR = 73728;
    u32x4 swk[5]; bool sw_pre = false;
    if (!SKIPF(1024))
    for (int it = vb; it < 2 * 8 * 16; it += G) {
        const int grp = it & 15, h = (it >> 4) & 7, b = it >> 7, R0 = 8 * grp;
        int lane = t & 63; asm volatile("" : "+v"(lane));
        const int lr = lane & 15, g = lane >> 4;
        const int rs = wv >> 2, w = wv & 3, c0 = 16 * w;
        int kc0 = c0 - 8; kc0 = kc0 < 0 ? 0 : (kc0 > 32 ? 32 : kc0);
        const bf16_t* Qg = (const bf16_t*)(P.ws + WS_NAQ) + ((size_t)(b * 8 + h) * SEQ) * 64;
        const bf16_t* Kg = (const bf16_t*)(P.ws + WS_NAK) + ((size_t)(b * 8 + h) * SEQ) * 64;
        const bf16_t* Vg = (const bf16_t*)(P.ws + WS_NAV) + ((size_t)(b * 8 + h) * SEQ) * 64;
#define R0OF(r_) ((r_) - 4 < 0 ? 0 : ((r_) - 4 > 120 ? 120 : (r_) - 4))
        __syncthreads();
        float* s_rpb = (float*)(smem + LDS_MISC);
        for (int i = t; i < 465; i += NTHR) s_rpb[i] = P.na_rpb[h * 465 + i] * LOG2E;
        {
            const int lo = R0OF(R0), hi = R0OF(R0 + 1) + 7;
            for (int row = lo; row <= hi; ++row) {
                const u32x4 kk_ = *(const u32x4*)(Kg + (size_t)row * 4096 + t * 8), vv_ = *(const u32x4*)(Vg + (size_t)row * 4096 + t * 8);
                const int sl = (row % 9) * 8192;
                *(u32x4*)(smem + KR + sl + k_off(t >> 3, t & 7)) = kk_; *(u32x4*)(smem + VR + sl + v_off(t >> 3, t & 7)) = vv_;
            }
        }
        f32x4 bia[16];
        const bool edge = grp == 0 || grp == 15;
        bf16x8 qn0, qn1;
        { const bf16_t* qp = Qg + (size_t)((R0 + rs) * 64 + c0 + lr) * 64 + 8 * g; qn0 = *(const bf16x8*)qp; qn1 = *(const bf16x8*)(qp + 32); }
#pragma unroll 1
        for (int p = 0; p < 4; ++p) {
            const int r = R0 + 2 * p + rs, r0 = R0OF(r);
            const int hi_p = R0OF(R0 + 2 * p + 1) + 7, hi_n = p < 3 ? R0OF(R0 + 2 * p + 3) + 7 : hi_p;
            __syncthreads();
            const bf16x8 q0 = qn0, q1 = qn1;
            if (p == 0 || edge) {
                const int c = c0 + lr; int cs = c - 8; cs = cs < 0 ? 0 : (cs > 48 ? 48 : cs);
                const float* rp = s_rpb + (r0 - r + 7) * 31;
#pragma unroll
                for (int j = 0; j < 8; ++j) {
                    const int kc = kc0 + (j >> 2) * 16 + 4 * g + (j & 3);
                    const bool ok = (kc >= cs) && (kc < cs + 16);
                    int dc = kc - c + 15; dc = dc < 0 ? 0 : (dc > 30 ? 30 : dc);
#pragma unroll
                    for (int i = 0; i < 8; ++i) { const float v = rp[i * 31 + dc]; bia[2 * i + (j >> 2)][j & 3] = ok ? v : -3.0e38f; }
                }
            }
            f32x4 sc[16];
            float mx = -3.0e38f;
#pragma unroll
            for (int tt = 0; tt < 16; ++tt) {
                const int sl = ((r0 + (tt >> 1)) % 9) * 8192, row = kc0 + (tt & 1) * 16 + lr;
                const bf16x8 k0 = *(const bf16x8*)(smem + KR + sl + k_off(row, g)), k1 = *(const bf16x8*)(smem + KR + sl + k_off(row, 4 + g));
                f32x4 a = bia[tt];
                a = __builtin_amdgcn_mfma_f32_16x16x32_bf16(k0, q0, a, 0, 0, 0);
                a = __builtin_amdgcn_mfma_f32_16x16x32_bf16(k1, q1, a, 0, 0, 0);
                sc[tt] = a;
                if ((tt & 3) == 3) asm volatile("" ::: "memory");
            }
            asm volatile("" ::: "memory");
            u32x4 kn0, vn0, kn1, vn1;
            { const int ra = hi_p + 1 <= hi_n ? hi_p + 1 : hi_n, rb = hi_p + 2 <= hi_n ? hi_p + 2 : hi_n;
              kn0 = *(const u32x4*)(Kg + (size_t)ra * 4096 + t * 8); vn0 = *(const u32x4*)(Vg + (size_t)ra * 4096 + t * 8);
              kn1 = *(const u32x4*)(Kg + (size_t)rb * 4096 + t * 8); vn1 = *(const u32x4*)(Vg + (size_t)rb * 4096 + t * 8);
              const bf16_t* qp = Qg + (size_t)((r + (p < 3 ? 2 : 0)) * 64 + c0 + lr) * 64 + 8 * g; qn0 = *(const bf16x8*)qp; qn1 = *(const bf16x8*)(qp + 32); }
            {
                int ma = 0, mb = 0;
#pragma unroll
                for (int tt = 0; tt < 16; ++tt) { ma = imax3(ma, __float_as_int(sc[tt][0]), __float_as_int(sc[tt][1])); mb = imax3(mb, __float_as_int(sc[tt][2]), __float_as_int(sc[tt][3])); }
                ma = ma > mb ? ma : mb;
                ma = gmaxi4(ma);
                if (__builtin_expect(__any(ma == 0), 0)) {
#pragma unroll
                    for (int tt = 0; tt < 16; ++tt) mx = fmaxf(fmaxf(mx, fmaxf(sc[tt][0], sc[tt][1])), fmaxf(sc[tt][2], sc[tt][3]));
                    mx = gmaxf4(mx);
                } else mx = __int_as_float(ma);
            }
            float sum = 0.f;
            bf16x8 pf[8];
#pragma unroll
            for (int kk = 0; kk < 8; ++kk) {
                float pe[8];
#pragma unroll
                for (int e = 0; e < 4; ++e) { pe[e] = __builtin_amdgcn_exp2f(sc[2 * kk][e] - mx); pe[4 + e] = __builtin_amdgcn_exp2f(sc[2 * kk + 1][e] - mx); }
                sum += ((pe[0] + pe[1]) + (pe[2] + pe[3])) + ((pe[4] + pe[5]) + (pe[6] + pe[7]));
                union { bf16x8 v; unsigned u[4]; } pk; pk.u[0] = pk2(pe[0], pe[1]); pk.u[1] = pk2(pe[2], pe[3]); pk.u[2] = pk2(pe[4], pe[5]); pk.u[3] = pk2(pe[6], pe[7]);
                pf[kk] = pk.v;
            }
            sum = gsum4(sum);
            f32x4 o[4];
#pragma unroll
            for (int dt = 0; dt < 4; ++dt) o[dt] = (f32x4){0.f, 0.f, 0.f, 0.f};
            const int vrow = kc0 + 4 * g + (lr >> 2), vsw = (vrow >> 1) & 3, vbase = VR + vrow * 128 + (lr & 3) * 8;
#pragma unroll
            for (int kk = 0; kk < 8; ++kk) {
                const int sl = ((r0 + kk) % 9) * 8192;
#pragma unroll
                for (int dt = 0; dt < 4; ++dt) {
                    const LAS3 unsigned char* ap = lsm + vbase + sl + ((dt ^ vsw) << 5);
                    o[dt] = __builtin_amdgcn_mfma_f32_16x16x32_bf16(tr_pair(ap, ap + 2048), pf[kk], o[dt], 0, 0, 0);
                }
            }
            if (p == 3 && it + G >= 2 * 8 * 16 && vb < 2 * 2 * 64 && !SKIPF(2048)) {
                const int sQ0 = (vb & 63) * 128, skvh = (vb >> 6) & 1, sb = vb >> 7;
                const bf16_t* sKg = (const bf16_t*)(P.ws + WS_SWK) + ((size_t)(sb * 2 + skvh) * SEQ) * 64;
#pragma unroll
                for (int i = 0; i < 5; ++i) {
                    const int idx = t + NTHR * i, kp = sQ0 - 128 + (idx >> 3), cch = idx & 7;
                    const int tokk = kp < 0 ? 0 : (kp > SEQ - 1 ? SEQ - 1 : kp);
                    swk[i] = *(const u32x4*)(sKg + (size_t)tokk * 64 + cch * 8);
                }
                sw_pre = true;
            }
            const float inv = __builtin_amdgcn_rcpf(sum); float sq = 0.f;
            const int tok = b * SEQ + r * 64 + c0 + lr;
#pragma unroll
            for (int dt = 0; dt < 4; dt += 2) {
                const f32x4 v = o[dt] * inv, v2 = o[dt + 1] * inv;
                sq += (v.x * v.x + v.y * v.y + v.z * v.z + v.w * v.w) + (v2.x * v2.x + v2.y * v2.y + v2.z * v2.z + v2.w * v2.w);
                u32x2 oa, ob; oa.x = pk2(v.x, v.y); oa.y = pk2(v.z, v.w); ob.x = pk2(v2.x, v2.y); ob.y = pk2(v2.z, v2.w);
                store_pair16(ATT + (size_t)tok * DM + h * 64, oa, ob, dt, dt + 1, g, true);
            }
            sq = gsum4(sq);
            if (g == 0) SSQ[tok * 16 + h] = sq;
            __syncthreads();
            if (hi_p + 1 <= hi_n) { const int sl = ((hi_p + 1) % 9) * 8192; *(u32x4*)(smem + KR + sl + k_off(t >> 3, t & 7)) = kn0; *(u32x4*)(smem + VR + sl + v_off(t >> 3, t & 7)) = vn0; }
            if (hi_p + 2 <= hi_n) { const int sl = ((hi_p + 2) % 9) * 8192; *(u32x4*)(smem + KR + sl + k_off(t >> 3, t & 7)) = kn1; *(u32x4*)(smem + VR + sl + v_off(t >> 3, t & 7)) = vn1; }
        }
#undef R0OF
    }
    if (!SKIPF(2048))
    for (int it = vb; it < 2 * 2 * 64; it += G) {
        constexpr int SKR = 0, SVR = 40960, RING = 320;
        const int span = it & 63, kvh = (it >> 6) & 1, b = it >> 7, Q0 = span * 128;
        int lane = t & 63; asm volatile("" : "+v"(lane));
        const int lr = lane & 15, g = lane >> 4;
        const int hqA = kvh * 4 + 2 * (wv & 1), qt = wv >> 1;
        const bf16_t* QgA = (const bf16_t*)(P.ws + WS_SWQ) + ((size_t)(b * 8 + hqA) * SEQ) * 64;
        const bf16_t* Kg = (const bf16_t*)(P.ws + WS_SWK) + ((size_t)(b * 2 + kvh) * SEQ) * 64;
        const bf16_t* Vg = (const bf16_t*)(P.ws + WS_SWV) + ((size_t)(b * 2 + kvh) * SEQ) * 64;
        const float skA = P.swa_sinks[hqA] * LOG2E, skB = P.swa_sinks[hqA + 1] * LOG2E;
        __syncthreads();
        {
            int tq = t; asm volatile("" : "+v"(tq));
            u32x4 swv[5];
#pragma unroll
            for (int i = 0; i < 5; ++i) {
                const int idx = tq + NTHR * i, kp = Q0 - 128 + (idx >> 3), cch = idx & 7;
                const int tokk = kp < 0 ? 0 : (kp > SEQ - 1 ? SEQ - 1 : kp);
                swv[i] = *(const u32x4*)(Vg + (size_t)tokk * 64 + cch * 8);
                if (!(sw_pre && it == vb)) swk[i] = *(const u32x4*)(Kg + (size_t)tokk * 64 + cch * 8);
            }
#pragma unroll
            for (int i = 0; i < 5; ++i) {
                const int idx = tq + NTHR * i, kp = Q0 - 128 + (idx >> 3), cch = idx & 7, rr = (kp + RING) % RING;
                *(u32x4*)(smem + SKR + k_off(rr, cch)) = swk[i]; *(u32x4*)(smem + SVR + v_off(rr, cch)) = swv[i];
            }
        }
        bf16x8 qnA0, qnA1, qnB0, qnB1;
        { const bf16_t* qp = QgA + (size_t)(Q0 + 16 * qt + lr) * 64 + 8 * g; qnA0 = *(const bf16x8*)qp; qnA1 = *(const bf16x8*)(qp + 32);
          qnB0 = *(const bf16x8*)(qp + (size_t)SEQ * 64); qnB1 = *(const bf16x8*)(qp + (size_t)SEQ * 64 + 32); }
#pragma unroll 1
        for (int st = 0; st < 2; ++st) {
            const int q0p = Q0 + 64 * st + 16 * qt, kb = q0p - 128;
            __syncthreads();
            const bf16x8 qA0 = qnA0, qA1 = qnA1, qB0 = qnB0, qB1 = qnB1;
            const int nkp = Q0 + 192 + (t >> 3), ncc = t & 7;
            f32x4 scA[17], scB[17];
            float mxA = skA, mxB = skB;
            int iA0 = skA > 0.f ? __float_as_int(skA) : 0, iA1 = 0, iB0 = skB > 0.f ? __float_as_int(skB) : 0, iB1 = 0;
            const int kcl0 = SKR + lr * 128 + ((g ^ ((lr >> 1) & 7)) << 4), kcl1 = SKR + lr * 128 + (((4 + g) ^ ((lr >> 1) & 7)) << 4);
#define SWA_QK(ALLOK_) \
            _Pragma("unroll") \
            for (int tt = 0; tt < 17; ++tt) { \
                const int kt0 = kb + 16 * tt; \
                const bool tile_ok = (ALLOK_) ? true : ((kt0 >= 0) && (kt0 < SEQ)); \
                f32x4 a; \
                if (tt >= 1 && tt <= 15) { const float a0 = (ALLOK_) ? 0.f : (tile_ok ? 0.f : -3.0e38f); a = (f32x4){a0, a0, a0, a0}; } \
                else { \
                    _Pragma("unroll") \
                    for (int e = 0; e < 4; ++e) { const int dlt = 16 * tt + 4 * g + e - lr; a[e] = (tile_ok && dlt >= 0 && dlt <= 256) ? 0.f : -3.0e38f; } \
                } \
                f32x4 aA = a, aB = a; \
                { \
                    const int rb = ((kt0 + RING) % RING) * 128; \
                    const bf16x8 k0 = *(const bf16x8*)(smem + rb + kcl0), k1 = *(const bf16x8*)(smem + rb + kcl1); \
                    aA = __builtin_amdgcn_mfma_f32_16x16x32_bf16(k0, qA0, aA, 0, 0, 0); \
                    aB = __builtin_amdgcn_mfma_f32_16x16x32_bf16(k0, qB0, aB, 0, 0, 0); \
                    aA = __builtin_amdgcn_mfma_f32_16x16x32_bf16(k1, qA1, aA, 0, 0, 0); \
                    aB = __builtin_amdgcn_mfma_f32_16x16x32_bf16(k1, qB1, aB, 0, 0, 0); \
                } \
                scA[tt] = aA; scB[tt] = aB; \
                if ((tt % 3) == 2) asm volatile("" ::: "memory");      \
                iA0 = imax3(iA0, __float_as_int(aA[0]), __float_as_int(aA[1])); iA1 = imax3(iA1, __float_as_int(aA[2]), __float_as_int(aA[3])); \
                iB0 = imax3(iB0, __float_as_int(aB[0]), __float_as_int(aB[1])); iB1 = imax3(iB1, __float_as_int(aB[2]), __float_as_int(aB[3])); \
            }
            if (kb >= 0 && kb + 256 < SEQ) { SWA_QK(true) } else { SWA_QK(false) }
#undef SWA_QK
            {
                int ia = iA0 > iA1 ? iA0 : iA1, ib = iB0 > iB1 ? iB0 : iB1;
                ia = gmaxi4(ia);
                ib = gmaxi4(ib);
                if (__builtin_expect(__any(ia == 0 || ib == 0), 0)) {
#pragma unroll
                    for (int tt = 0; tt < 17; ++tt) { mxA = fmaxf(fmaxf(mxA, fmaxf(scA[tt][0], scA[tt][1])), fmaxf(scA[tt][2], scA[tt][3])); mxB = fmaxf(fmaxf(mxB, fmaxf(scB[tt][0], scB[tt][1])), fmaxf(scB[tt][2], scB[tt][3])); }
                    mxA = gmaxf4(mxA);
                    mxB = gmaxf4(mxB);
                } else { mxA = __int_as_float(ia); mxB = __int_as_float(ib); }
            }
            float sumA = 0.f, sumB = 0.f;
            bf16x8 pfA[9], pfB[9];
#define SWA_SM(sc_, mx_, sum_, pf_) { \
            const f32x2 nm_ = {-(mx_), -(mx_)}; \
            _Pragma("unroll") \
            for (int kk = 0; kk < 9; ++kk) { \
                const f32x4 sa_ = sc_[2 * kk], sb_ = sc_[kk < 8 ? 2 * kk + 1 : 0]; \
                const f32x2 d0 = __builtin_shufflevector(sa_, sa_, 0, 1) + nm_, d1 = __builtin_shufflevector(sa_, sa_, 2, 3) + nm_;      \
                const f32x2 d2 = __builtin_shufflevector(sb_, sb_, 0, 1) + nm_, d3 = __builtin_shufflevector(sb_, sb_, 2, 3) + nm_; \
                float pe[8]; \
                pe[0] = __builtin_amdgcn_exp2f(d0.x); pe[1] = __builtin_amdgcn_exp2f(d0.y); pe[2] = __builtin_amdgcn_exp2f(d1.x); pe[3] = __builtin_amdgcn_exp2f(d1.y); \
                if (kk < 8) { pe[4] = __builtin_amdgcn_exp2f(d2.x); pe[5] = __builtin_amdgcn_exp2f(d2.y); pe[6] = __builtin_amdgcn_exp2f(d3.x); pe[7] = __builtin_amdgcn_exp2f(d3.y); } \
                else { pe[4] = 0.f; pe[5] = 0.f; pe[6] = 0.f; pe[7] = 0.f; } \
                union { bf16x8 v; unsigned u[4]; } pk; pk.u[0] = pk2(pe[0], pe[1]); pk.u[1] = pk2(pe[2], pe[3]); pk.u[2] = pk2(pe[4], pe[5]); pk.u[3] = pk2(pe[6], pe[7]); \
                pf_[kk] = pk.v; \
            } }
            SWA_SM(scA, mxA, sumA, pfA)
            SWA_SM(scB, mxB, sumB, pfB)
#undef SWA_SM
            asm volatile("" ::: "memory");
            u32x4 nwk, nwv;
            { const int tokk = nkp > SEQ - 1 ? SEQ - 1 : nkp; nwk = *(const u32x4*)(Kg + (size_t)tokk * 64 + ncc * 8); nwv = *(const u32x4*)(Vg + (size_t)tokk * 64 + ncc * 8);
              const bf16_t* qp = QgA + (size_t)(q0p + (st < 1 ? 64 : 0) + lr) * 64 + 8 * g; qnA0 = *(const bf16x8*)qp; qnA1 = *(const bf16x8*)(qp + 32);
              qnB0 = *(const bf16x8*)(qp + (size_t)SEQ * 64); qnB1 = *(const bf16x8*)(qp + (size_t)SEQ * 64 + 32); }

            f32x4 oA[4], oB[4];
#pragma unroll
            for (int dt = 0; dt < 4; ++dt) { oA[dt] = (f32x4){0.f, 0.f, 0.f, 0.f}; oB[dt] = (f32x4){0.f, 0.f, 0.f, 0.f}; }
            f32x4 osA = {0.f, 0.f, 0.f, 0.f}, osB = {0.f, 0.f, 0.f, 0.f};
            bf16x8 ones8;
#pragma unroll
            for (int j = 0; j < 8; ++j) ones8[j] = (short)0x3F80;
            const int vrow = 4 * g + (lr >> 2), vsw = (vrow >> 1) & 3, vbase = SVR + vrow * 128 + (lr & 3) * 8;
#pragma unroll
            for (int kk = 0; kk < 9; ++kk) {
                const int ra = ((kb + 32 * kk + RING) % RING) * 128, rb = kk == 8 ? ra : ((kb + 32 * kk + 16 + RING) % RING) * 128;
#pragma unroll
                for (int dt = 0; dt < 4; ++dt) {
                    const LAS3 unsigned char* ap = lsm + vbase + ((dt ^ vsw) << 5);
                    const bf16x8 vf = tr_pair(ap + ra, ap + rb);
                    oA[dt] = __builtin_amdgcn_mfma_f32_16x16x32_bf16(vf, pfA[kk], oA[dt], 0, 0, 0);
                    oB[dt] = __builtin_amdgcn_mfma_f32_16x16x32_bf16(vf, pfB[kk], oB[dt], 0, 0, 0);
                }
                osA = __builtin_amdgcn_mfma_f32_16x16x32_bf16(ones8, pfA[kk], osA, 0, 0, 0);
                osB = __builtin_amdgcn_mfma_f32_16x16x32_bf16(ones8, pfB[kk], osB, 0, 0, 0);
            }
            sumA = osA[0] + __builtin_amdgcn_exp2f(skA - mxA); sumB = osB[0] + __builtin_amdgcn_exp2f(skB - mxB);
            const int tok = b * SEQ + q0p + lr;
#define SWA_OUT(o_, sum_, hq_) { \
            const float inv = __builtin_amdgcn_rcpf(sum_); float sq = 0.f; \
            _Pragma("unroll") \
            for (int dt = 0; dt < 4; dt += 2) { \
                const f32x4 v = o_[dt] * inv, v2 = o_[dt + 1] * inv; \
                sq += (v.x * v.x + v.y * v.y + v.z * v.z + v.w * v.w) + (v2.x * v2.x + v2.y * v2.y + v2.z * v2.z + v2.w * v2.w); \
                u32x2 oa, ob; oa.x = pk2(v.x, v.y); oa.y = pk2(v.z, v.w); ob.x = pk2(v2.x, v2.y); ob.y = pk2(v2.z, v2.w); \
                store_pair16(ATT + (size_t)tok * DM + 512 + (hq_) * 64, oa, ob, dt, dt + 1, g, true); \
            } \
            sq = gsum4(sq); \
            if (g == 0) SSQ[tok * 16 + 8 + (hq_)] = sq; }
            SWA_OUT(oA, sumA, hqA)
            SWA_OUT(oB, sumB, hqA + 1)
#undef SWA_OUT
            __syncthreads();
            if (st == 0) { const int rr = (nkp + RING) % RING;
              *(u32x4*)(smem + SKR + k_off(rr, ncc)) = nwk; *(u32x4*)(smem + SVR + v_off(rr, ncc)) = nwv; }
        }
    }
}
#endif

DEVINL void phase4(const Params& P, unsigned char* smem) {
    const int t = threadIdx.x, wv = __builtin_amdgcn_readfirstlane(t >> 6);
    const bf16_t* ATT = (const bf16_t*)(P.ws + WS_ATT); const float* SSQ = (const float*)(P.ws + WS_SSQ);
    const bf16_t* WrF = (const bf16_t*)(P.ws + WS_WRF);
    const float* mod = (const float*)(P.ws + WS_MOD);
    unsigned char* H2 = P.ws + WS_H;
    bf16_t* X1B = (bf16_t*)(P.ws + WS_X1B); const bf16_t* XB = (const bf16_t*)(P.ws + WS_XB);
    unsigned* ccnt = (unsigned*)(P.ws + WS_CCNT); int* ctok = (int*)(P.ws + WS_CTOK); f32x2* cw = (f32x2*)(P.ws + WS_CW);
    float* s_part = (float*)(smem + 131072);
    float* s_lg = (float*)smem;
    float* s_t1 = (float*)(smem + 135168); float* s_t2 = s_t1 + 1024; float* s_t3 = s_t2 + 1024;
    for (int tile = blockIdx.x; tile < NT / 64; tile += gridDim.x) {
        const int m0 = tile * 64;
        int lane = t & 63;
        asm volatile("" : "+v"(lane));
        const int lr = lane & 15, g = lane >> 4;
        __syncthreads();
        {
            const float* mbt = mod + (m0 >> 13) * 6144;
            const int c2_ = 2 * t;
            const f32x2 ga_ = *(const f32x2*)(mbt + 2048 + c2_), gp_ = *(const f32x2*)(P.g_post_mix + c2_), gf_ = *(const f32x2*)(P.g_pre_ffn + c2_), sc_ = *(const f32x2*)(mbt + 4096 + c2_), sh_ = *(const f32x2*)(mbt + 3072 + c2_);
            *(f32x2*)(s_t1 + c2_) = ga_ * gp_; *(f32x2*)(s_t2 + c2_) = gf_ * (sc_ + 1.f); *(f32x2*)(s_t3 + c2_) = sh_;
        }
        {
            const int row = t >> 3;
            const float* sp = SSQ + (size_t)(m0 + row) * 16;
            const f32x4 a = *(const f32x4*)sp, b2 = *(const f32x4*)(sp + 4), c2 = *(const f32x4*)(sp + 8), d2 = *(const f32x4*)(sp + 12);
            const float rna = rsqrtf((a.x + a.y + a.z + a.w + b2.x + b2.y + b2.z + b2.w) * (1.f / 512.f) + EPS);
            const float rsw = rsqrtf((c2.x + c2.y + c2.z + c2.w + d2.x + d2.y + d2.z + d2.w) * (1.f / 512.f) + EPS);
            const bf16_t* src = ATT + (size_t)(m0 + row) * DM;
#pragma unroll 8
            for (int i = 0; i < 16; ++i) {
                const int c = (t & 7) + 8 * i;
                u32x4 v = *(const u32x4*)(src + c * 8);
                const float sc = (c < 64) ? rna : rsw;
                v.x = pk2(bflo(v.x) * sc, bfhi(v.x) * sc); v.y = pk2(bflo(v.y) * sc, bfhi(v.y) * sc);
                v.z = pk2(bflo(v.z) * sc, bfhi(v.z) * sc); v.w = pk2(bflo(v.w) * sc, bfhi(v.w) * sc);
                *(u32x4*)(smem + row * 2048 + ((c ^ (row & 15)) << 4)) = v;
            }
        }
        __syncthreads();
        f32x4 acc[8][4];
#pragma unroll
        for (int i = 0; i < 8; ++i)
#pragma unroll
            for (int mi = 0; mi < 4; ++mi) acc[i][mi] = (f32x4){0.f, 0.f, 0.f, 0.f};
        if (!SKIPF(32)) {
            const unsigned char* wb = (const unsigned char*)(P.ws + WS_WOF) + (size_t)(8 * wv) * 1024;
            unsigned voff = (unsigned)(lane * 16);
            asm volatile("" : "+v"(voff));
            const int aoff = lr * 2048;
#define AFRAG(mi_, ks_) (*(const bf16x8*)(smem + aoff + (mi_) * 32768 + (((4 * (ks_) + g) ^ lr) << 4)))
            bf16x8 b0[8], b1[8];
#define LOADB(dst, ks_) do { const unsigned char* ub_ = wb + (size_t)((ks_) * 64) * 1024; \
        _Pragma("unroll") for (int j_ = 0; j_ < 8; ++j_) dst[j_] = *(const bf16x8*)(ub_ + j_ * 1024 + voff); } while (0)
#define LOADA(fd, ks_) do { _Pragma("unroll") for (int mi_ = 0; mi_ < 4; ++mi_) fd[mi_] = AFRAG(mi_, ks_); } while (0)
#define MMA(src, fs, ksn_) do { _Pragma("unroll") for (int mi_ = 0; mi_ < 4; ++mi_) { \
        _Pragma("unroll") for (int j_ = 0; j_ < 8; ++j_) acc[j_][mi_] = __builtin_amdgcn_mfma_f32_16x16x32_bf16(src[j_], fs[mi_], acc[j_][mi_], 0, 0, 0); \
        fs[mi_] = AFRAG(mi_, (ksn_) < 32 ? (ksn_) : 31); } } while (0)
            bf16x8 fa[4];
            LOADB(b0, 0); LOADA(fa, 0);
#pragma unroll 1
            for (int ks = 0; ks < 32; ks += 2) {
                LOADB(b1, ks + 1);
                __builtin_amdgcn_sched_barrier(0);
                MMA(b0, fa, ks + 1);
                __builtin_amdgcn_sched_barrier(0);
                LOADB(b0, ks + 2 < 32 ? ks + 2 : 31);
                __builtin_amdgcn_sched_barrier(0);
                MMA(b1, fa, ks + 2);
                __builtin_amdgcn_sched_barrier(0);
            }
#undef LOADB
#undef MMA
#undef LOADA
#undef AFRAG
        }
        u32x2 xbv[16];
#define LDXB(hf_) { int l4 = lane; asm volatile("" : "+v"(l4)); const bf16_t* xp_ = XB + (size_t)(m0 + 32 * (hf_) + (l4 & 15)) * DM + 128 * wv + 4 * (l4 >> 4); \
        _Pragma("unroll") for (int i_ = 0; i_ < 16; ++i_) xbv[i_] = *(const u32x2*)(xp_ + (size_t)(16 * (i_ & 1)) * DM + 16 * (i_ >> 1)); }
        LDXB(0)
        float ss[4];
#pragma unroll
        for (int mi = 0; mi < 4; ++mi) {
            float q = 0.f;
#pragma unroll
            for (int nt = 0; nt < 8; ++nt) { const f32x4 a = acc[nt][mi]; q += a.x * a.x + a.y * a.y + a.z * a.z + a.w * a.w; }
            q = gsum4(q); ss[mi] = q;
        }
        if (g == 0) {
#pragma unroll
            for (int mi = 0; mi < 4; ++mi) s_part[wv * 64 + 16 * mi + lr] = ss[mi];
        }
        __syncthreads();
        float rs_[4];
#pragma unroll
        for (int mi = 0; mi < 4; ++mi) { float q = 0.f;
#pragma unroll
            for (int w2 = 0; w2 < 8; ++w2) q += s_part[w2 * 64 + 16 * mi + lr];
            rs_[mi] = rsqrtf(q * (1.f / DM) + EPS); }
        if (SKIPF(64)) continue;
        const float* mb = mod + (m0 >> 13) * 6144;
        f32x4 lg[3][4];
#pragma unroll
        for (int i = 0; i < 3; ++i)
#pragma unroll
            for (int mi = 0; mi < 4; ++mi) lg[i][mi] = (f32x4){0.f, 0.f, 0.f, 0.f};
        f32x4* xl = (f32x4*)smem + t;
        const bf16_t* wr = WrF + ((size_t)(wv * 4) * 3 * 64 + lane) * 8;
#pragma unroll
        for (int hf = 0; hf < 2; ++hf) {
            float q1[2] = {0.f, 0.f};
            if (!SKIPF(4096))
#pragma unroll
            for (int np = 0; np < 4; ++np) {
                u32x2 pk_[2][2];
#pragma unroll
                for (int q = 0; q < 2; ++q) {
                    const int nt = 2 * np + q, col = 128 * wv + 16 * nt + 4 * g;
                    const f32x4 gg_ = *(const f32x4*)(s_t1 + col);
#pragma unroll
                    for (int mi2 = 0; mi2 < 2; ++mi2) {
                        const int mi = 2 * hf + mi2;
                        const u32x2 xb_ = xbv[2 * nt + mi2];
                        const f32x4 r0 = (f32x4){bflo(xb_.x), bfhi(xb_.x), bflo(xb_.y), bfhi(xb_.y)} + gg_ * (acc[nt][mi] * rs_[mi]);
                        xl[(nt * 2 + mi2) * 512] = r0;
                        pk_[q][mi2].x = pk2(r0.x, r0.y); pk_[q][mi2].y = pk2(r0.z, r0.w);
                        q1[mi2] += r0.x * r0.x + r0.y * r0.y + r0.z * r0.z + r0.w * r0.w;
                    }
                }
#pragma unroll
                for (int mi2 = 0; mi2 < 2; ++mi2)
                    store_pair16(X1B + (size_t)(m0 + 16 * (2 * hf + mi2) + lr) * DM + 128 * wv, pk_[0][mi2], pk_[1][mi2], 2 * np, 2 * np + 1, g, true);
            }
            if (hf == 0) LDXB(1)
#pragma unroll
            for (int mi2 = 0; mi2 < 2; ++mi2) { q1[mi2] = gsum4(q1[mi2]); }
            if (g == 0) {
#pragma unroll
                for (int mi2 = 0; mi2 < 2; ++mi2) s_part[512 + wv * 64 + 16 * (2 * hf + mi2) + lr] = q1[mi2];
            }
            __syncthreads();
            if (SKIPF(8192)) continue;
            float rt2[2];
#pragma unroll
            for (int mi2 = 0; mi2 < 2; ++mi2) { float q = 0.f;
#pragma unroll
                for (int w2 = 0; w2 < 8; ++w2) q += s_part[512 + w2 * 64 + 16 * (2 * hf + mi2) + lr];
                rt2[mi2] = rsqrtf(q * (1.f / DM) + EPS); }
            bf16x8 rwh[3], rwl[3];
#pragma unroll
            for (int ot = 0; ot < 3; ++ot) { rwh[ot] = *(const bf16x8*)(wr + (size_t)ot * 512); rwl[ot] = *(const bf16x8*)(wr + (size_t)(4 * 8 * 3 * 64) * 8 + (size_t)ot * 512); }
#pragma unroll 1
            for (int p = 0; p < 4; ++p) {
                union { bf16x8 v; unsigned u[4]; } hh[2], hl[2];
                unsigned h8[2][2];
#pragma unroll
                for (int q = 0; q < 2; ++q) {
                    const int nt = 2 * p + q, col = 128 * wv + 16 * nt + 4 * g;
                    const f32x4 mul = *(const f32x4*)(s_t2 + col), sh = *(const f32x4*)(s_t3 + col);
#pragma unroll
                    for (int mi2 = 0; mi2 < 2; ++mi2) {
                        const f32x4 h = xl[(nt * 2 + mi2) * 512] * rt2[mi2] * mul + sh;
                        const unsigned u01 = pk2(h.x, h.y), u23 = pk2(h.z, h.w);
                        hh[mi2].u[2 * q] = u01; hh[mi2].u[2 * q + 1] = u23;
                        hl[mi2].u[2 * q] = pk2(h.x - bflo(u01), h.y - bfhi(u01));
                        hl[mi2].u[2 * q + 1] = pk2(h.z - bflo(u23), h.w - bfhi(u23));
                        h8[q][mi2] = pk4_fp8(h.x, h.y, h.z, h.w);
                    }
                }
                __builtin_amdgcn_sched_barrier(0);
#pragma unroll
                for (int ot = 0; ot < 3; ++ot) {
                    const bf16x8 whi = rwh[ot], wlo = rwl[ot];
#pragma unroll
                    for (int mi2 = 0; mi2 < 2; ++mi2) {
                        f32x4 a = lg[ot][2 * hf + mi2];
                        a = __builtin_amdgcn_mfma_f32_16x16x32_bf16(whi, hh[mi2].v, a, 0, 0, 0);
                        a = __builtin_amdgcn_mfma_f32_16x16x32_bf16(whi, hl[mi2].v, a, 0, 0, 0);
                        a = __builtin_amdgcn_mfma_f32_16x16x32_bf16(wlo, hh[mi2].v, a, 0, 0, 0);
                        lg[ot][2 * hf + mi2] = a;
                    }
                }
                __builtin_amdgcn_sched_barrier(0);
                { const int pn = p < 3 ? p + 1 : 3;
#pragma unroll
                  for (int ot = 0; ot < 3; ++ot) { rwh[ot] = *(const bf16x8*)(wr + (size_t)(pn * 3 + ot) * 512); rwl[ot] = *(const bf16x8*)(wr + (size_t)(4 * 8 * 3 * 64) * 8 + (size_t)(pn * 3 + ot) * 512); } }
                __builtin_amdgcn_sched_barrier(0);
#pragma unroll
                for (int mi2 = 0; mi2 < 2; ++mi2) {
                    const auto rr = __builtin_amdgcn_permlane16_swap(h8[0][mi2], h8[1][mi2], false, false);
                    u32x2 ov; ov.x = rr[0]; ov.y = rr[1];
                    *(u32x2*)(H2 + (size_t)(m0 + 16 * (2 * hf + mi2) + lr) * DM + 128 * wv + 16 * (2 * p + (g & 1)) + 8 * (g >> 1)) = ov;
                }
                __builtin_amdgcn_sched_barrier(0);
            }
        }
        __syncthreads();
#pragma unroll
        for (int ot = 0; ot < 3; ++ot)
#pragma unroll
            for (int mi = 0; mi < 4; ++mi)
#pragma unroll
                for (int e = 0; e < 4; ++e) s_lg[(wv * 48 + 16 * ot + 4 * g + e) * 64 + 16 * mi + lr] = lg[ot][mi][e];
        __syncthreads();
        if (t < 64 && !(P.flags & 1)) {
            const int row = m0 + t;
#define LG(o) (((s_lg[(o) * 64 + t] + s_lg[(48 + (o)) * 64 + t]) + (s_lg[(96 + (o)) * 64 + t] + s_lg[(144 + (o)) * 64 + t])) + \
               ((s_lg[(192 + (o)) * 64 + t] + s_lg[(240 + (o)) * 64 + t]) + (s_lg[(288 + (o)) * 64 + t] + s_lg[(336 + (o)) * 64 + t])))
            const float g0 = LG(0), g1 = LG(1), g2 = LG(2), g3 = LG(3);
            int gtop = 0; float gm = g0;
            if (g1 > gm) { gm = g1; gtop = 1; } if (g2 > gm) { gm = g2; gtop = 2; } if (g3 > gm) { gm = g3; gtop = 3; }
            const float gwt = 1.f / (expf(g0 - gm) + expf(g1 - gm) + expf(g2 - gm) + expf(g3 - gm));
            int i1 = 0, i2 = 0; float v1 = -3.0e38f, v2 = -3.0e38f;
            for (int e = 0; e < 8; ++e) {
                const float v = LG(4 + gtop * 8 + e);
                if (v > v1) { v2 = v1; i2 = i1; v1 = v; i1 = e; } else if (v > v2) { v2 = v; i2 = e; }
            }
#undef LG
            const float ex = expf(v2 - v1), w1 = gwt / (1.f + ex), w2 = gwt * ex / (1.f + ex);
            const int ilo = i1 < i2 ? i1 : i2, ihi = i1 < i2 ? i2 : i1; const float wlo = i1 < i2 ? w1 : w2, whi = i1 < i2 ? w2 : w1;
            const int cls = gtop * 28 + ilo * (15 - ilo) / 2 + (ihi - ilo - 1);
            unsigned* s_cnt = (unsigned*)(smem + LDS_MISC);
            s_cnt[t] = 0u; if (t < 48) s_cnt[64 + t] = 0u;
            asm volatile("s_waitcnt lgkmcnt(0)" ::: "memory");
            const unsigned lrk = atomicAdd(&s_cnt[cls], 1u);
            asm volatile("s_waitcnt lgkmcnt(0)" ::: "memory");
            { int tq = threadIdx.x; asm volatile("" : "+v"(tq));
              const unsigned c0_ = s_cnt[tq]; s_cnt[128 + tq] = c0_ ? atomicAdd(&ccnt[tq * 64], c0_) : 0u;
              if (tq < 48) { const unsigned c1_ = s_cnt[64 + tq]; s_cnt[192 + tq] = c1_ ? atomicAdd(&ccnt[(64 + tq) * 64], c1_) : 0u; } }
            asm volatile("s_waitcnt vmcnt(0) lgkmcnt(0)" ::: "memory");
            const unsigned pos = s_cnt[128 + cls] + lrk;
            ctok[cls * NT + pos] = row; cw[cls * NT + pos] = (f32x2){wlo, whi};
        }
    }
}

DEVINL void phase5(const Params& P, unsigned char* smem) {
    const int t0_ = threadIdx.x, wv = __builtin_amdgcn_readfirstlane(t0_ >> 6);
    int t = t0_;
    const unsigned char* H2 = P.ws + WS_H; const bf16_t* X1B = (const bf16_t*)(P.ws + WS_X1B);
    const unsigned* ccnt = (const unsigned*)(P.ws + WS_CCNT); const int* ctok = (const int*)(P.ws + WS_CTOK); const f32x2* cw = (const f32x2*)(P.ws + WS_CW);
    const float* mod = (const float*)(P.ws + WS_MOD);
    unsigned char* hs0 = smem + 81920;
    float* s_part = (float*)(smem + 122880);
    int* s_cv = (int*)(smem + LDS_MISC + 512);
    int* s_cp = (int*)(smem + LDS_MISC + 1024);
    int* s_tok = (int*)(smem + LDS_MISC + 2304);
    float* s_wl = (float*)(smem + LDS_MISC + 2304 + 320); float* s_wh = s_wl + 80;
    float* s_gfp = (float*)(smem + 126976);
    if (t < 64) {
        const int c0 = (int)ccnt[t * 64], c1 = t < 48 ? (int)ccnt[(64 + t) * 64] : 0;
        const int n0 = (c0 + 79) / 80, n1 = (c1 + 79) / 80;
        int i0 = n0, i1 = n1;
#pragma unroll
        for (int d = 1; d < 64; d <<= 1) { const int u0 = __shfl_up(i0, d), u1 = __shfl_up(i1, d); if (t >= d) { i0 += u0; i1 += u1; } }
        const int tot0 = __shfl(i0, 63);
        s_cv[t] = c0; s_cp[t] = i0 - n0;
        if (t < 48) { s_cv[64 + t] = c1; s_cp[64 + t] = tot0 + i1 - n1; }
        if (t == 47) s_cp[112] = tot0 + i1;
    }
    {
        const f32x4 gp = *(const f32x4*)(P.g_post_ffn + 4 * (t & 255)), gf = *(const f32x4*)(mod + (t >> 8) * 6144 + 5120 + 4 * (t & 255));
        *(f32x4*)(s_gfp + 4 * t) = gf * gp;
    }
    __syncthreads();
    const int total = s_cp[112];
    const int G = gridDim.x, vb = (G % 8 == 0) ? (int)(blockIdx.x % 8) * (G / 8) + (int)(blockIdx.x / 8) : (int)blockIdx.x;
    typedef int i32x8 __attribute__((ext_vector_type(8)));
    typedef int i32x4v __attribute__((ext_vector_type(4)));
#define MX(a_, b_, c_) __builtin_amdgcn_mfma_scale_f32_16x16x128_f8f6f4(a_, b_, c_, 0, 0, 0, 0x7f7f7f7f, 0, 0x7f7f7f7f)
#define CAT8(lo_, hi_) __builtin_shufflevector((lo_), (hi_), 0, 1, 2, 3, 4, 5, 6, 7)
#define LD32(p_) CAT8(*(const i32x4v*)(p_), *(const i32x4v*)((p_) + 16))
    for (int it = vb; it < total; it += G) {
        int cls = 0;
#pragma unroll
        for (int st = 64; st >= 1; st >>= 1) if (cls + st <= 111 && s_cp[cls + st] <= it) cls += st;
        const int mt = it - s_cp[cls], cc = s_cv[cls], ntl = s_cp[cls + 1] - s_cp[cls], rpt = (cc + ntl - 1) / ntl;
        const int rbeg = mt * rpt, rend = (rbeg + rpt < cc) ? rbeg + rpt : cc;
        const int grp = cls / 28, pidx = cls - grp * 28;
        int ilo = 0; for (; ilo < 7; ++ilo) { const int b_ = ilo * (15 - ilo) / 2; if (pidx < b_ + 7 - ilo) break; }
        const int e_lo = grp * 8 + ilo, e_hi = grp * 8 + ilo + 1 + (pidx - ilo * (15 - ilo) / 2);
        t = t0_; asm volatile("" : "+v"(t));
        int lane = t & 63;
        const int lr = lane & 15, g = lane >> 4;
        unsigned voff = (unsigned)(lane * 32);
        asm volatile("" : "+v"(voff));
        __syncthreads();
        {
#pragma unroll
            for (int rp = 0; rp < 2; ++rp) {
                const int row = (t >> 3) + 64 * rp, r = rbeg + row;
                if (row < 80) {
                    const bool ok = r < rend;
                    const int tok = ok ? ctok[cls * NT + r] : 0; const f32x2 w2 = ok ? cw[cls * NT + r] : (f32x2){0.f, 0.f};
                    if ((t & 7) == 0) { s_tok[row] = ok ? tok : -1; s_wl[row] = w2.x; s_wh[row] = w2.y; }
                    const unsigned char* src = H2 + (size_t)tok * DM;
#pragma unroll
                    for (int i = 0; i < 8; ++i) { const int c = (t & 7) + 8 * i; *(u32x4*)(smem + row * 1024 + ((c ^ (row & 15)) << 4)) = *(const u32x4*)(src + c * 16); }
                }
            }
        }
        __syncthreads();
        i32x8 b0[4];
#pragma unroll
        for (int j_ = 0; j_ < 4; ++j_) b0[j_] = LD32(P.ws + WS_WGUF + (size_t)e_lo * (8 * 32 * 2048) + (size_t)(4 * wv) * 2048 + j_ * 2048 + voff);
#pragma unroll 1
        for (int sx = 0; sx < 2; ++sx) {
            const int e = sx ? e_hi : e_lo;
            f32x4 acc[4][5];
#pragma unroll
            for (int i = 0; i < 4; ++i)
#pragma unroll
                for (int mi = 0; mi < 5; ++mi) acc[i][mi] = (f32x4){0.f, 0.f, 0.f, 0.f};
            const unsigned char* wb1 = P.ws + WS_WGUF + (size_t)e * (8 * 32 * 2048) + (size_t)(4 * wv) * 2048;
            const int aoff = lr * 1024;
#define AFRAG(mi_, ks_) CAT8(*(const i32x4v*)(smem + aoff + (mi_) * 16384 + (((8 * (ks_) + 2 * g) ^ lr) << 4)), *(const i32x4v*)(smem + aoff + (mi_) * 16384 + (((8 * (ks_) + 2 * g + 1) ^ lr) << 4)))
            const unsigned char* nxt_ = sx ? P.ws + WS_WDF + (size_t)e_lo * (2 * 64 * 2048) + (size_t)(8 * wv) * 2048 : P.ws + WS_WGUF + (size_t)e_hi * (8 * 32 * 2048) + (size_t)(4 * wv) * 2048;
#pragma unroll 1
            for (int ks = 0; ks < 8; ++ks) {
                i32x8 fa[5];
#pragma unroll
                for (int mi_ = 0; mi_ < 5; ++mi_) fa[mi_] = AFRAG(mi_, ks);
                const unsigned char* un_ = ks + 1 < 8 ? wb1 + (size_t)((ks + 1) * 32) * 2048 : nxt_;
#pragma unroll
                for (int j_ = 0; j_ < 4; ++j_) {
#pragma unroll
                    for (int mi_ = 0; mi_ < 5; ++mi_) acc[j_][mi_] = MX(b0[j_], fa[mi_], acc[j_][mi_]);
                    b0[j_] = LD32(un_ + j_ * 2048 + voff);
                    __builtin_amdgcn_sched_barrier(0);
                }
            }
#undef AFRAG
            int l1 = lane;
            asm volatile("" : "+v"(l1));
            const int lrh = l1 & 15, gh = l1 >> 4;
            unsigned char* hsm = hs0 + sx * 20480;
            const float* swt = sx ? s_wh : s_wl;
#pragma unroll
            for (int p = 0; p < 2; ++p)
#pragma unroll
                for (int mi = 0; mi < 5; ++mi) {
                    const int row = 16 * mi + lrh, c16 = 2 * wv + p;
                    const float ws_ = swt[row] * (8.f / 32.f);
                    const f32x4 gt = acc[2 * p][mi] * (1.f / 32.f), up = acc[2 * p + 1][mi] * ws_;
                    const unsigned o = pk4_fp8(sat8(gt.x * __builtin_amdgcn_rcpf(1.f + __expf(-gt.x)) * up.x), sat8(gt.y * __builtin_amdgcn_rcpf(1.f + __expf(-gt.y)) * up.y), sat8(gt.z * __builtin_amdgcn_rcpf(1.f + __expf(-gt.z)) * up.z), sat8(gt.w * __builtin_amdgcn_rcpf(1.f + __expf(-gt.w)) * up.w));
                    *(unsigned*)(hsm + row * 256 + ((c16 ^ (row & 15)) << 4) + 4 * gh) = o;
                }
        }
        __syncthreads();
        {
            int l2 = lane;
            asm volatile("" : "+v"(l2));
            const int lr2 = l2 & 15, g2 = l2 >> 4;
            const int aoff = lr2 * 256;
            unsigned voff2 = (unsigned)(l2 * 32);
#define AFRAG(hb_, mi_, ks_) CAT8(*(const i32x4v*)((hb_) + aoff + (mi_) * 4096 + (((8 * (ks_) + 2 * g2) ^ lr2) << 4)), *(const i32x4v*)((hb_) + aoff + (mi_) * 4096 + (((8 * (ks_) + 2 * g2 + 1) ^ lr2) << 4)))
            u32x2 ypk[4][5];
            f32x4 acc[4][5];
            float q[5] = {0.f, 0.f, 0.f, 0.f, 0.f};
            const unsigned char* wd0 = P.ws + WS_WDF + (size_t)(8 * wv) * 2048;
#pragma unroll
            for (int ph = 0; ph < 2; ++ph) {
#pragma unroll
                for (int i = 0; i < 4; ++i)
#pragma unroll
                    for (int mi = 0; mi < 5; ++mi) acc[i][mi] = (f32x4){0.f, 0.f, 0.f, 0.f};
#pragma unroll 1
                for (int sk = 0; sk < 4; ++sk) {
                    const int sn = 4 * ph + sk + 1 < 8 ? 4 * ph + sk + 1 : 7, sxn = (sn >> 1) & 1;
                    const unsigned char* wn = wd0 + (size_t)(sxn ? e_hi : e_lo) * (2 * 64 * 2048) + (size_t)((sn & 1) * 64 + 4 * (sn >> 2)) * 2048;
                    const unsigned char* hb = hs0 + (sk >> 1) * 20480;
                    i32x8 fa[5];
#pragma unroll
                    for (int mi_ = 0; mi_ < 5; ++mi_) fa[mi_] = AFRAG(hb, mi_, sk & 1);
#pragma unroll
                    for (int j_ = 0; j_ < 4; ++j_) {
#pragma unroll
                        for (int mi_ = 0; mi_ < 5; ++mi_) acc[j_][mi_] = MX(b0[j_], fa[mi_], acc[j_][mi_]);
                        b0[j_] = LD32(wn + j_ * 2048 + voff2);
                        __builtin_amdgcn_sched_barrier(0);
                    }
                }
#pragma unroll
                for (int i = 0; i < 4; ++i)
#pragma unroll
                    for (int mi = 0; mi < 5; ++mi) {
                        const f32x4 v = acc[i][mi] * (1.f / 128.f);
                        q[mi] += v.x * v.x + v.y * v.y + v.z * v.z + v.w * v.w;
                        if (ph == 0) { ypk[i][mi].x = pk2(v.x, v.y); ypk[i][mi].y = pk2(v.z, v.w); } else acc[i][mi] = v;
                    }
            }
#undef AFRAG
#pragma unroll
            for (int mi = 0; mi < 5; ++mi) { q[mi] = gsum4(q[mi]); }
            if (g2 == 0) {
#pragma unroll
                for (int mi = 0; mi < 5; ++mi) s_part[wv * 80 + 16 * mi + lr2] = q[mi];
            }
            u32x2 xb[2][8];
#define LDX1(mi_, buf_) { const int tk_ = s_tok[16 * (mi_) + lr2]; const bf16_t* xr_ = X1B + (size_t)(tk_ < 0 ? 0 : tk_) * DM + 128 * wv + 4 * g2; \
                _Pragma("unroll") for (int c_ = 0; c_ < 8; ++c_) xb[buf_][c_] = *(const u32x2*)(xr_ + 16 * c_); }
            LDX1(0, 0)
            __syncthreads();
#pragma unroll
            for (int mi = 0; mi < 5; ++mi) {
                if (mi + 1 < 5) LDX1(mi + 1, (mi + 1) & 1)
                const int tok = s_tok[16 * mi + lr2];
                float qs = 0.f;
#pragma unroll
                for (int w2 = 0; w2 < 8; ++w2) qs += s_part[w2 * 80 + 16 * mi + lr2];
                const float rstd = rsqrtf(qs * (1.f / DM) + EPS);
                const float* gfr = s_gfp + ((tok >> 13) & 1) * 1024 + 128 * wv + 4 * g2;
                float* orow = P.out + (size_t)(tok < 0 ? 0 : tok) * DM + 128 * wv + 4 * g2;
#pragma unroll
                for (int c = 0; c < 8; ++c) {
                    const f32x4 yv = c < 4 ? (f32x4){bflo(ypk[c & 3][mi].x), bfhi(ypk[c & 3][mi].x), bflo(ypk[c & 3][mi].y), bfhi(ypk[c & 3][mi].y)} : acc[c & 3][mi];
                    const u32x2 xv = xb[mi & 1][c];
                    const f32x4 x1 = {bflo(xv.x), bfhi(xv.x), bflo(xv.y), bfhi(xv.y)};
                    const f32x4 gg = *(const f32x4*)(gfr + 16 * c);
                    if (tok >= 0) *(f32x4*)(orow + 16 * c) = x1 + gg * (yv * rstd);
                }
                asm volatile("" ::: "memory");
            }
#undef LDX1
        }
    }
#undef MX
#undef LD32
#undef CAT8
}


#define LAS __attribute__((address_space(3)))
#define XB_TMO      128
#define XB_XCNT(j)  (256  + 64 * (j))
#define XB_XSUB(j)  (1280 + 64 * (j))
#define XB_XGEN(j)  (2304 + 64 * (j))
#define XB_TOP      3328
#define XB_TOPGEN   3392
#define XCD_BAR_WORDS 3456
#define XB_XSUBI(i, j) (4096 + 1024 * (i) + 64 * (j))
#define XB_TOPI(i)     (8192 + 64 * (i))
#define XB_GWORDS      8448
__device__ unsigned g_xbar[XB_GWORDS];
DEVINL void xb_st0(unsigned* p) { __hip_atomic_store(p, 0u, __ATOMIC_RELAXED, __HIP_MEMORY_SCOPE_AGENT); }
DEVINL void xb_reset_after(unsigned* bar, int i) {
#pragma unroll
    for (int j = 0; j < 16; ++j) xb_st0(&bar[XB_XSUBI(i - 1, j)]);
    xb_st0(&bar[XB_TOPI(i - 1)]);
    if (i == 1) {
#pragma unroll
        for (int j = 0; j < 16; ++j) xb_st0(&bar[256 + 64 * j]);
    }
}
#define XB_SPIN_CAP (1u << 18)
DEVINL unsigned xb_ld(unsigned* p)              { return __hip_atomic_load(p, __ATOMIC_RELAXED, __HIP_MEMORY_SCOPE_AGENT); }
DEVINL unsigned xb_add(unsigned* p, unsigned v) { return __hip_atomic_fetch_add(p, v, __ATOMIC_RELAXED, __HIP_MEMORY_SCOPE_AGENT); }
DEVINL unsigned xb_xcc_id() { return (unsigned)__builtin_amdgcn_s_getreg((3 << 11) | 20) & 0xFu; }
#define XB_SPIN(cond, bar) do { unsigned _sp = 0; while (cond) { __builtin_amdgcn_s_sleep(1); \
    if ((++_sp & 255u) == 0u) { if (xb_ld(&(bar)[XB_TMO])) break; if (_sp > XB_SPIN_CAP) { atomicAdd(&(bar)[XB_TMO], 1u); break; } } } } while (0)
struct XcdBarrier { unsigned* bar; unsigned x; volatile LAS unsigned* st; };
DEVINL XcdBarrier xcd_barrier_post(unsigned* bar, volatile LAS unsigned* st) {
    XcdBarrier b; b.bar = bar; b.x = xb_xcc_id(); b.st = st;
    if (threadIdx.x == 0) (void)xb_add(&bar[XB_XCNT(b.x)], 1u);
    return b;
}
DEVINL void xcd_barrier_complete(unsigned* bar, unsigned x, unsigned& nloc, unsigned& nx) {
    const unsigned G = gridDim.x * gridDim.y * gridDim.z;
    unsigned sum, cnt, mine, sp = 0u;
    for (;;) {
        sum = 0u; cnt = 0u; mine = 0u;
#pragma unroll
        for (unsigned j = 0; j < 16; ++j) { const unsigned c = xb_ld(&bar[XB_XCNT(j)]); sum += c; cnt += (c > 0u) ? 1u : 0u; mine = (j == x) ? c : mine; }
        if (sum == G) break;
        __builtin_amdgcn_s_sleep(1);
        if ((++sp & 255u) == 0u) { if (xb_ld(&bar[XB_TMO])) break; if (sp > XB_SPIN_CAP) { atomicAdd(&bar[XB_TMO], 1u); break; } }
    }
    nloc = mine > 0u ? mine : 1u; nx = cnt > 0u ? cnt : 1u;
}
DEVINL void xcd_barrier(const XcdBarrier& b, const int bi) {
    asm volatile("s_waitcnt vmcnt(0)" ::: "memory");
    __syncthreads();
    if (threadIdx.x == 0) {
        unsigned* bar = b.bar;
        __builtin_amdgcn_s_waitcnt(0);
        unsigned nloc = b.st[0], nx = b.st[1];
        const unsigned old = xb_add(&bar[XB_XSUBI(bi, b.x)], 1u);
        if (nloc == 0u) { xcd_barrier_complete(bar, b.x, nloc, nx); b.st[0] = nloc; b.st[1] = nx; }
        if (old + 1u == nloc) {
            __builtin_amdgcn_fence(__ATOMIC_RELEASE, "agent");
            asm volatile("s_waitcnt vmcnt(0)" ::: "memory");
            (void)xb_add(&bar[XB_TOPI(bi)], 1u);
        }
        XB_SPIN(xb_ld(&bar[XB_TOPI(bi)]) < nx, bar);
        __builtin_amdgcn_fence(__ATOMIC_ACQUIRE, "agent");
        asm volatile("s_waitcnt vmcnt(0)" ::: "memory");
        if (blockIdx.x == 0 && bi >= 1) xb_reset_after(bar, bi);
    }
    __syncthreads();
}
template <int W> DEVINL void xcd_barrier_w(const XcdBarrier& b, const Params& P, XPre& X) {
    asm volatile("s_waitcnt vmcnt(0)" ::: "memory");
    __syncthreads();
    if (threadIdx.x >= 256 && (int)blockIdx.x < NT / 64) {
        const int wv_ = __builtin_amdgcn_readfirstlane(threadIdx.x >> 6);
        { int l3 = threadIdx.x & 63; asm volatile("" : "+v"(l3)); expert_unit_quarter(P, 3 * (int)blockIdx.x + (W - 1), wv_ - 4, l3); }
        if (W == 1) { int l3 = threadIdx.x & 63; asm volatile("" : "+v"(l3)); wout_fragment(P, 8 * (int)blockIdx.x + 2 * (wv_ - 4), l3); wout_fragment(P, 8 * (int)blockIdx.x + 2 * (wv_ - 4) + 1, l3); }
    }
    if (W == 2 && threadIdx.x >= 64) router_frags(P, (int)blockIdx.x * (NTHR - 64) + ((int)threadIdx.x - 64), (int)gridDim.x * (NTHR - 64));
    if (W == 1 && threadIdx.x >= 64 && (int)blockIdx.x < NT / 64) stage_x_load(P, (int)blockIdx.x * 64, X);
    if (threadIdx.x == 0) {
        unsigned* bar = b.bar;
        __builtin_amdgcn_s_waitcnt(0);
        unsigned nloc = b.st[0], nx = b.st[1];
        const unsigned old = xb_add(&bar[XB_XSUBI((W - 1), b.x)], 1u);
        if (nloc == 0u) { xcd_barrier_complete(bar, b.x, nloc, nx); b.st[0] = nloc; b.st[1] = nx; }
        if (old + 1u == nloc) {
            __builtin_amdgcn_fence(__ATOMIC_RELEASE, "agent");
            asm volatile("s_waitcnt vmcnt(0)" ::: "memory");
            (void)xb_add(&bar[XB_TOPI((W - 1))], 1u);
        }
        XB_SPIN(xb_ld(&bar[XB_TOPI((W - 1))]) < nx, bar);
        __builtin_amdgcn_fence(__ATOMIC_ACQUIRE, "agent");
        asm volatile("s_waitcnt vmcnt(0)" ::: "memory");
        if (blockIdx.x == 0 && (W - 1) >= 1) xb_reset_after(bar, (W - 1));
    }
    __syncthreads();
}
constexpr size_t WS_BAR = 16384;
constexpr size_t CTL_ZERO_BYTES = 65536;

constexpr int NPHASE = 5;
__global__ void __launch_bounds__(NTHR, 2) fwd_kernel(Params P) {
    extern __shared__ __attribute__((aligned(16))) unsigned char smem[];
#if N_LAUNCH_MODE == 1
    cg::grid_group grid = cg::this_grid();
#define SEAM(k) do { if (P.ph_lo <= (k) && (k) + 1 < P.ph_hi) grid.sync(); } while (0)
#elif N_LAUNCH_MODE == 2
    volatile LAS unsigned* bst = (volatile LAS unsigned*)(smem + LDS_MISC + 2048);
    if (threadIdx.x < 4) bst[threadIdx.x] = 0u;
    __syncthreads();
    if (blockIdx.x == 0 && threadIdx.x < 17) xb_st0(threadIdx.x < 16 ? &g_xbar[XB_XSUBI(NPHASE - 2, threadIdx.x)] : &g_xbar[XB_TOPI(NPHASE - 2)]);
    const XcdBarrier xbar = xcd_barrier_post(g_xbar, bst);
#define SEAM(k) do { if (P.ph_lo <= (k) && (k) + 1 < P.ph_hi) xcd_barrier(xbar, (k)); } while (0)
#else
#define SEAM(k) do { } while (0)
#endif
#define IN(k) (P.ph_lo <= (k) && (k) < P.ph_hi)
    XPre xpre; bool have_pre = false;
#if N_LAUNCH_MODE == 2
    const bool fullrun = P.ph_lo == 0 && P.ph_hi == NPHASE;
#else
    const bool fullrun = false;
#endif
    if (IN(0)) { phase0(P, smem, !fullrun); }
#if N_LAUNCH_MODE == 2
    if (fullrun) { xcd_barrier_w<1>(xbar, P, xpre); have_pre = true; } else SEAM(0);
#else
    SEAM(0);
#endif
    if (IN(1)) { phase2(P, smem, xpre, have_pre); }
#if N_LAUNCH_MODE == 2
    if (fullrun) xcd_barrier_w<2>(xbar, P, xpre); else SEAM(1);
#else
    SEAM(1);
#endif
    if (IN(2)) { phase3(P, smem); }
#if N_LAUNCH_MODE == 2
    if (fullrun) xcd_barrier_w<3>(xbar, P, xpre); else SEAM(2);
#else
    SEAM(2);
#endif
    if (IN(3)) { phase4(P, smem); }  SEAM(3);
    if (IN(4)) { phase5(P, smem); }
#undef IN
#undef SEAM
}

extern "C" void kernel_launch(void* const* d_in, const int* in_sizes, int n_in, void* d_out, int out_size, void* d_ws, size_t ws_size, hipStream_t stream) {
    static int grid_blocks = 0;
    if (!grid_blocks) {
        if (ws_size < WS_END) { fprintf(stderr, "kernel_launch: workspace too small (%zu < %zu)\n", ws_size, (size_t)WS_END); grid_blocks = -1; return; }
        int dev = 0, cus = 0, per_cu = 0;
        hipGetDevice(&dev);
        hipDeviceGetAttribute(&cus, hipDeviceAttributeMultiprocessorCount, dev);
        hipFuncSetAttribute((const void*)fwd_kernel, hipFuncAttributeMaxDynamicSharedMemorySize, LDS_BYTES);
        hipOccupancyMaxActiveBlocksPerMultiprocessor(&per_cu, (const void*)fwd_kernel, NTHR, LDS_BYTES);
        if (per_cu > 1) per_cu = 1;
        if (per_cu < 1) per_cu = 1;
        grid_blocks = cus * per_cu;
        fprintf(stderr, "kernel_launch: %d CUs x %d blocks\n", cus, per_cu);
    }
    if (grid_blocks < 0) return;
    Params p{};
    const float** pp = (const float**)&p;
    for (int i = 0; i < 19; ++i) pp[i] = (const float*)d_in[i];
    p.out = (float*)d_out; p.ws = (unsigned char*)d_ws;
#if N_LAUNCH_MODE == 2
    p.ph_lo = 0; p.ph_hi = NPHASE;
    hipLaunchKernelGGL(fwd_kernel, dim3(grid_blocks), dim3(NTHR), LDS_BYTES, stream, p);
#elif N_LAUNCH_MODE == 1
    p.ph_lo = 0; p.ph_hi = NPHASE;
    void* args[] = {&p};
    hipError_t e = hipLaunchCooperativeKernel((const void*)fwd_kernel, dim3(grid_blocks), dim3(NTHR), args, LDS_BYTES, stream);
    if (e != hipSuccess) fprintf(stderr, "cooperative launch failed: %s (grid %d)\n", hipGetErrorString(e), grid_blocks);
#else
#ifndef REPEAT_ALL
#define REPEAT_ALL 1
#endif
#ifndef EMPTY_LAUNCHES
#define EMPTY_LAUNCHES 0
#endif
    for (int i = 0; i < EMPTY_LAUNCHES; ++i) { p.ph_lo = 99; p.ph_hi = 99; p.flags = 0; hipLaunchKernelGGL(fwd_kernel, dim3(grid_blocks), dim3(NTHR), LDS_BYTES, stream, p); }
#ifndef SKIP2_MASK
#define SKIP2_MASK 0
#endif
    for (int rep = 0; rep < REPEAT_ALL; ++rep)
    for (int ph = 0; ph < NPHASE; ++ph) {
        if (rep == 1 && (SKIP2_MASK & (1 << ph))) continue;
#ifndef SKIP1_MASK
#define SKIP1_MASK 0
#endif
        if (rep == 0 && REPEAT_ALL == 2 && (SKIP1_MASK & (1 << ph))) continue;
        p.ph_lo = ph; p.ph_hi = ph + 1;
        if (REPEAT_MASK & (1 << ph)) { p.flags = 1; hipLaunchKernelGGL(fwd_kernel, dim3(grid_blocks), dim3(NTHR), LDS_BYTES, stream, p); }
#ifndef PROBE_FLAGS1
#define PROBE_FLAGS1 0
#endif
        p.flags = (REPEAT_ALL == 2 && rep == 0) ? PROBE_FLAGS1 : 0;
        hipLaunchKernelGGL(fwd_kernel, dim3(grid_blocks), dim3(NTHR), LDS_BYTES, stream, p);
    }
#endif
}
```
